# Optimizing an MI355X kernel written in HIP

```python
import math
import jax, jax.numpy as jnp
from jax import lax
import numpy as np

D_MODEL = 2048
BATCH = 1
SEQ = 8192
DEPTH = 4

N_META = 16
LN_EPS = 1e-5
RMS_EPS = 1e-6
DEEPNORM_ALPHA = (2.0 * DEPTH) ** 0.25
DEEPNORM_BETA = (8.0 * DEPTH) ** -0.25
N_EVEN = (DEPTH + 1) // 2
N_ODD = DEPTH // 2

SSD_D_INNER = D_MODEL
SSD_HEAD_DIM = 64
SSD_HEADS = SSD_D_INNER // SSD_HEAD_DIM
SSD_GROUPS = 8
SSD_HPG = SSD_HEADS // SSD_GROUPS
SSD_STATE = 128
SSD_CONV = 4
SSD_CHUNK = 128
SSD_CONV_DIM = SSD_D_INNER + 2 * SSD_GROUPS * SSD_STATE
SSD_DT_MIN = 1e-3
SSD_DT_MAX = 1e-1

GLA_HEADS = 4
GLA_DK = D_MODEL // 2
GLA_DV = D_MODEL
GLA_HEAD_DK = GLA_DK // GLA_HEADS
GLA_HEAD_DV = GLA_DV // GLA_HEADS
GLA_GATE_RANK = 16
GLA_GATE_TAU = 16.0
GLA_CHUNK = 64

HYB_SIZES = (SSD_D_INNER, SSD_CONV_DIM, SSD_HEADS, GLA_DK, GLA_DK, GLA_DV, GLA_GATE_RANK, GLA_DV)
HYB_IN_COLS = sum(HYB_SIZES)
HYB_MIX_WIDTH = SSD_D_INNER + GLA_DV

SWA_HEAD_DIM = 64
SWA_Q_HEADS = D_MODEL // SWA_HEAD_DIM
SWA_KV_HEADS = 8
SWA_GROUP = SWA_Q_HEADS // SWA_KV_HEADS
SWA_WINDOW = 128
SWA_Q_DIM = SWA_Q_HEADS * SWA_HEAD_DIM
SWA_KV_DIM = SWA_KV_HEADS * SWA_HEAD_DIM
SWA_QKV_COLS = SWA_Q_DIM + 2 * SWA_KV_DIM
ROPE_THETA = 500000.0
ROPE_DIM = SWA_HEAD_DIM // 4

D_FF = 5504
FFN_CONV = 3

kernel_name = 'hybrid_ssd_gla_swa_convffn_deepnorm'


def _split_points(sizes):
    pts, acc = [], 0
    for s in sizes[:-1]:
        acc += s
        pts.append(acc)
    return pts


def _pad_front(t, n):
    return jnp.pad(t, ((0, 0), (n, 0)) + ((0, 0),) * (t.ndim - 2))


def layer_norm(x, g, b):
    xf = x.astype(jnp.float32)
    mu = jnp.mean(xf, axis=-1, keepdims=True)
    var = jnp.mean(jnp.square(xf - mu), axis=-1, keepdims=True)
    return ((xf - mu) * lax.rsqrt(var + LN_EPS) * g + b).astype(x.dtype)


def rms_norm_groups(x, w, group):
    shp = x.shape
    xf = x.astype(jnp.float32).reshape(shp[:-1] + (shp[-1] // group, group))
    y = xf * lax.rsqrt(jnp.mean(jnp.square(xf), axis=-1, keepdims=True) + RMS_EPS)
    return (y.reshape(shp) * w).astype(x.dtype)


def causal_depthwise_conv(x, w, b):
    k_size = w.shape[0]
    length = x.shape[1]
    xp = jnp.pad(x, ((0, 0), (k_size - 1, 0), (0, 0)))
    y = b + w[0] * xp[:, 0:length]
    for kk in range(1, k_size):
        y = y + w[kk] * xp[:, kk:kk + length]
    return y


def partial_rotary(x, pos):
    half = ROPE_DIM // 2
    inv_freq = ROPE_THETA ** (-jnp.arange(half, dtype=jnp.float32) / half)
    ang = pos.astype(jnp.float32)[:, None] * inv_freq[None, :]
    cos = jnp.cos(ang)[None, :, None, :]
    sin = jnp.sin(ang)[None, :, None, :]
    x1, x2, rest = x[..., :half], x[..., half:ROPE_DIM], x[..., ROPE_DIM:]
    rot = jnp.concatenate([x1 * cos - x2 * sin, x2 * cos + x1 * sin], axis=-1).astype(x.dtype)
    return jnp.concatenate([rot, rest], axis=-1)


def ssd_chunked_scan(xs, dt, a, bm, cm):
    bsz, length, g, hg, p = xs.shape
    n = bm.shape[-1]
    q = SSD_CHUNK
    nc = length // q
    xd = (xs * dt[..., None]).reshape(bsz, nc, q, g, hg, p)
    a_cs = jnp.cumsum((dt * a).astype(jnp.float32).reshape(bsz, nc, q, g, hg), axis=2)
    bm = bm.reshape(bsz, nc, q, g, n)
    cm = cm.reshape(bsz, nc, q, g, n)
    seg = a_cs[:, :, :, None] - a_cs[:, :, None, :]
    causal = jnp.tril(jnp.ones((q, q), bool))[:, :, None, None]
    decay = jnp.exp(jnp.where(causal, seg, -jnp.inf))
    cb = jnp.einsum('bcign,bcjgn->bcijg', cm, bm)
    y_diag = jnp.einsum('bcijgh,bcjghp->bcighp', cb[..., None] * decay, xd)
    decay_to_end = jnp.exp(a_cs[:, :, -1:] - a_cs)
    states = jnp.einsum('bcjgn,bcjgh,bcjghp->bcghpn', bm, decay_to_end, xd)
    chunk_decay = jnp.exp(a_cs[:, :, -1])

    def step(h, inp):
        s, d = inp
        return h * d[..., None, None] + s, h

    h0 = jnp.zeros_like(states[:, 0])
    _, prev = lax.scan(step, h0, (jnp.moveaxis(states, 1, 0), jnp.moveaxis(chunk_decay, 1, 0)))
    prev = jnp.moveaxis(prev, 0, 1)
    y_off = jnp.einsum('bcign,bcghpn,bcigh->bcighp', cm, prev, jnp.exp(a_cs))
    return (y_diag + y_off).reshape(bsz, length, g, hg, p)


def gla_chunked(q, k, v, g):
    bsz, length, h, dk = q.shape
    dv = v.shape[-1]
    qs = GLA_CHUNK
    nc = length // qs

    def to_chunks(t):
        return jnp.moveaxis(t.reshape((bsz, nc, qs) + t.shape[2:]), 1, 0)

    gc = jnp.cumsum(to_chunks(g.astype(jnp.float32)), axis=2)
    causal = jnp.tril(jnp.ones((qs, qs), bool))[:, :, None, None]

    def step(s_state, inp):
        qi, ki, vi, gi = inp
        rel = gi[:, :, None] - gi[:, None, :]
        wdec = jnp.exp(jnp.where(causal, rel, -jnp.inf))
        scores = jnp.einsum('bihd,bjhd,bijhd->bhij', qi, ki, wdec)
        o = jnp.einsum('bhij,bjhv->bihv', scores, vi) + jnp.einsum('bihd,bhdv->bihv', qi * jnp.exp(gi), s_state)
        g_last = gi[:, -1]
        s_state = s_state * jnp.exp(g_last)[..., None] + jnp.einsum('bjhd,bjhv->bhdv', ki * jnp.exp(g_last[:, None] - gi), vi)
        return s_state, o

    s0 = jnp.zeros((bsz, h, dk, dv), jnp.float32)
    _, o = lax.scan(step, s0, (to_chunks(q), to_chunks(k), to_chunks(v), gc))
    return jnp.moveaxis(o, 0, 1).reshape(bsz, length, h, dv)


def ssd_gla_mixer(x, w_in, conv_w, conv_b, dt_bias, a_log, d_skip, ssd_norm_w, gate_w2, gate_b, gla_norm_w, w_out):
    bsz, length, _ = x.shape
    u = x @ w_in
    z, xbc, dt_raw, q, k, v, g_lr, r = jnp.split(u, _split_points(HYB_SIZES), axis=-1)
    xbc = jax.nn.silu(causal_depthwise_conv(xbc, conv_w, conv_b))
    xs, bm, cm = jnp.split(xbc, [SSD_D_INNER, SSD_D_INNER + SSD_GROUPS * SSD_STATE], axis=-1)
    xs = xs.reshape(bsz, length, SSD_GROUPS, SSD_HPG, SSD_HEAD_DIM)
    bm = bm.reshape(bsz, length, SSD_GROUPS, SSD_STATE)
    cm = cm.reshape(bsz, length, SSD_GROUPS, SSD_STATE)
    dt = jax.nn.softplus((dt_raw + dt_bias).astype(jnp.float32)).reshape(bsz, length, SSD_GROUPS, SSD_HPG)
    a = -jnp.exp(a_log.astype(jnp.float32)).reshape(SSD_GROUPS, SSD_HPG)
    pad = SSD_CHUNK - N_META
    y = ssd_chunked_scan(_pad_front(xs, pad), _pad_front(dt, pad), a, _pad_front(bm, pad), _pad_front(cm, pad))[:, pad:]
    y = y + xs * d_skip.reshape(SSD_GROUPS, SSD_HPG, 1)
    y = y.reshape(bsz, length, SSD_D_INNER).astype(x.dtype)
    y_ssd = rms_norm_groups(y * jax.nn.silu(z), ssd_norm_w, SSD_D_INNER // SSD_GROUPS)
    gk = jax.nn.log_sigmoid((g_lr @ gate_w2 + gate_b).astype(jnp.float32)) / GLA_GATE_TAU
    shp_k = (bsz, length, GLA_HEADS, GLA_HEAD_DK)
    qh = q.reshape(shp_k) * (GLA_HEAD_DK ** -0.5)
    kh = k.reshape(shp_k)
    vh = v.reshape(bsz, length, GLA_HEADS, GLA_HEAD_DV)
    gh = gk.reshape(shp_k)
    pad = GLA_CHUNK - N_META
    o = gla_chunked(_pad_front(qh, pad), _pad_front(kh, pad), _pad_front(vh, pad), _pad_front(gh, pad))[:, pad:]
    o = rms_norm_groups(o.reshape(bsz, length, GLA_DV).astype(x.dtype), gla_norm_w, GLA_HEAD_DV)
    y_gla = o * jax.nn.silu(r)
    return jnp.concatenate([y_ssd, y_gla], axis=-1) @ w_out


def swa_with_sinks(q, k, v, sinks):
    bsz, length = q.shape[:2]
    w = SWA_WINDOW
    nb = (length - N_META) // w
    scale = SWA_HEAD_DIM ** -0.5
    q = q.reshape(bsz, length, SWA_KV_HEADS, SWA_GROUP, SWA_HEAD_DIM)
    sink = sinks.astype(jnp.float32).reshape(SWA_KV_HEADS, SWA_GROUP)
    qm, km, vm = q[:, :N_META], k[:, :N_META], v[:, :N_META]
    s_mm = jnp.einsum('bqkgd,bskd->bkgqs', qm, km).astype(jnp.float32) * scale
    s_mm = jnp.where(jnp.tril(jnp.ones((N_META, N_META), bool)), s_mm, -jnp.inf)
    sink_m = jnp.broadcast_to(sink[None, :, :, None, None], s_mm.shape[:-1] + (1,))
    p_mm = jax.nn.softmax(jnp.concatenate([s_mm, sink_m], axis=-1), axis=-1)[..., :N_META]
    o_meta = jnp.einsum('bkgqs,bskd->bqkgd', p_mm, vm).reshape(bsz, N_META, SWA_Q_DIM)
    qb = q[:, N_META:].reshape(bsz, nb, w, SWA_KV_HEADS, SWA_GROUP, SWA_HEAD_DIM)
    kb = k[:, N_META:].reshape(bsz, nb, w, SWA_KV_HEADS, SWA_HEAD_DIM)
    vb = v[:, N_META:].reshape(bsz, nb, w, SWA_KV_HEADS, SWA_HEAD_DIM)

    def with_prev(t):
        prev = jnp.pad(t, ((0, 0), (1, 0), (0, 0), (0, 0), (0, 0)))[:, :-1]
        return jnp.concatenate([prev, t], axis=2)

    kw, vw = with_prev(kb), with_prev(vb)
    i = jnp.arange(w)[:, None]
    j = jnp.arange(2 * w)[None, :]
    band = (j > i) & (j <= i + w)
    first_ok = (jnp.arange(nb)[:, None, None] > 0) | (j >= w)[None]
    mask = (band[None] & first_ok)[None, :, None, None]
    s_w = jnp.einsum('bnqkgd,bnskd->bnkgqs', qb, kw).astype(jnp.float32) * scale
    s_w = jnp.where(mask, s_w, -jnp.inf)
    s_m = jnp.einsum('bnqkgd,bmkd->bnkgqm', qb, km).astype(jnp.float32) * scale
    sink_b = jnp.broadcast_to(sink[None, None, :, :, None, None], s_m.shape[:-1] + (1,))
    p = jax.nn.softmax(jnp.concatenate([s_m, s_w, sink_b], axis=-1), axis=-1)
    o = (jnp.einsum('bnkgqm,bmkd->bnqkgd', p[..., :N_META], vm)
         + jnp.einsum('bnkgqs,bnskd->bnqkgd', p[..., N_META:N_META + 2 * w], vw))
    o_real = o.reshape(bsz, nb * w, SWA_Q_DIM)
    return jnp.concatenate([o_meta, o_real], axis=1).astype(q.dtype)


def swa_mixer(x, w_qkv, sinks, w_out):
    bsz, length, _ = x.shape
    q, k, v = jnp.split(x @ w_qkv, [SWA_Q_DIM, SWA_Q_DIM + SWA_KV_DIM], axis=-1)
    pos = jnp.arange(length, dtype=jnp.int32)
    q = partial_rotary(q.reshape(bsz, length, SWA_Q_HEADS, SWA_HEAD_DIM), pos)
    k = partial_rotary(k.reshape(bsz, length, SWA_KV_HEADS, SWA_HEAD_DIM), pos)
    v = v.reshape(bsz, length, SWA_KV_HEADS, SWA_HEAD_DIM)
    return swa_with_sinks(q, k, v, sinks) @ w_out


def conv_glu_ffn(x, w_up, conv_w, conv_b, w_down):
    h = causal_depthwise_conv(x @ w_up, conv_w, conv_b)
    gate, val = jnp.split(h, 2, axis=-1)
    return (jax.nn.silu(gate) * val) @ w_down


def setup_inputs(seed: int = 0) -> dict:
    key = jax.random.key(seed)
    ks = jax.random.split(key, 24)

    def nrm(k, shape, s):
        return s * jax.random.normal(k, shape, jnp.float32)

    dt0 = jnp.exp(jax.random.uniform(ks[5], (N_EVEN, SSD_HEADS), jnp.float32, math.log(SSD_DT_MIN), math.log(SSD_DT_MAX)))
    return {
        'x': nrm(ks[0], (BATCH, SEQ, D_MODEL), 1.0),
        'meta_tokens': nrm(ks[1], (N_META, D_MODEL), 1.0),
        'hyb_w_in': nrm(ks[2], (N_EVEN, D_MODEL, HYB_IN_COLS), D_MODEL ** -0.5),
        'hyb_conv_w': nrm(ks[3], (N_EVEN, SSD_CONV, SSD_CONV_DIM), SSD_CONV ** -0.5),
        'hyb_conv_b': nrm(ks[4], (N_EVEN, SSD_CONV_DIM), 0.02),
        'ssd_dt_bias': dt0 + jnp.log(-jnp.expm1(-dt0)),
        'ssd_a_log': jnp.log(jax.random.uniform(ks[6], (N_EVEN, SSD_HEADS), jnp.float32, 1.0, 16.0)),
        'ssd_d': 1.0 + nrm(ks[7], (N_EVEN, SSD_HEADS), 0.1),
        'ssd_norm_w': 1.0 + nrm(ks[8], (N_EVEN, SSD_D_INNER), 0.05),
        'gla_gate_w2': nrm(ks[9], (N_EVEN, GLA_GATE_RANK, GLA_DK), GLA_GATE_RANK ** -0.5),
        'gla_gate_b': nrm(ks[10], (N_EVEN, GLA_DK), 0.1),
        'gla_norm_w': 1.0 + nrm(ks[11], (N_EVEN, GLA_DV), 0.05),
        'hyb_w_out': nrm(ks[12], (N_EVEN, HYB_MIX_WIDTH, D_MODEL), HYB_MIX_WIDTH ** -0.5 * DEEPNORM_BETA),
        'swa_w_qkv': nrm(ks[13], (N_ODD, D_MODEL, SWA_QKV_COLS), D_MODEL ** -0.5),
        'swa_sinks': nrm(ks[14], (N_ODD, SWA_Q_HEADS), 0.5),
        'swa_w_out': nrm(ks[15], (N_ODD, SWA_Q_DIM, D_MODEL), SWA_Q_DIM ** -0.5 * DEEPNORM_BETA),
        'ffn_w_up': nrm(ks[16], (DEPTH, D_MODEL, 2 * D_FF), D_MODEL ** -0.5),
        'ffn_conv_w': nrm(ks[17], (DEPTH, FFN_CONV, 2 * D_FF), FFN_CONV ** -0.5),
        'ffn_conv_b': nrm(ks[18], (DEPTH, 2 * D_FF), 0.02),
        'ffn_w_down': nrm(ks[19], (DEPTH, D_FF, D_MODEL), D_FF ** -0.5 * DEEPNORM_BETA),
        'ln_mix_g': 1.0 + nrm(ks[20], (DEPTH, D_MODEL), 0.05),
        'ln_mix_b': nrm(ks[21], (DEPTH, D_MODEL), 0.02),
        'ln_ffn_g': 1.0 + nrm(ks[22], (DEPTH, D_MODEL), 0.05),
        'ln_ffn_b': nrm(ks[23], (DEPTH, D_MODEL), 0.02),
    }


def reference(x, meta_tokens, hyb_w_in, hyb_conv_w, hyb_conv_b, ssd_dt_bias, ssd_a_log, ssd_d, ssd_norm_w,
              gla_gate_w2, gla_gate_b, gla_norm_w, hyb_w_out, swa_w_qkv, swa_sinks, swa_w_out,
              ffn_w_up, ffn_conv_w, ffn_conv_b, ffn_w_down, ln_mix_g, ln_mix_b, ln_ffn_g, ln_ffn_b):
    bsz = x.shape[0]
    meta = jnp.broadcast_to(meta_tokens.astype(x.dtype)[None], (bsz, N_META, D_MODEL))
    h = jnp.concatenate([meta, x], axis=1)
    for layer in range(DEPTH):
        j = layer // 2
        if layer % 2 == 0:
            mix = ssd_gla_mixer(h, hyb_w_in[j], hyb_conv_w[j], hyb_conv_b[j], ssd_dt_bias[j], ssd_a_log[j], ssd_d[j],
                                ssd_norm_w[j], gla_gate_w2[j], gla_gate_b[j], gla_norm_w[j], hyb_w_out[j])
        else:
            mix = swa_mixer(h, swa_w_qkv[j], swa_sinks[j], swa_w_out[j])
        h = layer_norm(DEEPNORM_ALPHA * h + mix, ln_mix_g[layer], ln_mix_b[layer])
        ffn = conv_glu_ffn(h, ffn_w_up[layer], ffn_conv_w[layer], ffn_conv_b[layer], ffn_w_down[layer])
        h = layer_norm(DEEPNORM_ALPHA * h + ffn, ln_ffn_g[layer], ln_ffn_b[layer])
    return h[:, N_META:]
```

```cpp
#include <hip/hip_runtime.h>
#include <hip/hip_cooperative_groups.h>
#include <cstdio>
#include <cmath>
namespace cg = cooperative_groups;
#ifndef PER_PHASE_LAUNCH
#define PER_PHASE_LAUNCH 1
#endif
__device__ __forceinline__ int tidx() { int t = threadIdx.x; asm volatile("" : "+v"(t)); return t; }
__device__ __forceinline__ int bidx() { int b = blockIdx.x; asm volatile("" : "+s"(b)); return b; }
namespace pg8 {
#define PG8_LAS __attribute__((address_space(3)))
typedef unsigned short bf16_t;
typedef short bf16x8 __attribute__((ext_vector_type(8)));
typedef float f32x4 __attribute__((ext_vector_type(4)));
typedef unsigned u32x4 __attribute__((ext_vector_type(4)));
constexpr int BM = 256, BK = 64, HALF = 128, HTB = HALF * BK * 2  , STAGE_BYTES = 8 * HTB, NXCD = 8, WGM = 8;

__host__ __device__ __forceinline__ int lds_byte(int r, int c) { const int st = (r >> 4) * 2 + (c >> 5), rr = r & 15, cc = c & 31, ob = rr * 64 + cc * 2; return st * 1024 + (ob ^ (((ob >> 9) & 1) << 5)); }
__host__ __device__ __forceinline__ void stage_rc(int b, int& R, int& C) { const int st = b / 1024, sb = b % 1024, swz = sb ^ (((sb >> 9) & 1) << 5); R = (st >> 1) * 16 + swz / 64; C = (st & 1) * 32 + (swz % 64) / 2; }
__host__ __device__ __forceinline__ int perm32(int rho) { const int n = rho >> 4, i = rho & 15; return 8 * (i >> 2) + 4 * n + (i & 3); }

struct Unit { int pm, pn; };
struct Gemm { const bf16_t* A; const bf16_t* Bt; int M, N, K; };

struct StaticOrder {
    int nM, nN, nwg, G, c;
    __host__ __device__ void init(int M, int N, int G_, int c_) { nM = M / BM; nN = N / BM; nwg = nM * nN; G = G_; c = c_; }
    __host__ __device__ bool next(int i, Unit& u) const {
        const long L = (long)i * G + c; if (L >= nwg) return false;
        int wgid = (int)L; { const int q = nwg / NXCD, r = nwg % NXCD, xcd = wgid % NXCD, off = wgid / NXCD; wgid = (xcd < r ? xcd * (q + 1) : r * (q + 1) + (xcd - r) * q) + off; }
        const int nig = WGM * nN, gid = wgid / nig, fm = gid * WGM, gsz = (nM - fm) < WGM ? (nM - fm) : WGM;
        u.pm = fm + ((wgid % nig) % gsz); u.pn = (wgid % nig) / gsz; return true;
    }
    __device__ __forceinline__ void a_ready(const Unit&) const {}
    __device__ __forceinline__ void done(const Unit&) const {}
};
__device__ __forceinline__ unsigned cvt_pk_bf16(float lo, float hi) { unsigned r; asm volatile("v_cvt_pk_bf16_f32 %0, %1, %2" : "=v"(r) : "v"(lo), "v"(hi)); return r; }
typedef float f32x2 __attribute__((ext_vector_type(2)));

template <class Epi, class Sched, bool STAMP = false>
__device__ __forceinline__ void gemm_phase(PG8_LAS unsigned char* lds, const Gemm g, const Sched& S, const Epi& E, unsigned long long* stamps) {
    const int tid = tidx(), wid = __builtin_amdgcn_readfirstlane(tid >> 6), lane = tid & 63, wr = wid >> 2, wc = wid & 3, fr = lane & 15, fq = lane >> 4;
    const int K = g.K, nt = K / BK;
    int ts_lo = 0, ts_hi = 0, nts = 0; const unsigned long long rt_entry = STAMP ? (unsigned long long)wall_clock64() : 0ull;
#define PG8_STAMP() do { if (STAMP && wid == 0 && nts < 64) { const unsigned long long _c = (unsigned long long)clock64(); \
        ts_lo = (lane == nts) ? (int)(unsigned)_c : ts_lo; ts_hi = (lane == nts) ? (int)(unsigned)(_c >> 32) : ts_hi; ++nts; } } while (0)
    PG8_STAMP();
    unsigned voffA[2], voffB[2];
#pragma unroll
    for (int i = 0; i < 2; ++i) { int R, C; stage_rc(tid * 16 + i * 8192, R, C); const int Rb = Epi::PERM ? ((R & ~31) + perm32(R & 31)) : R;
        voffA[i] = (unsigned)(R * K + C) * 2u; voffB[i] = (unsigned)(Rb * K + C) * 2u; }
    const size_t kstep = (size_t)(BK * 2);
    const size_t hstep = (size_t)HALF * K * 2;
    const size_t tstep = 2 * hstep;
    const unsigned ldsw = (unsigned)wid * 1024u;
    const int aoff = lds_byte(wr * 64 + fr, fq * 8), boff = lds_byte(wc * 32 + fr, fq * 8);
#define PG8_SA(b, h) (((b) * 2 + (h)) * HTB)
#define PG8_SB(b, h) ((4 + (b) * 2 + (h)) * HTB)
#define PG8_STAGE(bufoff, gbase, voff) do { _Pragma("unroll") for (int _i = 0; _i < 2; ++_i) \
        __builtin_amdgcn_global_load_lds((const unsigned*)((const char*)(gbase) + (voff)[_i]), (PG8_LAS unsigned*)(lds + (bufoff) + ldsw + _i * 8192), 16, 0, 0); } while (0)
#define PG8_LDA(dst, b, h) do { _Pragma("unroll") for (int m = 0; m < 4; ++m) _Pragma("unroll") for (int k = 0; k < 2; ++k) dst[m][k] = *(const PG8_LAS bf16x8*)(lds + PG8_SA(b, h) + aoff + m * 2048 + k * 1024); } while (0)
#define PG8_LDB(dst, b, h) do { _Pragma("unroll") for (int n = 0; n < 2; ++n) _Pragma("unroll") for (int k = 0; k < 2; ++k) dst[n][k] = *(const PG8_LAS bf16x8*)(lds + PG8_SB(b, h) + boff + n * 2048 + k * 1024); } while (0)
#define PG8_MMA(ai, bj, At, Bt) do { __builtin_amdgcn_s_setprio(1); _Pragma("unroll") for (int m = 0; m < 4; ++m) _Pragma("unroll") for (int n = 0; n < 2; ++n) _Pragma("unroll") for (int k = 0; k < 2; ++k) \
        acc[ai][bj][m][n] = __builtin_amdgcn_mfma_f32_16x16x32_bf16(Bt[n][k], At[m][k], acc[ai][bj][m][n], 0, 0, 0); __builtin_amdgcn_s_setprio(0); } while (0)
#define PG8_WAIT_V(n) asm volatile("s_waitcnt vmcnt(" #n ")" ::: "memory")
#define PG8_WAIT_L(n) asm volatile("s_waitcnt lgkmcnt(" #n ")" ::: "memory")
#define PG8_BAR __builtin_amdgcn_s_barrier()
#define PG8_SCHED __builtin_amdgcn_sched_barrier(0)
    Unit cur, nxt; int ui = 0;
    if (!S.next(0, cur)) return;
    f32x4 acc[2][2][4][2];
#pragma unroll
    for (int a = 0; a < 2; ++a)
#pragma unroll
        for (int b = 0; b < 2; ++b)
#pragma unroll
            for (int m = 0; m < 4; ++m)
#pragma unroll
                for (int n = 0; n < 2; ++n) acc[a][b][m][n] = (f32x4){0.f, 0.f, 0.f, 0.f};
    bf16x8 At[4][2], B0[2][2], B1[2][2];
    const char* cA = (const char*)g.A + (size_t)cur.pm * tstep; const char* cB = (const char*)g.Bt + (size_t)cur.pn * tstep;
    S.a_ready(cur);
    PG8_STAGE(PG8_SB(0, 0), cB, voffB); PG8_STAGE(PG8_SA(0, 0), cA, voffA); PG8_STAGE(PG8_SB(0, 1), cB + hstep, voffB); PG8_STAGE(PG8_SA(0, 1), cA + hstep, voffA);
    if (wr == 1) PG8_BAR;
    PG8_WAIT_V(4); PG8_BAR;
    PG8_STAGE(PG8_SB(1, 0), cB + kstep, voffB); PG8_STAGE(PG8_SA(1, 0), cA + kstep, voffA); PG8_STAGE(PG8_SB(1, 1), cB + hstep + kstep, voffB);
    PG8_WAIT_V(6); PG8_BAR;
    PG8_STAMP();
    for (;;) {
        const bool has_next = S.next(ui + 1, nxt);
        const char* nA = has_next ? (const char*)g.A + (size_t)nxt.pm * tstep : cA; const char* nB = has_next ? (const char*)g.Bt + (size_t)nxt.pn * tstep : cB;
        for (int t = 0; t < nt; t += 2) {
            const bool last = (t == nt - 2);
            const char* a1 = cA + (size_t)(t + 1) * kstep;
            const char* a2 = last ? nA : cA + (size_t)(t + 2) * kstep; const char* b2 = last ? nB : cB + (size_t)(t + 2) * kstep;
            const char* a3 = a2 + kstep; const char* b3 = b2 + kstep;
            if (last && has_next) S.a_ready(nxt);
            PG8_LDB(B0, 0, 0); PG8_SCHED; PG8_LDA(At, 0, 0); PG8_STAGE(PG8_SA(1, 1), a1 + hstep, voffA);
            PG8_WAIT_L(8); PG8_BAR; PG8_WAIT_L(0); PG8_MMA(0, 0, At, B0); PG8_BAR; PG8_SCHED;
            PG8_LDB(B1, 0, 1); PG8_STAGE(PG8_SB(0, 0), b2, voffB);
            PG8_BAR; PG8_WAIT_L(0); PG8_MMA(0, 1, At, B1); PG8_BAR;
            PG8_LDA(At, 0, 1); PG8_STAGE(PG8_SA(0, 0), a2, voffA);
            PG8_BAR; PG8_WAIT_L(0); PG8_MMA(1, 0, At, B0); PG8_BAR; PG8_SCHED;
            PG8_STAGE(PG8_SB(0, 1), b2 + hstep, voffB);
            PG8_WAIT_V(6); PG8_BAR; PG8_MMA(1, 1, At, B1); PG8_BAR;
            PG8_LDB(B0, 1, 0); PG8_SCHED; PG8_LDA(At, 1, 0); PG8_STAGE(PG8_SA(0, 1), a2 + hstep, voffA);
            PG8_WAIT_L(8); PG8_BAR; PG8_WAIT_L(0); PG8_MMA(0, 0, At, B0); PG8_BAR; PG8_SCHED;
            PG8_LDB(B1, 1, 1); PG8_STAGE(PG8_SB(1, 0), b3, voffB);
            PG8_BAR; PG8_WAIT_L(0); PG8_MMA(0, 1, At, B1); PG8_BAR;
            PG8_LDA(At, 1, 1); PG8_STAGE(PG8_SA(1, 0), a3, voffA);
            PG8_BAR; PG8_WAIT_L(0); PG8_MMA(1, 0, At, B0); PG8_BAR; PG8_SCHED;
            PG8_STAGE(PG8_SB(1, 1), b3 + hstep, voffB);
            PG8_WAIT_V(6); PG8_BAR; PG8_MMA(1, 1, At, B1); PG8_BAR;
        }
        PG8_STAMP();
        if constexpr (!Epi::AFTER_DRAIN) { E(acc, cur, wr, wc, fr, fq); S.done(cur); }
        PG8_STAMP();
        if (!has_next) break;
#pragma unroll
        for (int a = 0; a < 2; ++a)
#pragma unroll
            for (int b = 0; b < 2; ++b)
#pragma unroll
                for (int m = 0; m < 4; ++m)
#pragma unroll
                    for (int n = 0; n < 2; ++n) acc[a][b][m][n] = (f32x4){0.f, 0.f, 0.f, 0.f};
        cur = nxt; cA = nA; cB = nB; ++ui;
    }
    PG8_WAIT_V(0);
    if (wr == 0) PG8_BAR;
    PG8_BAR;
    if constexpr (Epi::AFTER_DRAIN) { E.fused(acc, cur, wr, wc, fr, fq, lds, wid, lane); S.done(cur); }
    PG8_STAMP();
    if (STAMP && wid == 0) { stamps[lane] = lane < nts ? (((unsigned long long)(unsigned)ts_hi << 32) | (unsigned)ts_lo) : 0ull;
        if (lane == 62) stamps[62] = rt_entry; if (lane == 63) stamps[63] = (unsigned long long)wall_clock64(); }
#undef PG8_STAMP
#undef PG8_SA
#undef PG8_SB
#undef PG8_STAGE
#undef PG8_LDA
#undef PG8_LDB
#undef PG8_MMA
#undef PG8_WAIT_V
#undef PG8_WAIT_L
#undef PG8_BAR
#undef PG8_SCHED
}
}
using pg8::bf16_t; using pg8::bf16x8; using pg8::f32x4; using pg8::u32x4;
#define LAS __attribute__((address_space(3)))
typedef unsigned u32x2 __attribute__((ext_vector_type(2)));

constexpr int L_TOK = 8208, DM = 2048;
constexpr int HYB_N = 12288, DFF = 5504, DFF2 = 11008, QKV_N = 3072;
constexpr int UZ = 0, UXBC = 2048, UQ = 6144, UK = 7168, UV = 8192, UR = 10240;
constexpr float ALPHA = 1.6817928305074292f;
constexpr int NTHREADS = 512;
constexpr int LDS_BYTES = 131072;

constexpr size_t al256(size_t x) { return (x + 255) & ~(size_t)255; }
constexpr size_t O_WT_HIN   = 0;
constexpr size_t O_WT_HSIDE = O_WT_HIN   + al256(2ull * 12288 * 2048 * 2);
constexpr size_t O_WT_HOUT  = O_WT_HSIDE + al256(2ull * 48 * 2048 * 2);
constexpr size_t O_WT_QKV   = O_WT_HOUT  + al256(2ull * 2048 * 4096 * 2);
constexpr size_t O_WT_SOUT  = O_WT_QKV   + al256(2ull * 3072 * 2048 * 2);
constexpr size_t O_WT_UP    = O_WT_SOUT  + al256(2ull * 2048 * 2048 * 2);
constexpr size_t O_WT_DOWN  = O_WT_UP    + al256(4ull * 11008 * 2048 * 2);
constexpr size_t O_H        = O_WT_DOWN  + al256(4ull * 2048 * 5504 * 2);
constexpr size_t O_HB       = O_H        + al256((size_t)L_TOK * 2048 * 4);
constexpr size_t O_U        = O_HB       + al256((size_t)L_TOK * 2048 * 2);
constexpr size_t O_R2       = O_U        + al256((size_t)L_TOK * 12288 * 2);
constexpr size_t GLA_ST_BYTES = 129ull * 4 * 512 * 256 * 2;
constexpr size_t O_MIX      = O_R2       + al256(2 * GLA_ST_BYTES);
constexpr size_t O_XC       = O_MIX      + al256((size_t)L_TOK * 5504 * 2);
constexpr size_t O_SIDE     = O_XC       + al256((size_t)L_TOK * 4096 * 2);
constexpr size_t O_DT       = O_SIDE     + al256((size_t)L_TOK * 48 * 4);
constexpr size_t O_ACS      = O_DT       + al256((size_t)L_TOK * 32 * 4);
constexpr size_t O_QT       = O_ACS      + al256((size_t)L_TOK * 32 * 4);
constexpr size_t O_KT       = O_QT       + al256((size_t)L_TOK * 1024 * 2);
constexpr size_t O_GLAST    = O_KT       + al256((size_t)L_TOK * 1024 * 2);
constexpr size_t O_CDEC     = O_GLAST    + al256(129ull * 1024 * 4);
constexpr size_t O_SSDLOC   = O_CDEC     + al256(65ull * 32 * 4);
constexpr size_t O_SSDPREV  = O_SSDLOC   + al256(65ull * 32 * 64 * 128 * 4);
constexpr size_t O_ROPE     = O_SSDPREV  + al256(65ull * 32 * 64 * 128 * 2);
constexpr size_t O_TAB      = O_ROPE     + al256((size_t)L_TOK * 16 * 4);
constexpr size_t WS_END     = O_TAB      + 256;
static_assert(WS_END <= 1442840576ull, "workspace too large");

struct Params {
    const float* in[24];
    float* out;
    unsigned char* ws;
    float inv_freq[8];
    int ph_lo, ph_hi;
};

struct Ctx { unsigned char* ws; float* out;
    __device__ __forceinline__ const float* in(int k) const { return ((const float* const*)(ws + O_TAB))[k]; } };

__device__ __forceinline__ bf16_t f2bf(float f) { unsigned u = __float_as_uint(f); u += 0x7FFFu + ((u >> 16) & 1u); return (bf16_t)(u >> 16); }
__device__ __forceinline__ float bf2f(bf16_t b) { return __uint_as_float(((unsigned)b) << 16); }
__device__ __forceinline__ unsigned pack2(float lo, float hi) { return (unsigned)f2bf(lo) | ((unsigned)f2bf(hi) << 16); }
__device__ __forceinline__ float bflo(unsigned w) { return __uint_as_float(w << 16); }
__device__ __forceinline__ float bfhi(unsigned w) { return __uint_as_float(w & 0xffff0000u); }
__device__ __forceinline__ float silu_f(float x) { return x / (1.f + __expf(-x)); }
__device__ __forceinline__ float wave_sum(float v) {
#pragma unroll
    for (int o = 32; o > 0; o >>= 1) v += __shfl_xor(v, o);
    return v;
}
__device__ __forceinline__ bf16x8 ldfrag(const LAS bf16_t* base, int ld, int row0, int k0, int lane) {
    return *(const LAS bf16x8*)(base + (row0 + (lane & 15)) * ld + k0 + 8 * (lane >> 4));
}
__device__ __forceinline__ bf16x8 gfrag(const bf16_t* base, size_t ld, int row0, int k0, int lane) {
    return *(const bf16x8*)(base + (size_t)(row0 + (lane & 15)) * ld + k0 + 8 * (lane >> 4));
}
#define MFMA16(a, b, c) __builtin_amdgcn_mfma_f32_16x16x32_bf16((a), (b), (c), 0, 0, 0)
#define LDS_FENCE() asm volatile("s_waitcnt lgkmcnt(0)" ::: "memory")

struct EpiStoreBf16 {
    static constexpr bool PERM = true, AFTER_DRAIN = false;
    bf16_t* O; int ldc;
    __device__ __forceinline__ void operator()(const f32x4 (&acc)[2][2][4][2], const pg8::Unit& u, int wr, int wc, int fr, int fq) const {
        const int row0 = u.pm * 256 + wr * 64 + fr, col0 = u.pn * 256 + wc * 32 + 8 * fq;
#pragma unroll
        for (int ai = 0; ai < 2; ++ai)
#pragma unroll
            for (int m = 0; m < 4; ++m) { bf16_t* rowp = O + (size_t)(row0 + ai * 128 + m * 16) * ldc + col0;
#pragma unroll
                for (int bj = 0; bj < 2; ++bj) { const f32x4 v0 = acc[ai][bj][m][0], v1 = acc[ai][bj][m][1];
                    u32x4 w; w.x = pg8::cvt_pk_bf16(v0[0], v0[1]); w.y = pg8::cvt_pk_bf16(v0[2], v0[3]); w.z = pg8::cvt_pk_bf16(v1[0], v1[1]); w.w = pg8::cvt_pk_bf16(v1[2], v1[3]);
                    *(u32x4*)(rowp + bj * 128) = w; } }
    }
    __device__ __forceinline__ void meta(int row, int col, f32x4 v) const {
        u32x2 w; w.x = pg8::cvt_pk_bf16(v[0], v[1]); w.y = pg8::cvt_pk_bf16(v[2], v[3]);
        *(u32x2*)(O + (size_t)row * ldc + col) = w;
    }
};
struct EpiResF32 {
    static constexpr bool PERM = false, AFTER_DRAIN = false;
    float* H;
    __device__ __forceinline__ void operator()(const f32x4 (&acc)[2][2][4][2], const pg8::Unit& u, int wr, int wc, int fr, int fq) const {
        const int row0 = u.pm * 256 + wr * 64 + fr, col0 = u.pn * 256 + wc * 32 + 4 * fq;
#pragma unroll
        for (int ai = 0; ai < 2; ++ai)
#pragma unroll
            for (int m = 0; m < 4; ++m) { float* rowp = H + (size_t)(row0 + ai * 128 + m * 16) * DM + col0;
#pragma unroll
                for (int bj = 0; bj < 2; ++bj)
#pragma unroll
                    for (int n = 0; n < 2; ++n) { f32x4* q = (f32x4*)(rowp + bj * 128 + n * 16); const f32x4 hv = *q; *q = hv * ALPHA + acc[ai][bj][m][n]; } }
    }
    __device__ __forceinline__ void meta(int row, int col, f32x4 v) const {
        f32x4* q = (f32x4*)(H + (size_t)row * DM + col); const f32x4 hv = *q; *q = hv * ALPHA + v;
    }
};
__device__ __forceinline__ f32x4 wave_gemm16(const bf16_t* A, const bf16_t* Bt, int K, int lane) {
    f32x4 acc = {0.f, 0.f, 0.f, 0.f};
    const bf16_t* pa = A + (size_t)(lane & 15) * K + 8 * (lane >> 4);
    const bf16_t* pb = Bt + (size_t)(lane & 15) * K + 8 * (lane >> 4);
#pragma unroll 4
    for (int k0 = 0; k0 < K; k0 += 32) {
        const bf16x8 a = *(const bf16x8*)(pa + k0), b = *(const bf16x8*)(pb + k0);
        acc = MFMA16(b, a, acc);
    }
    return acc;
}
template <class Epi>
__device__ __forceinline__ void gemm_full(LAS unsigned char* lds, const bf16_t* A, const bf16_t* Bt, int N, int K, const Epi& Emeta, const Epi& Emain) {
    const int lane = tidx() & 63, wid = tidx() >> 6;
    for (int tile = bidx() * 8 + wid; tile < N / 16; tile += gridDim.x * 8) {
        const f32x4 acc = wave_gemm16(A, Bt + (size_t)tile * 16 * K, K, lane);
        Emeta.meta(lane & 15, tile * 16 + 4 * (lane >> 4), acc);
    }
    pg8::Gemm g{A + (size_t)16 * K, Bt, 8192, N, K};
    pg8::StaticOrder S; S.init(8192, N, (int)gridDim.x, (int)bidx());
    pg8::gemm_phase<Epi, pg8::StaticOrder, false>(lds, g, S, Emain, nullptr);
    __syncthreads();
}
struct TJob { const float* src; int ld, ncols, K; bf16_t* dst; };
__device__ __forceinline__ TJob get_job(const Params& p, int j) {
    TJob J;
    bf16_t* ws16 = (bf16_t*)p.ws;
    if (j < 10) {
        const int jj = j / 5, sub = j % 5;
        const float* base = p.in[2] + (size_t)jj * 2048 * 12336;
        bf16_t* wmain = (bf16_t*)(p.ws + O_WT_HIN) + (size_t)jj * 12288 * 2048;
        bf16_t* wside = (bf16_t*)(p.ws + O_WT_HSIDE) + (size_t)jj * 48 * 2048;
        J.ld = 12336; J.K = 2048;
        if (sub == 0)      { J.src = base;          J.ncols = 6144; J.dst = wmain; }
        else if (sub == 1) { J.src = base + 6176;   J.ncols = 4096; J.dst = wmain + (size_t)6144 * 2048; }
        else if (sub == 2) { J.src = base + 10288;  J.ncols = 2048; J.dst = wmain + (size_t)10240 * 2048; }
        else if (sub == 3) { J.src = base + 6144;   J.ncols = 32;   J.dst = wside; }
        else               { J.src = base + 10272;  J.ncols = 16;   J.dst = wside + (size_t)32 * 2048; }
    } else if (j < 12) { const int jj = j - 10; J.src = p.in[12] + (size_t)jj * 4096 * 2048; J.ld = 2048; J.ncols = 2048; J.K = 4096; J.dst = (bf16_t*)(p.ws + O_WT_HOUT) + (size_t)jj * 2048 * 4096; }
    else if (j < 14) { const int jj = j - 12; J.src = p.in[13] + (size_t)jj * 2048 * 3072; J.ld = 3072; J.ncols = 3072; J.K = 2048; J.dst = (bf16_t*)(p.ws + O_WT_QKV) + (size_t)jj * 3072 * 2048; }
    else if (j < 16) { const int jj = j - 14; J.src = p.in[15] + (size_t)jj * 2048 * 2048; J.ld = 2048; J.ncols = 2048; J.K = 2048; J.dst = (bf16_t*)(p.ws + O_WT_SOUT) + (size_t)jj * 2048 * 2048; }
    else if (j < 20) { const int l = j - 16; J.src = p.in[16] + (size_t)l * 2048 * 11008; J.ld = 11008; J.ncols = 11008; J.K = 2048; J.dst = (bf16_t*)(p.ws + O_WT_UP) + (size_t)l * 11008 * 2048; }
    else { const int l = j - 20; J.src = p.in[19] + (size_t)l * 5504 * 2048; J.ld = 2048; J.ncols = 2048; J.K = 5504; J.dst = (bf16_t*)(p.ws + O_WT_DOWN) + (size_t)l * 2048 * 5504; }
    (void)ws16;
    return J;
}
__device__ __forceinline__ void phase_prep(const Params& p, LAS unsigned char* lds) {
    const int tid = tidx();
    LAS float* ts = (LAS float*)lds;
    for (int j = 0; j < 24; ++j) {
        const TJob J = get_job(p, j);
        const int tn = (J.ncols + 63) / 64, tk = J.K / 64;
        for (int tile = bidx(); tile < tn * tk; tile += gridDim.x) {
            const int kb = tile / tn, nb = tile % tn;
            __syncthreads();
#pragma unroll
            for (int i = 0; i < 2; ++i) {
                const int r = (tid >> 4) + 32 * i, c4 = (tid & 15) * 4, n = nb * 64 + c4;
                if (n < J.ncols) {
                    const float4 v = *(const float4*)(J.src + (size_t)(kb * 64 + r) * J.ld + n);
                    ts[r * 65 + c4] = v.x; ts[r * 65 + c4 + 1] = v.y; ts[r * 65 + c4 + 2] = v.z; ts[r * 65 + c4 + 3] = v.w;
                }
            }
            __syncthreads();
            const int n = tid >> 3, kc = tid & 7;
            if (nb * 64 + n < J.ncols) {
                u32x4 w;
                w.x = pack2(ts[(kc * 8 + 0) * 65 + n], ts[(kc * 8 + 1) * 65 + n]);
                w.y = pack2(ts[(kc * 8 + 2) * 65 + n], ts[(kc * 8 + 3) * 65 + n]);
                w.z = pack2(ts[(kc * 8 + 4) * 65 + n], ts[(kc * 8 + 5) * 65 + n]);
                w.w = pack2(ts[(kc * 8 + 6) * 65 + n], ts[(kc * 8 + 7) * 65 + n]);
                *(u32x4*)(J.dst + (size_t)(nb * 64 + n) * J.K + kb * 64 + kc * 8) = w;
            }
        }
    }
    __syncthreads();
    const size_t gtid = (size_t)bidx() * NTHREADS + tid, gn = (size_t)gridDim.x * NTHREADS;
    float* h = (float*)(p.ws + O_H); bf16_t* hb = (bf16_t*)(p.ws + O_HB);
    for (size_t i = gtid; i < (size_t)L_TOK * 512; i += gn) {
        const int row = (int)(i >> 9), c4 = (int)(i & 511) * 4;
        const float4 v = row < 16 ? *(const float4*)(p.in[1] + (size_t)row * DM + c4) : *(const float4*)(p.in[0] + (size_t)(row - 16) * DM + c4);
        *(float4*)(h + i * 4) = v;
        u32x2 w; w.x = pack2(v.x, v.y); w.y = pack2(v.z, v.w);
        *(u32x2*)(hb + i * 4) = w;
    }
    if (gtid < 24) ((const float**)(p.ws + O_TAB))[gtid] = p.in[gtid];
    float* rope = (float*)(p.ws + O_ROPE);
    for (size_t i = gtid; i < (size_t)L_TOK * 8; i += gn) {
        const int pos = (int)(i >> 3), f = (int)(i & 7);
        const float ang = (float)pos * p.inv_freq[f];
        double rev = (double)ang * 0.15915494309189535;
        rev -= rint(rev);
        rope[pos * 16 + f] = __builtin_amdgcn_cosf((float)rev);
        rope[pos * 16 + 8 + f] = __builtin_amdgcn_sinf((float)rev);
    }
}

__device__ __forceinline__ void phase_ln(const Ctx& p, const float* g, const float* b, bool last) {
    const int lane = tidx() & 63, wid = tidx() >> 6;
    float* h = (float*)(p.ws + O_H); bf16_t* hb = (bf16_t*)(p.ws + O_HB);
    for (int row = bidx() * 8 + wid; row < L_TOK; row += gridDim.x * 8) {
        float4 v[8]; float s = 0.f;
#pragma unroll
        for (int i = 0; i < 8; ++i) { v[i] = *(const float4*)(h + (size_t)row * DM + i * 256 + lane * 4); s += v[i].x + v[i].y + v[i].z + v[i].w; }
        const float mean = wave_sum(s) * (1.f / 2048.f);
        float q = 0.f;
#pragma unroll
        for (int i = 0; i < 8; ++i) { v[i].x -= mean; v[i].y -= mean; v[i].z -= mean; v[i].w -= mean; q += v[i].x * v[i].x + v[i].y * v[i].y + v[i].z * v[i].z + v[i].w * v[i].w; }
        const float rstd = rsqrtf(wave_sum(q) * (1.f / 2048.f) + 1e-5f);
#pragma unroll
        for (int i = 0; i < 8; ++i) {
            const int c = i * 256 + lane * 4;
            const float4 gg = *(const float4*)(g + c), bb = *(const float4*)(b + c);
            float4 y; y.x = v[i].x * rstd * gg.x + bb.x; y.y = v[i].y * rstd * gg.y + bb.y; y.z = v[i].z * rstd * gg.z + bb.z; y.w = v[i].w * rstd * gg.w + bb.w;
            if (last) { if (row >= 16) *(float4*)(p.out + (size_t)(row - 16) * DM + c) = y; }
            else { *(float4*)(h + (size_t)row * DM + c) = y; u32x2 w; w.x = pack2(y.x, y.y); w.y = pack2(y.z, y.w); *(u32x2*)(hb + (size_t)row * DM + c) = w; }
        }
    }
}

__device__ __forceinline__ void unpack8(const u32x4 w, float (&f)[8]) {
    f[0] = bflo(w.x); f[1] = bfhi(w.x); f[2] = bflo(w.y); f[3] = bfhi(w.y); f[4] = bflo(w.z); f[5] = bfhi(w.z); f[6] = bflo(w.w); f[7] = bfhi(w.w);
}
__device__ __forceinline__ void ld8f(const float* q, float (&f)[8]) {
    const float4 a = *(const float4*)q, b = *(const float4*)(q + 4);
    f[0] = a.x; f[1] = a.y; f[2] = a.z; f[3] = a.w; f[4] = b.x; f[5] = b.y; f[6] = b.z; f[7] = b.w;
}
__device__ __forceinline__ void phase_ffn_conv(const Ctx& p, int layer) {
    const bf16_t* up = (const bf16_t*)(p.ws + O_R2); bf16_t* act = (bf16_t*)(p.ws + O_MIX);
    const float* cw = p.in(17) + (size_t)layer * 3 * DFF2; const float* cb = p.in(18) + (size_t)layer * DFF2;
    const size_t gtid = (size_t)bidx() * NTHREADS + tidx(), gn = (size_t)gridDim.x * NTHREADS;
    for (size_t task = gtid; task < (size_t)1026 * 688; task += gn) {
        const int jb = (int)(task % 688), tb = (int)(task / 688), j0 = jb * 8, t0 = tb * 8;
        float wg[3][8], wv[3][8], bg[8], bv[8];
#pragma unroll
        for (int k = 0; k < 3; ++k) { ld8f(cw + (size_t)k * DFF2 + j0, wg[k]); ld8f(cw + (size_t)k * DFF2 + DFF + j0, wv[k]); }
        ld8f(cb + j0, bg); ld8f(cb + DFF + j0, bv);
        float g2[8], g1[8], v2[8], v1[8];
#pragma unroll
        for (int i = 0; i < 8; ++i) { g2[i] = g1[i] = v2[i] = v1[i] = 0.f; }
        if (t0 >= 2) { unpack8(*(const u32x4*)(up + (size_t)(t0 - 2) * DFF2 + j0), g2); unpack8(*(const u32x4*)(up + (size_t)(t0 - 2) * DFF2 + DFF + j0), v2); }
        if (t0 >= 1) { unpack8(*(const u32x4*)(up + (size_t)(t0 - 1) * DFF2 + j0), g1); unpack8(*(const u32x4*)(up + (size_t)(t0 - 1) * DFF2 + DFF + j0), v1); }
#pragma unroll
        for (int tt = 0; tt < 8; ++tt) {
            const int t = t0 + tt;
            float g0[8], v0[8], o[8];
            unpack8(*(const u32x4*)(up + (size_t)t * DFF2 + j0), g0); unpack8(*(const u32x4*)(up + (size_t)t * DFF2 + DFF + j0), v0);
#pragma unroll
            for (int i = 0; i < 8; ++i) {
                const float gg = bg[i] + wg[0][i] * g2[i] + wg[1][i] * g1[i] + wg[2][i] * g0[i];
                const float vv = bv[i] + wv[0][i] * v2[i] + wv[1][i] * v1[i] + wv[2][i] * v0[i];
                o[i] = silu_f(gg) * vv;
                g2[i] = g1[i]; g1[i] = g0[i]; v2[i] = v1[i]; v1[i] = v0[i];
            }
            u32x4 w; w.x = pack2(o[0], o[1]); w.y = pack2(o[2], o[3]); w.z = pack2(o[4], o[5]); w.w = pack2(o[6], o[7]);
            *(u32x4*)(act + (size_t)t * DFF + j0) = w;
        }
    }
}
__device__ __forceinline__ void phase_hyb_prep(const Ctx& p, int jj) {
    const bf16_t* u = (const bf16_t*)(p.ws + O_U);
    const float* side = (const float*)(p.ws + O_SIDE);
    const size_t gtid = (size_t)bidx() * NTHREADS + tidx(), gn = (size_t)gridDim.x * NTHREADS;
    {
        bf16_t* xc = (bf16_t*)(p.ws + O_XC);
        const float* cw = p.in(3) + (size_t)jj * 4 * 4096; const float* cb = p.in(4) + (size_t)jj * 4096;
        for (size_t task = gtid; task < (size_t)1026 * 512; task += gn) {
            const int cbk = (int)(task & 511), tb = (int)(task >> 9), c0 = cbk * 8, t0 = tb * 8;
            float w[4][8], bb[8], x3[8], x2[8], x1[8];
#pragma unroll
            for (int k = 0; k < 4; ++k) ld8f(cw + (size_t)k * 4096 + c0, w[k]);
            ld8f(cb + c0, bb);
#pragma unroll
            for (int i = 0; i < 8; ++i) { x3[i] = x2[i] = x1[i] = 0.f; }
            if (t0 >= 3) unpack8(*(const u32x4*)(u + (size_t)(t0 - 3) * HYB_N + UXBC + c0), x3);
            if (t0 >= 2) unpack8(*(const u32x4*)(u + (size_t)(t0 - 2) * HYB_N + UXBC + c0), x2);
            if (t0 >= 1) unpack8(*(const u32x4*)(u + (size_t)(t0 - 1) * HYB_N + UXBC + c0), x1);
#pragma unroll
            for (int tt = 0; tt < 8; ++tt) {
                const int t = t0 + tt;
                float x0[8], o[8];
                unpack8(*(const u32x4*)(u + (size_t)t * HYB_N + UXBC + c0), x0);
#pragma unroll
                for (int i = 0; i < 8; ++i) {
                    const float y = bb[i] + w[0][i] * x3[i] + w[1][i] * x2[i] + w[2][i] * x1[i] + w[3][i] * x0[i];
                    o[i] = silu_f(y);
                    x3[i] = x2[i]; x2[i] = x1[i]; x1[i] = x0[i];
                }
                u32x4 ww; ww.x = pack2(o[0], o[1]); ww.y = pack2(o[2], o[3]); ww.z = pack2(o[4], o[5]); ww.w = pack2(o[6], o[7]);
                *(u32x4*)(xc + (size_t)t * 4096 + c0) = ww;
            }
        }
    }
    {
        float* dt = (float*)(p.ws + O_DT); float* acs = (float*)(p.ws + O_ACS); float* cdec = (float*)(p.ws + O_CDEC);
        for (size_t task = gtid; task < (size_t)65 * 32; task += gn) {
            const int head = (int)(task & 31), c = (int)(task >> 5);
            const float bias = p.in(5)[jj * 32 + head], a = -__expf(p.in(6)[jj * 32 + head]);
            float cs = 0.f;
            for (int i = 0; i < 128; ++i) {
                const int t = c * 128 - 112 + i;
                if (t < 0) continue;
                const float x = side[(size_t)t * 48 + head] + bias;
                const float d = x > 20.f ? x : log1pf(__expf(x));
                cs += d * a;
                dt[(size_t)t * 32 + head] = d; acs[(size_t)t * 32 + head] = cs;
            }
            cdec[c * 32 + head] = __expf(cs);
        }
    }
    {
        bf16_t* qt = (bf16_t*)(p.ws + O_QT); bf16_t* kt = (bf16_t*)(p.ws + O_KT); float* glast = (float*)(p.ws + O_GLAST);
        const float* w2 = p.in(9) + (size_t)jj * 16 * 1024; const float* gb = p.in(10) + (size_t)jj * 1024;
        for (size_t task = gtid; task < (size_t)129 * 1024; task += gn) {
            const int d = (int)(task & 1023), c = (int)(task >> 10);
            float w[16];
#pragma unroll
            for (int r = 0; r < 16; ++r) w[r] = w2[r * 1024 + d];
            const float b = gb[d];
            float gc = 0.f;
            for (int i = 0; i < 64; ++i) {
                const int t = c * 64 - 48 + i;
                if (t < 0) continue;
                const float* gl = side + (size_t)t * 48 + 32;
                float x = b;
#pragma unroll
                for (int r = 0; r < 16; ++r) x += gl[r] * w[r];
                const float ls = fminf(x, 0.f) - log1pf(__expf(-fabsf(x)));
                gc += ls * (1.f / 16.f);
                const float qv = bf2f(u[(size_t)t * HYB_N + UQ + d]), kv = bf2f(u[(size_t)t * HYB_N + UK + d]);
                qt[(size_t)t * 1024 + d] = f2bf(qv * 0.0625f * __expf(gc));
                kt[(size_t)t * 1024 + d] = f2bf(kv * __expf(-gc));
            }
            glast[c * 1024 + d] = __expf(gc);
        }
    }
}

__device__ __forceinline__ void phase_hyb_local(const Ctx& p, LAS unsigned char* lds) {
    const int tid = tidx(), lane = tid & 63, wid = tid >> 6, fr = lane & 15, fq = lane >> 4;
    const bf16_t* xc = (const bf16_t*)(p.ws + O_XC);
    const float* dt = (const float*)(p.ws + O_DT); const float* acs = (const float*)(p.ws + O_ACS);
    const int NSSD = 65 * 8, NGLA = 129 * 16;
    for (int task = bidx(); task < NSSD + NGLA; task += gridDim.x) {
        __syncthreads();
        if (task < NSSD) {
            const int c = task >> 3, g = task & 7, tbase = c * 128 - 112;
            LAS bf16_t* Bt = (LAS bf16_t*)lds;
            LAS bf16_t* Xt = Bt + 128 * 136;
            const int tlast = tbase + 127;
            for (int item = tid; item < 128 * 16; item += NTHREADS) {
                const int j = item >> 4, cb = item & 15, t = tbase + j;
                float f[8];
                if (t >= 0) unpack8(*(const u32x4*)(xc + (size_t)t * 4096 + 2048 + g * 128 + cb * 8), f);
                else {
#pragma unroll
                    for (int i = 0; i < 8; ++i) f[i] = 0.f; }
#pragma unroll
                for (int i = 0; i < 8; ++i) Bt[(cb * 8 + i) * 136 + j] = f2bf(f[i]);
            }
            for (int item = tid; item < 128 * 32; item += NTHREADS) {
                const int j = item >> 5, cb = item & 31, hh = cb >> 3, t = tbase + j, head = g * 4 + hh;
                float f[8]; float sc = 0.f;
                if (t >= 0) { unpack8(*(const u32x4*)(xc + (size_t)t * 4096 + g * 256 + cb * 8), f); sc = dt[(size_t)t * 32 + head] * __expf(acs[(size_t)tlast * 32 + head] - acs[(size_t)t * 32 + head]); }
                else {
#pragma unroll
                    for (int i = 0; i < 8; ++i) f[i] = 0.f; }
#pragma unroll
                for (int i = 0; i < 8; ++i) Xt[(hh * 64 + (cb & 7) * 8 + i) * 136 + j] = f2bf(f[i] * sc);
            }
            __syncthreads();
            float* loc = (float*)(p.ws + O_SSDLOC) + ((size_t)c * 32 + g * 4) * 64 * 128;
            const int pt = wid & 3, nh = wid >> 2;
            for (int hh = 0; hh < 4; ++hh) {
                f32x4 acc[4];
#pragma unroll
                for (int nt = 0; nt < 4; ++nt) acc[nt] = (f32x4){0.f, 0.f, 0.f, 0.f};
#pragma unroll
                for (int ks = 0; ks < 4; ++ks) {
                    const bf16x8 xf = ldfrag(Xt + hh * 64 * 136, 136, pt * 16, ks * 32, lane);
#pragma unroll
                    for (int nt = 0; nt < 4; ++nt) { const bf16x8 bf = ldfrag(Bt, 136, nh * 64 + nt * 16, ks * 32, lane); acc[nt] = MFMA16(bf, xf, acc[nt]); }
                }
#pragma unroll
                for (int nt = 0; nt < 4; ++nt) *(f32x4*)(loc + ((size_t)hh * 64 + pt * 16 + fr) * 128 + nh * 64 + nt * 16 + 4 * fq) = acc[nt];
            }
        } else {
            const int gt = task - NSSD, c = gt >> 4, h = (gt >> 2) & 3, vs = gt & 3, tbase = c * 64 - 48;
            const bf16_t* u = (const bf16_t*)(p.ws + O_U); const bf16_t* kt = (const bf16_t*)(p.ws + O_KT);
            LAS bf16_t* Kt = (LAS bf16_t*)lds;
            LAS bf16_t* Vt = Kt + 256 * 72;
            for (int item = tid; item < 64 * 32; item += NTHREADS) {
                const int j = item >> 5, cb = item & 31, t = tbase + j;
                u32x4 w = {0u, 0u, 0u, 0u};
                if (t >= 0) w = *(const u32x4*)(kt + (size_t)t * 1024 + h * 256 + cb * 8);
                const bf16_t e[8] = {(bf16_t)(w.x & 0xffff), (bf16_t)(w.x >> 16), (bf16_t)(w.y & 0xffff), (bf16_t)(w.y >> 16), (bf16_t)(w.z & 0xffff), (bf16_t)(w.z >> 16), (bf16_t)(w.w & 0xffff), (bf16_t)(w.w >> 16)};
#pragma unroll
                for (int i = 0; i < 8; ++i) Kt[(cb * 8 + i) * 72 + j] = e[i];
            }
            for (int item = tid; item < 64 * 16; item += NTHREADS) {
                const int j = item >> 4, cb = item & 15, t = tbase + j;
                u32x4 w = {0u, 0u, 0u, 0u};
                if (t >= 0) w = *(const u32x4*)(u + (size_t)t * HYB_N + UV + h * 512 + vs * 128 + cb * 8);
                const bf16_t e[8] = {(bf16_t)(w.x & 0xffff), (bf16_t)(w.x >> 16), (bf16_t)(w.y & 0xffff), (bf16_t)(w.y >> 16), (bf16_t)(w.z & 0xffff), (bf16_t)(w.z >> 16), (bf16_t)(w.w & 0xffff), (bf16_t)(w.w >> 16)};
#pragma unroll
                for (int i = 0; i < 8; ++i) Vt[(cb * 8 + i) * 72 + j] = e[i];
            }
            __syncthreads();
            const float* glast = (const float*)(p.ws + O_GLAST) + c * 1024 + h * 256;
            bf16_t* kv = (bf16_t*)(p.ws + O_R2) + (((size_t)c * 4 + h) * 512 + vs * 128 + wid * 16 + fr) * 256;
            const bf16x8 vf0 = ldfrag(Vt, 72, wid * 16, 0, lane), vf1 = ldfrag(Vt, 72, wid * 16, 32, lane);
#pragma unroll
            for (int nt = 0; nt < 16; ++nt) {
                f32x4 acc = {0.f, 0.f, 0.f, 0.f};
                acc = MFMA16(ldfrag(Kt, 72, nt * 16, 0, lane), vf0, acc);
                acc = MFMA16(ldfrag(Kt, 72, nt * 16, 32, lane), vf1, acc);
                const f32x4 gl = *(const f32x4*)(glast + nt * 16 + 4 * fq);
                u32x2 w; w.x = pack2(acc[0] * gl[0], acc[1] * gl[1]); w.y = pack2(acc[2] * gl[2], acc[3] * gl[3]);
                *(u32x2*)(kv + nt * 16 + 4 * fq) = w;
            }
        }
    }
}

__device__ __forceinline__ void phase_hyb_scan(const Ctx& p) {
    const size_t gtid = (size_t)bidx() * NTHREADS + tidx(), gn = (size_t)gridDim.x * NTHREADS;
    for (size_t task = gtid; task < 131072; task += gn) {
        if (task < 65536) {
            const size_t e = task * 4; const int head = (int)(e >> 13);
            const float* loc = (const float*)(p.ws + O_SSDLOC) + e; bf16_t* prev = (bf16_t*)(p.ws + O_SSDPREV) + e;
            const float* cdec = (const float*)(p.ws + O_CDEC) + head;
            float4 run = {0.f, 0.f, 0.f, 0.f};
#pragma unroll 5
            for (int c = 0; c < 65; ++c) {
                const float4 l = *(const float4*)(loc + (size_t)c * 262144); const float dcy = cdec[c * 32];
                u32x2 w; w.x = pack2(run.x, run.y); w.y = pack2(run.z, run.w);
                *(u32x2*)(prev + (size_t)c * 262144) = w;
                run.x = run.x * dcy + l.x; run.y = run.y * dcy + l.y; run.z = run.z * dcy + l.z; run.w = run.w * dcy + l.w;
            }
        } else {
            const size_t e = (task - 65536) * 8; const int h = (int)(e >> 17), d0 = (int)(e & 255);
            const bf16_t* kv = (const bf16_t*)(p.ws + O_R2) + e; bf16_t* sp = (bf16_t*)(p.ws + O_R2 + GLA_ST_BYTES) + e;
            const float* glast = (const float*)(p.ws + O_GLAST) + h * 256 + d0;
            float run[8];
#pragma unroll
            for (int i = 0; i < 8; ++i) run[i] = 0.f;
#pragma unroll 3
            for (int c = 0; c < 129; ++c) {
                float l[8], gd[8];
                unpack8(*(const u32x4*)(kv + (size_t)c * 524288), l); ld8f(glast + c * 1024, gd);
                u32x4 w; w.x = pack2(run[0], run[1]); w.y = pack2(run[2], run[3]); w.z = pack2(run[4], run[5]); w.w = pack2(run[6], run[7]);
                *(u32x4*)(sp + (size_t)c * 524288) = w;
#pragma unroll
                for (int i = 0; i < 8; ++i) run[i] = run[i] * gd[i] + l[i];
            }
        }
    }
}
__device__ __forceinline__ void phase_hyb_out(const Ctx& p, int jj, LAS unsigned char* lds) {
    const int tid = tidx(), lane = tid & 63, wid = tid >> 6, fr = lane & 15, fq = lane >> 4;
    const bf16_t* xc = (const bf16_t*)(p.ws + O_XC); const bf16_t* u = (const bf16_t*)(p.ws + O_U);
    const float* dt = (const float*)(p.ws + O_DT); const float* acs = (const float*)(p.ws + O_ACS);
    bf16_t* mix = (bf16_t*)(p.ws + O_MIX);
    const int NSSD = 65 * 8, NGLA = 129 * 4;
    for (int task = bidx(); task < NSSD + NGLA; task += gridDim.x) {
        __syncthreads();
        if (task < NSSD) {
            const int c = task >> 3, g = task & 7, tbase = c * 128 - 112;
            LAS bf16_t* Cs = (LAS bf16_t*)lds;
            LAS bf16_t* Bs = Cs + 128 * 136;
            LAS bf16_t* Xt = Bs + 128 * 136;
            LAS bf16_t* Pv = Xt + 64 * 136;
            LAS float* Acs = (LAS float*)(Pv + 64 * 136);
            for (int item = tid; item < 128 * 32; item += NTHREADS) {
                const int j = item >> 5, cb = item & 31, t = tbase + j;
                u32x4 w = {0u, 0u, 0u, 0u};
                if (t >= 0) w = *(const u32x4*)(xc + (size_t)t * 4096 + 2048 + (cb < 16 ? 0 : 1024) + g * 128 + (cb & 15) * 8);
                *(LAS u32x4*)((cb < 16 ? Bs : Cs) + j * 136 + (cb & 15) * 8) = w;
            }
            { const int j = tid & 127, hh = tid >> 7, t = tbase + j; Acs[hh * 128 + j] = t >= 0 ? acs[(size_t)t * 32 + g * 4 + hh] : 0.f; }
            __syncthreads();
            const int i_row = wid * 16 + fr, ti = tbase + i_row;
            f32x4 cb_acc[8];
#pragma unroll
            for (int nt = 0; nt < 8; ++nt) cb_acc[nt] = (f32x4){0.f, 0.f, 0.f, 0.f};
#pragma unroll
            for (int ks = 0; ks < 4; ++ks) {
                const bf16x8 cf = ldfrag(Cs, 136, wid * 16, ks * 32, lane);
#pragma unroll
                for (int nt = 0; nt < 8; ++nt) cb_acc[nt] = MFMA16(ldfrag(Bs, 136, nt * 16, ks * 32, lane), cf, cb_acc[nt]);
            }
            f32x4 yv[4][4];
#pragma unroll
            for (int k = 0; k < 4; ++k)
#pragma unroll
                for (int pt = 0; pt < 4; ++pt) yv[k][pt] = (f32x4){0.f, 0.f, 0.f, 0.f};
            float ssq = 0.f;
#pragma unroll 1
            for (int hh = 0; hh < 4; ++hh) {
                const int head = g * 4 + hh;
                __syncthreads();
                for (int item = tid; item < 128 * 8; item += NTHREADS) {
                    const int j = item >> 3, cb = item & 7, t = tbase + j;
                    float f[8]; float sc = 0.f;
                    if (t >= 0) { unpack8(*(const u32x4*)(xc + (size_t)t * 4096 + head * 64 + cb * 8), f); sc = dt[(size_t)t * 32 + head]; }
                    else {
#pragma unroll
                        for (int i = 0; i < 8; ++i) f[i] = 0.f; }
#pragma unroll
                    for (int i = 0; i < 8; ++i) Xt[(cb * 8 + i) * 136 + j] = f2bf(f[i] * sc);
                }
                { const bf16_t* pv = (const bf16_t*)(p.ws + O_SSDPREV) + ((size_t)c * 32 + head) * 64 * 128;
                  for (int item = tid; item < 64 * 16; item += NTHREADS) { const int pp = item >> 4, cb = item & 15; *(LAS u32x4*)(Pv + pp * 136 + cb * 8) = *(const u32x4*)(pv + pp * 128 + cb * 8); } }
                const float ai = Acs[hh * 128 + i_row];
#pragma unroll
                for (int nt = 0; nt < 8; ++nt) {
                    float m[4];
#pragma unroll
                    for (int q = 0; q < 4; ++q) { const int j = nt * 16 + 4 * fq + q; m[q] = j <= i_row ? cb_acc[nt][q] * __expf(ai - Acs[hh * 128 + j]) : 0.f; }
                    u32x2 w; w.x = pack2(m[0], m[1]); w.y = pack2(m[2], m[3]);
                    *(LAS u32x2*)(Bs + i_row * 136 + nt * 16 + 4 * fq) = w;
                }
                __syncthreads();
                f32x4 yd[4], yo[4];
#pragma unroll
                for (int pt = 0; pt < 4; ++pt) { yd[pt] = (f32x4){0.f, 0.f, 0.f, 0.f}; yo[pt] = (f32x4){0.f, 0.f, 0.f, 0.f}; }
#pragma unroll
                for (int ks = 0; ks < 4; ++ks) {
                    const bf16x8 mf = ldfrag(Bs, 136, wid * 16, ks * 32, lane), cf = ldfrag(Cs, 136, wid * 16, ks * 32, lane);
#pragma unroll
                    for (int pt = 0; pt < 4; ++pt) {
                        yd[pt] = MFMA16(ldfrag(Xt, 136, pt * 16, ks * 32, lane), mf, yd[pt]);
                        yo[pt] = MFMA16(ldfrag(Pv, 136, pt * 16, ks * 32, lane), cf, yo[pt]);
                    }
                }
                const float ea = __expf(ai), dsk = p.in(7)[jj * 32 + head];
#pragma unroll
                for (int pt = 0; pt < 4; ++pt) {
                    const int ch = head * 64 + pt * 16 + 4 * fq;
                    float xs[4] = {0.f, 0.f, 0.f, 0.f}, zz[4] = {0.f, 0.f, 0.f, 0.f};
                    if (ti >= 0) {
                        const u32x2 xw = *(const u32x2*)(xc + (size_t)ti * 4096 + ch), zw = *(const u32x2*)(u + (size_t)ti * HYB_N + UZ + ch);
                        xs[0] = bflo(xw.x); xs[1] = bfhi(xw.x); xs[2] = bflo(xw.y); xs[3] = bfhi(xw.y);
                        zz[0] = bflo(zw.x); zz[1] = bfhi(zw.x); zz[2] = bflo(zw.y); zz[3] = bfhi(zw.y);
                    }
#pragma unroll
                    for (int q = 0; q < 4; ++q) { const float y = (yd[pt][q] + ea * yo[pt][q] + dsk * xs[q]) * silu_f(zz[q]); ssq += y * y;
#pragma unroll
                        for (int k = 0; k < 4; ++k) yv[k][pt][q] = (k == hh) ? y : yv[k][pt][q]; }
                }
            }
            ssq += __shfl_xor(ssq, 16); ssq += __shfl_xor(ssq, 32);
            const float rs = rsqrtf(ssq * (1.f / 256.f) + 1e-6f);
            if (ti >= 0) {
                const float* nw = p.in(8) + (size_t)jj * 2048;
#pragma unroll
                for (int hh = 0; hh < 4; ++hh)
#pragma unroll
                    for (int pt = 0; pt < 4; ++pt) {
                        const int ch = (g * 4 + hh) * 64 + pt * 16 + 4 * fq;
                        const f32x4 wv = *(const f32x4*)(nw + ch);
                        u32x2 w; w.x = pack2(yv[hh][pt][0] * rs * wv[0], yv[hh][pt][1] * rs * wv[1]); w.y = pack2(yv[hh][pt][2] * rs * wv[2], yv[hh][pt][3] * rs * wv[3]);
                        *(u32x2*)(mix + (size_t)ti * 4096 + ch) = w;
                    }
            }
        } else {
            const int gt = task - NSSD, c = gt >> 2, h = gt & 3, tbase = c * 64 - 48;
            const bf16_t* qt = (const bf16_t*)(p.ws + O_QT); const bf16_t* kt = (const bf16_t*)(p.ws + O_KT);
            LAS bf16_t* Qs = (LAS bf16_t*)lds;
            LAS bf16_t* Ks = Qs + 64 * 264;
            LAS bf16_t* Ps = Ks + 64 * 264;
            LAS bf16_t* Vt = Ps + 64 * 72;
            LAS float* Ssq = (LAS float*)(Vt + 128 * 72);
            for (int item = tid; item < 64 * 64; item += NTHREADS) {
                const int j = item >> 6, cb = item & 63, t = tbase + j;
                u32x4 w = {0u, 0u, 0u, 0u};
                if (t >= 0) w = *(const u32x4*)((cb < 32 ? qt : kt) + (size_t)t * 1024 + h * 256 + (cb & 31) * 8);
                *(LAS u32x4*)((cb < 32 ? Qs : Ks) + j * 264 + (cb & 31) * 8) = w;
            }
            __syncthreads();
#pragma unroll
            for (int rep = 0; rep < 2; ++rep) {
                const int tix = wid + rep * 8, it = tix >> 2, jt = tix & 3;
                f32x4 acc = {0.f, 0.f, 0.f, 0.f};
                if (jt <= it) {
#pragma unroll
                    for (int ks = 0; ks < 8; ++ks) acc = MFMA16(ldfrag(Ks, 264, jt * 16, ks * 32, lane), ldfrag(Qs, 264, it * 16, ks * 32, lane), acc);
                }
                const int i = it * 16 + fr;
                float m[4];
#pragma unroll
                for (int q = 0; q < 4; ++q) { const int j = jt * 16 + 4 * fq + q; m[q] = (j <= i) ? acc[q] : 0.f; }
                u32x2 w; w.x = pack2(m[0], m[1]); w.y = pack2(m[2], m[3]);
                *(LAS u32x2*)(Ps + i * 72 + jt * 16 + 4 * fq) = w;
            }
            f32x4 o[4][4];
            float ssq[4] = {0.f, 0.f, 0.f, 0.f};
            const bf16_t* sp = (const bf16_t*)(p.ws + O_R2 + GLA_ST_BYTES) + ((size_t)c * 4 + h) * 512 * 256;
#pragma unroll
            for (int vs = 0; vs < 4; ++vs) {
                __syncthreads();
                for (int item = tid; item < 64 * 16; item += NTHREADS) {
                    const int j = item >> 4, cb = item & 15, t = tbase + j;
                    u32x4 w = {0u, 0u, 0u, 0u};
                    if (t >= 0) w = *(const u32x4*)(u + (size_t)t * HYB_N + UV + h * 512 + vs * 128 + cb * 8);
                    const bf16_t e[8] = {(bf16_t)(w.x & 0xffff), (bf16_t)(w.x >> 16), (bf16_t)(w.y & 0xffff), (bf16_t)(w.y >> 16), (bf16_t)(w.z & 0xffff), (bf16_t)(w.z >> 16), (bf16_t)(w.w & 0xffff), (bf16_t)(w.w >> 16)};
#pragma unroll
                    for (int i = 0; i < 8; ++i) Vt[(cb * 8 + i) * 72 + j] = e[i];
                }
                __syncthreads();
#pragma unroll
                for (int it = 0; it < 4; ++it) o[vs][it] = (f32x4){0.f, 0.f, 0.f, 0.f};
#pragma unroll
                for (int ks = 0; ks < 2; ++ks) {
                    const bf16x8 vf = ldfrag(Vt, 72, wid * 16, ks * 32, lane);
#pragma unroll
                    for (int it = 0; it < 4; ++it) o[vs][it] = MFMA16(vf, ldfrag(Ps, 72, it * 16, ks * 32, lane), o[vs][it]);
                }
                const bf16_t* spw = sp + (size_t)(vs * 128 + wid * 16) * 256;
#pragma unroll
                for (int ks = 0; ks < 8; ++ks) {
                    const bf16x8 sf = gfrag(spw, 256, 0, ks * 32, lane);
#pragma unroll
                    for (int it = 0; it < 4; ++it) o[vs][it] = MFMA16(sf, ldfrag(Qs, 264, it * 16, ks * 32, lane), o[vs][it]);
                }
#pragma unroll
                for (int it = 0; it < 4; ++it) ssq[it] += o[vs][it][0] * o[vs][it][0] + o[vs][it][1] * o[vs][it][1] + o[vs][it][2] * o[vs][it][2] + o[vs][it][3] * o[vs][it][3];
            }
#pragma unroll
            for (int it = 0; it < 4; ++it) { float s = ssq[it]; s += __shfl_xor(s, 16); s += __shfl_xor(s, 32); if (fq == 0) Ssq[wid * 64 + it * 16 + fr] = s; }
            __syncthreads();
            const float* nw = p.in(11) + (size_t)jj * 2048 + h * 512;
#pragma unroll
            for (int it = 0; it < 4; ++it) {
                const int i = it * 16 + fr, t = tbase + i;
                float s = 0.f;
#pragma unroll
                for (int w8 = 0; w8 < 8; ++w8) s += Ssq[w8 * 64 + i];
                const float rs = rsqrtf(s * (1.f / 512.f) + 1e-6f);
                if (t >= 0) {
#pragma unroll
                    for (int vs = 0; vs < 4; ++vs) {
                        const int v0 = vs * 128 + wid * 16 + 4 * fq;
                        const f32x4 wv = *(const f32x4*)(nw + v0);
                        const u32x2 rw = *(const u32x2*)(u + (size_t)t * HYB_N + UR + h * 512 + v0);
                        const float r0 = bflo(rw.x), r1 = bfhi(rw.x), r2 = bflo(rw.y), r3 = bfhi(rw.y);
                        u32x2 w;
                        w.x = pack2(o[vs][it][0] * rs * wv[0] * silu_f(r0), o[vs][it][1] * rs * wv[1] * silu_f(r1));
                        w.y = pack2(o[vs][it][2] * rs * wv[2] * silu_f(r2), o[vs][it][3] * rs * wv[3] * silu_f(r3));
                        *(u32x2*)(mix + (size_t)t * 4096 + 2048 + h * 512 + v0) = w;
                    }
                }
            }
        }
    }
}
__device__ __forceinline__ void rot_pair(const u32x4 a, const u32x4 b, const float* cs, u32x4& oa, u32x4& ob) {
    float x1[8], x2[8], c[8], s[8]; unpack8(a, x1); unpack8(b, x2); ld8f(cs, c); ld8f(cs + 8, s);
    float r1[8], r2[8];
#pragma unroll
    for (int i = 0; i < 8; ++i) { r1[i] = x1[i] * c[i] - x2[i] * s[i]; r2[i] = x2[i] * c[i] + x1[i] * s[i]; }
    oa.x = pack2(r1[0], r1[1]); oa.y = pack2(r1[2], r1[3]); oa.z = pack2(r1[4], r1[5]); oa.w = pack2(r1[6], r1[7]);
    ob.x = pack2(r2[0], r2[1]); ob.y = pack2(r2[2], r2[3]); ob.z = pack2(r2[4], r2[5]); ob.w = pack2(r2[6], r2[7]);
}
__device__ __forceinline__ void phase_attn(const Ctx& p, int jj, LAS unsigned char* lds) {
    const int tid = tidx(), lane = tid & 63, wid = tid >> 6, fr = lane & 15, fq = lane >> 4;
    const bf16_t* qkv = (const bf16_t*)(p.ws + O_U);
    const float* rope = (const float*)(p.ws + O_ROPE);
    bf16_t* ao = (bf16_t*)(p.ws + O_MIX);
    LAS bf16_t* Ks = (LAS bf16_t*)lds;
    LAS bf16_t* Vt = Ks + 272 * 72;
    LAS bf16_t* Pw = Vt + 64 * 280 + wid * (16 * 168);
    for (int task = bidx(); task < 520; task += gridDim.x) {
        const bool meta = task >= 512;
        const int b = meta ? 0 : (task >> 3), kh = task & 7;
        const int nkeys = meta ? 32 : 272;
        __syncthreads();
        for (int item = tid; item < nkeys * 8; item += NTHREADS) {
            const int key = item >> 3, cb = item & 7;
            const int tok = key < 16 ? key : 16 + 128 * (b - 1) + (key - 16);
            const bool valid = meta ? (key < 16) : (key < 16 || tok >= 16);
            {
                u32x4 w = {0u, 0u, 0u, 0u};
                if (valid) w = *(const u32x4*)(qkv + (size_t)tok * QKV_N + 2560 + kh * 64 + cb * 8);
                const bf16_t e[8] = {(bf16_t)(w.x & 0xffff), (bf16_t)(w.x >> 16), (bf16_t)(w.y & 0xffff), (bf16_t)(w.y >> 16), (bf16_t)(w.z & 0xffff), (bf16_t)(w.z >> 16), (bf16_t)(w.w & 0xffff), (bf16_t)(w.w >> 16)};
#pragma unroll
                for (int i = 0; i < 8; ++i) Vt[(cb * 8 + i) * 280 + key] = e[i];
            }
            if (cb == 1) continue;
            const bf16_t* src = qkv + (size_t)tok * QKV_N + 2048 + kh * 64;
            if (cb == 0) {
                u32x4 oa = {0u, 0u, 0u, 0u}, ob = {0u, 0u, 0u, 0u};
                if (valid) rot_pair(*(const u32x4*)src, *(const u32x4*)(src + 8), rope + (size_t)tok * 16, oa, ob);
                *(LAS u32x4*)(Ks + key * 72) = oa; *(LAS u32x4*)(Ks + key * 72 + 8) = ob;
            } else {
                u32x4 w = {0u, 0u, 0u, 0u};
                if (valid) w = *(const u32x4*)(src + cb * 8);
                *(LAS u32x4*)(Ks + key * 72 + cb * 8) = w;
            }
        }
        __syncthreads();
        if (meta && wid >= 4) continue;
        const int ng = meta ? 1 : 4;
        for (int gi = 0; gi < ng; ++gi) {
            const int g = meta ? wid : gi, hq = kh * 4 + g;
            const int tq = meta ? fr : 16 + 128 * b + 16 * wid + fr;
            u32x4 q0 = *(const u32x4*)(qkv + (size_t)tq * QKV_N + hq * 64 + 8 * fq), q1 = *(const u32x4*)(qkv + (size_t)tq * QKV_N + hq * 64 + 32 + 8 * fq);
            {
                u32x4 ot; ot.x = __shfl_xor((int)q0.x, 16); ot.y = __shfl_xor((int)q0.y, 16); ot.z = __shfl_xor((int)q0.z, 16); ot.w = __shfl_xor((int)q0.w, 16);
                if (fq < 2) {
                    float mine[8], oth[8], c[8], s[8]; unpack8(q0, mine); unpack8(ot, oth); ld8f(rope + (size_t)tq * 16, c); ld8f(rope + (size_t)tq * 16 + 8, s);
                    const float sg = fq == 0 ? -1.f : 1.f;
                    float r[8];
#pragma unroll
                    for (int i = 0; i < 8; ++i) r[i] = mine[i] * c[i] + sg * oth[i] * s[i];
                    q0.x = pack2(r[0], r[1]); q0.y = pack2(r[2], r[3]); q0.z = pack2(r[4], r[5]); q0.w = pack2(r[6], r[7]);
                }
            }
            const bf16x8 qa0 = __builtin_bit_cast(bf16x8, q0), qa1 = __builtin_bit_cast(bf16x8, q1);
            const float sink = p.in(14)[jj * 32 + hq];
            const int nt = meta ? 1 : 10;
            f32x4 sc[10];
            float mx = sink;
#pragma unroll
            for (int t = 0; t < 10; ++t) {
                if (t < nt) {
                    const int krow = t == 0 ? 0 : 16 + 16 * (wid + t - 1);
                    f32x4 a = {0.f, 0.f, 0.f, 0.f};
                    a = MFMA16(ldfrag(Ks, 72, krow, 0, lane), qa0, a);
                    a = MFMA16(ldfrag(Ks, 72, krow, 32, lane), qa1, a);
#pragma unroll
                    for (int j = 0; j < 4; ++j) {
                        bool vis;
                        if (t == 0) vis = meta ? (4 * fq + j <= fr) : true;
                        else { const int rel = 16 * (t - 1) + 4 * fq + j - fr; vis = rel >= 1 && rel <= 128 && (b > 0 || 16 * wid + 16 * (t - 1) + 4 * fq + j >= 128); }
                        const float v = vis ? a[j] * 0.125f : -INFINITY;
                        a[j] = v; mx = fmaxf(mx, v);
                    }
                    sc[t] = a;
                }
            }
            mx = fmaxf(mx, __shfl_xor(mx, 16)); mx = fmaxf(mx, __shfl_xor(mx, 32));
            float den = 0.f;
#pragma unroll
            for (int t = 0; t < 10; ++t) {
                if (t < nt) {
                    float e[4];
#pragma unroll
                    for (int j = 0; j < 4; ++j) { e[j] = __expf(sc[t][j] - mx); den += e[j]; }
                    u32x2 w; w.x = pack2(e[0], e[1]); w.y = pack2(e[2], e[3]);
                    *(LAS u32x2*)(Pw + fr * 168 + t * 16 + 4 * fq) = w;
                }
            }
            if (meta) { unsigned zz = 0u; asm volatile("" : "+v"(zz)); u32x2 z = {zz, zz}; *(LAS u32x2*)(Pw + fr * 168 + 16 + 4 * fq) = z; }
            den += __shfl_xor(den, 16); den += __shfl_xor(den, 32);
            den += __expf(sink - mx);
            const float rden = 1.f / den;
            LDS_FENCE();
            f32x4 oacc[4];
#pragma unroll
            for (int dtl = 0; dtl < 4; ++dtl) oacc[dtl] = (f32x4){0.f, 0.f, 0.f, 0.f};
            const int nks = meta ? 1 : 5;
#pragma unroll
            for (int ks = 0; ks < 5; ++ks) {
                if (ks < nks) {
                    const int pc = 32 * ks + 8 * fq;
                    const bf16x8 pf = *(const LAS bf16x8*)(Pw + fr * 168 + pc);
                    const int vcol = (pc < 16 || meta) ? pc : pc + 16 * wid;
#pragma unroll
                    for (int dtl = 0; dtl < 4; ++dtl) {
                        const bf16x8 vf = *(const LAS bf16x8*)(Vt + (dtl * 16 + fr) * 280 + vcol);
                        oacc[dtl] = MFMA16(vf, pf, oacc[dtl]);
                    }
                }
            }
            LDS_FENCE();
#pragma unroll
            for (int dtl = 0; dtl < 4; ++dtl) {
                u32x2 w; w.x = pack2(oacc[dtl][0] * rden, oacc[dtl][1] * rden); w.y = pack2(oacc[dtl][2] * rden, oacc[dtl][3] * rden);
                *(u32x2*)(ao + (size_t)tq * DM + hq * 64 + dtl * 16 + 4 * fq) = w;
            }
        }
    }
}
enum { K_PREP = 0, K_HIN, K_HPREP, K_HLOCAL, K_HSCAN, K_HOUT, K_GOUT, K_LN1, K_UP, K_CONV, K_DOWN, K_LN2, K_QKV, K_ATTN };
constexpr int N_PHASES = 1 + 2 * 11 + 2 * 8;
__device__ __forceinline__ void decode_phase(int ph, int& kind, int& layer) {
    if (ph == 0) { kind = K_PREP; layer = 0; return; }
    int r = ph - 1; layer = 0;
    if (r >= 19) { r -= 19; layer = 2; }
    if (r < 11) { kind = K_HIN + r; return; }
    r -= 11; layer += 1;
    kind = r == 0 ? K_QKV : (r == 1 ? K_ATTN : K_GOUT + (r - 2));
}
__global__ void __launch_bounds__(512, 2) fwd_megakernel(Params pin) {
    extern __shared__ __attribute__((aligned(16))) unsigned char shm[];
    LAS unsigned char* lds = (LAS unsigned char*)shm;
    cg::grid_group grid = cg::this_grid();
    if (pin.ph_lo == 0) { phase_prep(pin, lds); if (pin.ph_hi > 1) grid.sync(); }
    for (int ph = pin.ph_lo < 1 ? 1 : pin.ph_lo; ph < pin.ph_hi; ++ph) {
        Ctx p; { unsigned lo = (unsigned)(size_t)pin.ws, hi = (unsigned)((size_t)pin.ws >> 32); asm volatile("" : "+s"(lo), "+s"(hi)); p.ws = (unsigned char*)(((size_t)hi << 32) | lo); p.out = pin.out; }
        ph = __builtin_amdgcn_readfirstlane(ph);
        int kind, layer; decode_phase(ph, kind, layer);
        const int jj = layer >> 1;
        bf16_t* hb = (bf16_t*)(p.ws + O_HB); float* h = (float*)(p.ws + O_H);
        bf16_t* mix = (bf16_t*)(p.ws + O_MIX);
        switch (kind) {
        case K_HIN: case K_QKV: case K_UP: {
            const bf16_t* w; bf16_t* O; int N;
            if (kind == K_HIN) { w = (const bf16_t*)(p.ws + O_WT_HIN) + (size_t)jj * 12288 * 2048; O = (bf16_t*)(p.ws + O_U); N = HYB_N;
                const int lane = tidx() & 63, wid = tidx() >> 6; const bf16_t* ws_ = (const bf16_t*)(p.ws + O_WT_HSIDE) + (size_t)jj * 48 * 2048; float* side = (float*)(p.ws + O_SIDE);
                for (int tile = bidx() * 8 + wid; tile < 513 * 3; tile += gridDim.x * 8) { const int rt = tile / 3, ct = tile % 3;
                    const f32x4 acc = wave_gemm16(hb + (size_t)rt * 16 * 2048, ws_ + (size_t)ct * 16 * 2048, 2048, lane);
                    *(f32x4*)(side + (size_t)(rt * 16 + (lane & 15)) * 48 + ct * 16 + 4 * (lane >> 4)) = acc; }
            } else if (kind == K_QKV) { w = (const bf16_t*)(p.ws + O_WT_QKV) + (size_t)jj * 3072 * 2048; O = (bf16_t*)(p.ws + O_U); N = QKV_N; }
            else { w = (const bf16_t*)(p.ws + O_WT_UP) + (size_t)layer * 11008 * 2048; O = (bf16_t*)(p.ws + O_R2); N = DFF2; }
            EpiStoreBf16 em{O, N}, e{O + (size_t)16 * N, N};
            gemm_full(lds, hb, w, N, 2048, em, e);
        } break;
        case K_GOUT: case K_DOWN: {
            const bf16_t* w; int K;
            if (kind == K_DOWN) { w = (const bf16_t*)(p.ws + O_WT_DOWN) + (size_t)layer * 2048 * 5504; K = DFF; }
            else if ((layer & 1) == 0) { w = (const bf16_t*)(p.ws + O_WT_HOUT) + (size_t)jj * 2048 * 4096; K = 4096; }
            else { w = (const bf16_t*)(p.ws + O_WT_SOUT) + (size_t)jj * 2048 * 2048; K = 2048; }
            EpiResF32 em{h}, e{h + (size_t)16 * DM};
            gemm_full(lds, mix, w, 2048, K, em, e);
        } break;
        case K_HPREP: phase_hyb_prep(p, jj); break;
        case K_HLOCAL: phase_hyb_local(p, lds); break;
        case K_HSCAN: phase_hyb_scan(p); break;
        case K_HOUT: phase_hyb_out(p, jj, lds); break;
        case K_ATTN: phase_attn(p, jj, lds); break;
        case K_LN1: phase_ln(p, p.in(20) + (size_t)layer * DM, p.in(21) + (size_t)layer * DM, false); break;
        case K_LN2: phase_ln(p, p.in(22) + (size_t)layer * DM, p.in(23) + (size_t)layer * DM, layer == 3); break;
        case K_CONV: phase_ffn_conv(p, layer); break;
        default: break;
        }
        if (ph + 1 < pin.ph_hi) grid.sync();
    }
}

extern "C" void kernel_launch(void* const* d_in, const int* in_sizes, int n_in, void* d_out, int out_size, void* d_ws, size_t ws_size, hipStream_t stream) {
    static int grid = 0;
    if (grid == 0) {
        if (n_in != 24 || ws_size < WS_END) { fprintf(stderr, "kernel_launch: unexpected inputs (n_in %d, ws %zu, need %zu)\n", n_in, ws_size, (size_t)WS_END); grid = -1; return; }
        int dev = 0, cus = 0, per_cu = 0;
        (void)hipGetDevice(&dev);
        (void)hipDeviceGetAttribute(&cus, hipDeviceAttributeMultiprocessorCount, dev);
        if (hipFuncSetAttribute((const void*)fwd_megakernel, hipFuncAttributeMaxDynamicSharedMemorySize, LDS_BYTES) != hipSuccess) { fprintf(stderr, "kernel_launch: hipFuncSetAttribute failed\n"); grid = -1; return; }
        if (hipOccupancyMaxActiveBlocksPerMultiprocessor(&per_cu, (const void*)fwd_megakernel, NTHREADS, LDS_BYTES) != hipSuccess || per_cu < 1) { fprintf(stderr, "kernel_launch: occupancy query gave %d\n", per_cu); per_cu = 1; }
        (void)hipGetLastError();
        grid = cus * per_cu;
        if (grid > 256) grid = 256;
        fprintf(stderr, "kernel_launch: grid %d (cus %d, per_cu %d), ws need %zu of %zu\n", grid, cus, per_cu, (size_t)WS_END, ws_size);
    }
    if (grid < 0) return;
    Params p{};
    for (int i = 0; i < 24; ++i) p.in[i] = (const float*)d_in[i];
    p.out = (float*)d_out; p.ws = (unsigned char*)d_ws;
    for (int i = 0; i < 8; ++i) p.inv_freq[i] = powf(500000.0f, -(float)i / 8.0f);
#if PER_PHASE_LAUNCH
    for (int ph = 0; ph < N_PHASES; ++ph) {
        p.ph_lo = ph; p.ph_hi = ph + 1;
        hipLaunchKernelGGL(fwd_megakernel, dim3(grid), dim3(NTHREADS), LDS_BYTES, stream, p);
    }
#else
    p.ph_lo = 0; p.ph_hi = N_PHASES;
    void* args[] = {&p};
    hipError_t e = hipLaunchCooperativeKernel((const void*)fwd_megakernel, dim3(grid), dim3(NTHREADS), args, LDS_BYTES, stream);
    if (e != hipSuccess) fprintf(stderr, "cooperative launch failed: %s (grid %d)\n", hipGetErrorString(e), grid);
#endif
}
```

```cpp
#include <hip/hip_runtime.h>
#include <hip/hip_cooperative_groups.h>
#include <cstdio>
#include <cmath>
namespace cg = cooperative_groups;
#ifndef PER_PHASE_LAUNCH
#define PER_PHASE_LAUNCH 0
#endif
__device__ __forceinline__ int tidx() { int t = threadIdx.x; asm volatile("" : "+v"(t)); return t; }
__device__ __forceinline__ int bidx() { int b = blockIdx.x; asm volatile("" : "+s"(b)); return b; }
#ifndef DUP_MASK
#define DUP_MASK 0
#endif
namespace pg8 {
#define PG8_LAS __attribute__((address_space(3)))
typedef unsigned short bf16_t;
typedef short bf16x8 __attribute__((ext_vector_type(8)));
typedef float f32x4 __attribute__((ext_vector_type(4)));
typedef unsigned u32x4 __attribute__((ext_vector_type(4)));
constexpr int BM = 256, BK = 64, HALF = 128, HTB = HALF * BK * 2  , STAGE_BYTES = 8 * HTB, NXCD = 8, WGM = 8;

__host__ __device__ __forceinline__ int lds_byte(int r, int c) { const int st = (r >> 4) * 2 + (c >> 5), rr = r & 15, cc = c & 31, ob = rr * 64 + cc * 2; return st * 1024 + (ob ^ (((ob >> 9) & 1) << 5)); }
__host__ __device__ __forceinline__ void stage_rc(int b, int& R, int& C) { const int st = b / 1024, sb = b % 1024, swz = sb ^ (((sb >> 9) & 1) << 5); R = (st >> 1) * 16 + swz / 64; C = (st & 1) * 32 + (swz % 64) / 2; }
__host__ __device__ __forceinline__ int perm32(int rho) { const int n = rho >> 4, i = rho & 15; return 8 * (i >> 2) + 4 * n + (i & 3); }

struct Unit { int pm, pn; };
struct Gemm { const bf16_t* A; const bf16_t* Bt; int M, N, K; };

struct StaticOrder {
    int nM, nN, nwg, G, c;
    __host__ __device__ void init(int M, int N, int G_, int c_) { nM = M / BM; nN = N / BM; nwg = nM * nN; G = G_; c = c_; }
    __host__ __device__ bool next(int i, Unit& u) const {
        const long L = (long)i * G + c; if (L >= nwg) return false;
        int wgid = (int)L; { const int q = nwg / NXCD, r = nwg % NXCD, xcd = wgid % NXCD, off = wgid / NXCD; wgid = (xcd < r ? xcd * (q + 1) : r * (q + 1) + (xcd - r) * q) + off; }
        const int nig = WGM * nN, gid = wgid / nig, fm = gid * WGM, gsz = (nM - fm) < WGM ? (nM - fm) : WGM;
        u.pm = fm + ((wgid % nig) % gsz); u.pn = (wgid % nig) / gsz; return true;
    }
    __device__ __forceinline__ void a_ready(const Unit&) const {}
    __device__ __forceinline__ void done(const Unit&) const {}
};
__device__ __forceinline__ unsigned cvt_pk_bf16(float lo, float hi) { unsigned r; asm volatile("v_cvt_pk_bf16_f32 %0, %1, %2" : "=v"(r) : "v"(lo), "v"(hi)); return r; }
typedef float f32x2 __attribute__((ext_vector_type(2)));

template <class Epi, class Sched, bool STAMP = false>
__device__ __forceinline__ void gemm_phase(PG8_LAS unsigned char* lds, const Gemm g, const Sched& S, const Epi& E, unsigned long long* stamps) {
    const int tid = tidx(), wid = __builtin_amdgcn_readfirstlane(tid >> 6), lane = tid & 63, wr = wid >> 2, wc = wid & 3, fr = lane & 15, fq = lane >> 4;
    const int K = g.K, nt = K / BK;
    int ts_lo = 0, ts_hi = 0, nts = 0; const unsigned long long rt_entry = STAMP ? (unsigned long long)wall_clock64() : 0ull;
#define PG8_STAMP() do { if (STAMP && wid == 0 && nts < 64) { const unsigned long long _c = (unsigned long long)clock64(); \
        ts_lo = (lane == nts) ? (int)(unsigned)_c : ts_lo; ts_hi = (lane == nts) ? (int)(unsigned)(_c >> 32) : ts_hi; ++nts; } } while (0)
    PG8_STAMP();
    unsigned voffA[2], voffB[2];
#pragma unroll
    for (int i = 0; i < 2; ++i) { int R, C; stage_rc(tid * 16 + i * 8192, R, C); const int Rb = Epi::PERM ? ((R & ~31) + perm32(R & 31)) : R;
        voffA[i] = (unsigned)(R * K + C) * 2u; voffB[i] = (unsigned)(Rb * K + C) * 2u; }
    const size_t kstep = (size_t)(BK * 2);
    const size_t hstep = (size_t)HALF * K * 2;
    const size_t tstep = 2 * hstep;
    const unsigned ldsw = (unsigned)wid * 1024u;
    const int aoff = lds_byte(wr * 64 + fr, fq * 8), boff = lds_byte(wc * 32 + fr, fq * 8);
#define PG8_SA(b, h) (((b) * 2 + (h)) * HTB)
#define PG8_SB(b, h) ((4 + (b) * 2 + (h)) * HTB)
#define PG8_STAGE(bufoff, gbase, voff) do { _Pragma("unroll") for (int _i = 0; _i < 2; ++_i) \
        __builtin_amdgcn_global_load_lds((const unsigned*)((const char*)(gbase) + (voff)[_i]), (PG8_LAS unsigned*)(lds + (bufoff) + ldsw + _i * 8192), 16, 0, 0); } while (0)
#define PG8_LDA(dst, b, h) do { _Pragma("unroll") for (int m = 0; m < 4; ++m) _Pragma("unroll") for (int k = 0; k < 2; ++k) dst[m][k] = *(const PG8_LAS bf16x8*)(lds + PG8_SA(b, h) + aoff + m * 2048 + k * 1024); } while (0)
#define PG8_LDB(dst, b, h) do { _Pragma("unroll") for (int n = 0; n < 2; ++n) _Pragma("unroll") for (int k = 0; k < 2; ++k) dst[n][k] = *(const PG8_LAS bf16x8*)(lds + PG8_SB(b, h) + boff + n * 2048 + k * 1024); } while (0)
#define PG8_MMA(ai, bj, At, Bt) do { __builtin_amdgcn_s_setprio(1); _Pragma("unroll") for (int m = 0; m < 4; ++m) _Pragma("unroll") for (int n = 0; n < 2; ++n) _Pragma("unroll") for (int k = 0; k < 2; ++k) \
        acc[ai][bj][m][n] = __builtin_amdgcn_mfma_f32_16x16x32_bf16(Bt[n][k], At[m][k], acc[ai][bj][m][n], 0, 0, 0); __builtin_amdgcn_s_setprio(0); } while (0)
#define PG8_WAIT_V(n) asm volatile("s_waitcnt vmcnt(" #n ")" ::: "memory")
#define PG8_WAIT_L(n) asm volatile("s_waitcnt lgkmcnt(" #n ")" ::: "memory")
#define PG8_BAR __builtin_amdgcn_s_barrier()
#define PG8_SCHED __builtin_amdgcn_sched_barrier(0)
    Unit cur, nxt; int ui = 0;
    if (!S.next(0, cur)) return;
    f32x4 acc[2][2][4][2];
#pragma unroll
    for (int a = 0; a < 2; ++a)
#pragma unroll
        for (int b = 0; b < 2; ++b)
#pragma unroll
            for (int m = 0; m < 4; ++m)
#pragma unroll
                for (int n = 0; n < 2; ++n) acc[a][b][m][n] = (f32x4){0.f, 0.f, 0.f, 0.f};
    bf16x8 At[4][2], B0[2][2], B1[2][2];
    const char* cA = (const char*)g.A + (size_t)cur.pm * tstep; const char* cB = (const char*)g.Bt + (size_t)cur.pn * tstep;
    S.a_ready(cur);
    PG8_STAGE(PG8_SB(0, 0), cB, voffB); PG8_STAGE(PG8_SA(0, 0), cA, voffA); PG8_STAGE(PG8_SB(0, 1), cB + hstep, voffB); PG8_STAGE(PG8_SA(0, 1), cA + hstep, voffA);
    if (wr == 1) PG8_BAR;
    PG8_WAIT_V(4); PG8_BAR;
    PG8_STAGE(PG8_SB(1, 0), cB + kstep, voffB); PG8_STAGE(PG8_SA(1, 0), cA + kstep, voffA); PG8_STAGE(PG8_SB(1, 1), cB + hstep + kstep, voffB);
    PG8_WAIT_V(6); PG8_BAR;
    PG8_STAMP();
    for (;;) {
        const bool has_next = S.next(ui + 1, nxt);
        const char* nA = has_next ? (const char*)g.A + (size_t)nxt.pm * tstep : cA; const char* nB = has_next ? (const char*)g.Bt + (size_t)nxt.pn * tstep : cB;
        for (int t = 0; t < nt; t += 2) {
            const bool last = (t == nt - 2);
            const char* a1 = cA + (size_t)(t + 1) * kstep;
            const char* a2 = last ? nA : cA + (size_t)(t + 2) * kstep; const char* b2 = last ? nB : cB + (size_t)(t + 2) * kstep;
            const char* a3 = a2 + kstep; const char* b3 = b2 + kstep;
            if (last && has_next) S.a_ready(nxt);
            PG8_LDB(B0, 0, 0); PG8_SCHED; PG8_LDA(At, 0, 0); PG8_STAGE(PG8_SA(1, 1), a1 + hstep, voffA);
            PG8_WAIT_L(8); PG8_BAR; PG8_WAIT_L(0); PG8_MMA(0, 0, At, B0); PG8_BAR; PG8_SCHED;
            PG8_LDB(B1, 0, 1); PG8_STAGE(PG8_SB(0, 0), b2, voffB);
            PG8_BAR; PG8_WAIT_L(0); PG8_MMA(0, 1, At, B1); PG8_BAR;
            PG8_LDA(At, 0, 1); PG8_STAGE(PG8_SA(0, 0), a2, voffA);
            PG8_BAR; PG8_WAIT_L(0); PG8_MMA(1, 0, At, B0); PG8_BAR; PG8_SCHED;
            PG8_STAGE(PG8_SB(0, 1), b2 + hstep, voffB);
            PG8_WAIT_V(6); PG8_BAR; PG8_MMA(1, 1, At, B1); PG8_BAR;
            PG8_LDB(B0, 1, 0); PG8_SCHED; PG8_LDA(At, 1, 0); PG8_STAGE(PG8_SA(0, 1), a2 + hstep, voffA);
            PG8_WAIT_L(8); PG8_BAR; PG8_WAIT_L(0); PG8_MMA(0, 0, At, B0); PG8_BAR; PG8_SCHED;
            PG8_LDB(B1, 1, 1); PG8_STAGE(PG8_SB(1, 0), b3, voffB);
            PG8_BAR; PG8_WAIT_L(0); PG8_MMA(0, 1, At, B1); PG8_BAR;
            PG8_LDA(At, 1, 1); PG8_STAGE(PG8_SA(1, 0), a3, voffA);
            PG8_BAR; PG8_WAIT_L(0); PG8_MMA(1, 0, At, B0); PG8_BAR; PG8_SCHED;
            PG8_STAGE(PG8_SB(1, 1), b3 + hstep, voffB);
            PG8_WAIT_V(6); PG8_BAR; PG8_MMA(1, 1, At, B1); PG8_BAR;
        }
        PG8_STAMP();
        if constexpr (!Epi::AFTER_DRAIN) { E(acc, cur, wr, wc, fr, fq); S.done(cur); }
        PG8_STAMP();
        if (!has_next) break;
#pragma unroll
        for (int a = 0; a < 2; ++a)
#pragma unroll
            for (int b = 0; b < 2; ++b)
#pragma unroll
                for (int m = 0; m < 4; ++m)
#pragma unroll
                    for (int n = 0; n < 2; ++n) acc[a][b][m][n] = (f32x4){0.f, 0.f, 0.f, 0.f};
        cur = nxt; cA = nA; cB = nB; ++ui;
    }
    PG8_WAIT_V(0);
    if (wr == 0) PG8_BAR;
    PG8_BAR;
    if constexpr (Epi::AFTER_DRAIN) { E.fused(acc, cur, wr, wc, fr, fq, lds, wid, lane); S.done(cur); }
    PG8_STAMP();
    if (STAMP && wid == 0) { stamps[lane] = lane < nts ? (((unsigned long long)(unsigned)ts_hi << 32) | (unsigned)ts_lo) : 0ull;
        if (lane == 62) stamps[62] = rt_entry; if (lane == 63) stamps[63] = (unsigned long long)wall_clock64(); }
#undef PG8_STAMP
#undef PG8_SA
#undef PG8_SB
#undef PG8_STAGE
#undef PG8_LDA
#undef PG8_LDB
#undef PG8_MMA
#undef PG8_WAIT_V
#undef PG8_WAIT_L
#undef PG8_BAR
#undef PG8_SCHED
}
}
using pg8::bf16_t; using pg8::bf16x8; using pg8::f32x4; using pg8::u32x4;
#define LAS __attribute__((address_space(3)))
typedef unsigned u32x2 __attribute__((ext_vector_type(2)));

constexpr int L_TOK = 8208, DM = 2048;
constexpr int HYB_N = 12288, DFF = 5504, DFF2 = 11008, QKV_N = 3072;
constexpr int UZ = 0, UXBC = 2048, UQ = 6144, UK = 7168, UV = 8192, UR = 10240;
constexpr float ALPHA = 1.6817928305074292f;
constexpr int NTHREADS = 512;
constexpr int LDS_MAIN = 143360;
constexpr int LDS_BYTES = LDS_MAIN + 256;

constexpr size_t al256(size_t x) { return (x + 255) & ~(size_t)255; }
constexpr size_t O_WT_HIN   = 0;
constexpr size_t O_WT_HSIDE = O_WT_HIN   + al256(2ull * 12288 * 2048 * 2);
constexpr size_t O_WT_HOUT  = O_WT_HSIDE + al256(2ull * 48 * 2048 * 2);
constexpr size_t O_WT_QKV   = O_WT_HOUT  + al256(2ull * 2048 * 4096 * 2);
constexpr size_t O_WT_SOUT  = O_WT_QKV   + al256(2ull * 3072 * 2048 * 2);
constexpr size_t O_WT_UP    = O_WT_SOUT  + al256(2ull * 2048 * 2048 * 2);
constexpr size_t O_WT_DOWN  = O_WT_UP    + al256(4ull * 11008 * 2048 * 2);
constexpr size_t O_H        = O_WT_DOWN  + al256(4ull * 2048 * 5504 * 2);
constexpr size_t O_HB       = O_H        + al256((size_t)L_TOK * 2048 * 4);
constexpr size_t O_U        = O_HB       + al256((size_t)L_TOK * 2048 * 2);
constexpr size_t O_R2       = O_U        + al256((size_t)L_TOK * 12288 * 2);
constexpr size_t GLA_ST_BYTES = 129ull * 4 * 512 * 256 * 2;
constexpr size_t O_MIX      = O_R2       + al256(2 * GLA_ST_BYTES);
constexpr size_t O_XC       = O_MIX      + al256((size_t)L_TOK * 5504 * 2);
constexpr size_t O_SIDE     = O_XC       + al256((size_t)L_TOK * 4096 * 2);
constexpr size_t O_DT       = O_SIDE     + al256((size_t)L_TOK * 64 * 4);
constexpr size_t O_ACS      = O_DT       + al256((size_t)L_TOK * 32 * 4);
constexpr size_t O_QT       = O_ACS      + al256((size_t)L_TOK * 32 * 4);
constexpr size_t O_KT       = O_QT       + al256((size_t)L_TOK * 1024 * 2);
constexpr size_t O_GLAST    = O_KT       + al256((size_t)L_TOK * 1024 * 2);
constexpr size_t O_CDEC     = O_GLAST    + al256(129ull * 1024 * 4);
constexpr size_t O_SSDLOC   = O_CDEC     + al256(65ull * 32 * 4);
constexpr size_t O_SSDPREV  = O_SSDLOC   + al256(65ull * 32 * 64 * 128 * 4);
constexpr size_t O_ROPE     = O_SSDPREV  + al256(65ull * 32 * 64 * 128 * 2);
constexpr size_t O_TAB      = O_ROPE     + al256((size_t)L_TOK * 16 * 4);
constexpr size_t O_BAR      = O_TAB      + 256;
constexpr size_t WS_END     = O_BAR      + al256(4096 * 4);
static_assert(WS_END <= 1442840576ull, "workspace too large");

struct Params {
    const float* in[24];
    float* out;
    unsigned char* ws;
    float inv_freq[8];
    int ph_lo, ph_hi;
};

struct Ctx { unsigned char* ws; float* out;
    __device__ __forceinline__ const float* in(int k) const { const size_t a = ((const size_t*)(ws + O_TAB))[k]; return (const float*)(const __attribute__((address_space(1))) float*)a; } };

__device__ __forceinline__ bf16_t f2bf(float f) { unsigned u = __float_as_uint(f); u += 0x7FFFu + ((u >> 16) & 1u); return (bf16_t)(u >> 16); }
__device__ __forceinline__ float bf2f(bf16_t b) { return __uint_as_float(((unsigned)b) << 16); }
__device__ __forceinline__ unsigned pack2(float lo, float hi) { unsigned r; asm("v_cvt_pk_bf16_f32 %0, %1, %2" : "=v"(r) : "v"(lo), "v"(hi)); return r; }
__device__ __forceinline__ float bflo(unsigned w) { return __uint_as_float(w << 16); }
__device__ __forceinline__ float bfhi(unsigned w) { return __uint_as_float(w & 0xffff0000u); }
__device__ __forceinline__ float silu_f(float x) { return x / (1.f + __expf(-x)); }
__device__ __forceinline__ float wave_sum(float v) {
#pragma unroll
    for (int o = 32; o > 0; o >>= 1) v += __shfl_xor(v, o);
    return v;
}
__device__ __forceinline__ bf16x8 ldfrag(const LAS bf16_t* base, int ld, int row0, int k0, int lane) {
    return *(const LAS bf16x8*)(base + (row0 + (lane & 15)) * ld + k0 + 8 * (lane >> 4));
}
__device__ __forceinline__ bf16x8 gfrag(const bf16_t* base, size_t ld, int row0, int k0, int lane) {
    return *(const bf16x8*)(base + (size_t)(row0 + (lane & 15)) * ld + k0 + 8 * (lane >> 4));
}
typedef short s16x4 __attribute__((ext_vector_type(4)));
__device__ __forceinline__ bf16x8 ldfrag_tr(const LAS bf16_t* base, int ld, int n0, int k0, int lane) {
    const int g = lane >> 4, i = lane & 15, q = i >> 2, pp = i & 3;
    const LAS bf16_t* a = base + (k0 + 8 * g + q) * ld + n0 + 4 * pp;
    const s16x4 r1 = __builtin_amdgcn_ds_read_tr16_b64_v4i16((LAS s16x4*)a);
    const s16x4 r2 = __builtin_amdgcn_ds_read_tr16_b64_v4i16((LAS s16x4*)(a + 4 * ld));
    return __builtin_shufflevector(r1, r2, 0, 1, 2, 3, 4, 5, 6, 7);
}
#define MFMA16(a, b, c) __builtin_amdgcn_mfma_f32_16x16x32_bf16((a), (b), (c), 0, 0, 0)
#define LDS_FENCE() asm volatile("s_waitcnt lgkmcnt(0)" ::: "memory")

struct EpiStoreBf16 {
    static constexpr bool PERM = true, AFTER_DRAIN = false;
    bf16_t* O; int ldc;
    __device__ __forceinline__ void operator()(const f32x4 (&acc)[2][2][4][2], const pg8::Unit& u, int wr, int wc, int fr, int fq) const {
        const int row0 = u.pm * 256 + wr * 64 + fr, col0 = u.pn * 256 + wc * 32 + 8 * fq;
#pragma unroll
        for (int ai = 0; ai < 2; ++ai)
#pragma unroll
            for (int m = 0; m < 4; ++m) { bf16_t* rowp = O + (size_t)(row0 + ai * 128 + m * 16) * ldc + col0;
#pragma unroll
                for (int bj = 0; bj < 2; ++bj) { const f32x4 v0 = acc[ai][bj][m][0], v1 = acc[ai][bj][m][1];
                    u32x4 w; w.x = pg8::cvt_pk_bf16(v0[0], v0[1]); w.y = pg8::cvt_pk_bf16(v0[2], v0[3]); w.z = pg8::cvt_pk_bf16(v1[0], v1[1]); w.w = pg8::cvt_pk_bf16(v1[2], v1[3]);
                    *(u32x4*)(rowp + bj * 128) = w; } }
    }
    __device__ __forceinline__ void meta(int row, int col, f32x4 v) const {
        u32x2 w; w.x = pg8::cvt_pk_bf16(v[0], v[1]); w.y = pg8::cvt_pk_bf16(v[2], v[3]);
        *(u32x2*)(O + (size_t)row * ldc + col) = w;
    }
};
struct EpiResF32 {
    static constexpr bool PERM = false, AFTER_DRAIN = false;
    float* H; const bf16_t* HB;
    __device__ __forceinline__ void operator()(const f32x4 (&acc)[2][2][4][2], const pg8::Unit& u, int wr, int wc, int fr, int fq) const {
        const int row0 = u.pm * 256 + wr * 64 + fr, col0 = u.pn * 256 + wc * 32 + 4 * fq;
#pragma unroll
        for (int ai = 0; ai < 2; ++ai)
#pragma unroll
            for (int m = 0; m < 4; ++m) { const size_t ro = (size_t)(row0 + ai * 128 + m * 16) * DM + col0;
#pragma unroll
                for (int bj = 0; bj < 2; ++bj)
#pragma unroll
                    for (int n = 0; n < 2; ++n) { const size_t o = ro + bj * 128 + n * 16; const u32x2 hw = *(const u32x2*)(HB + o);
                        const f32x4 hv = {bflo(hw.x), bfhi(hw.x), bflo(hw.y), bfhi(hw.y)}; *(f32x4*)(H + o) = hv * ALPHA + acc[ai][bj][m][n]; } }
    }
    __device__ __forceinline__ void meta(int row, int col, f32x4 v) const {
        const size_t o = (size_t)row * DM + col; const u32x2 hw = *(const u32x2*)(HB + o);
        const f32x4 hv = {bflo(hw.x), bfhi(hw.x), bflo(hw.y), bfhi(hw.y)}; *(f32x4*)(H + o) = hv * ALPHA + v;
    }
};
__device__ __forceinline__ f32x4 wave_gemm16(const bf16_t* A, const bf16_t* Bt, int K, int lane) {
    f32x4 acc = {0.f, 0.f, 0.f, 0.f};
    const bf16_t* pa = A + (size_t)(lane & 15) * K + 8 * (lane >> 4);
    const bf16_t* pb = Bt + (size_t)(lane & 15) * K + 8 * (lane >> 4);
#pragma unroll 16
    for (int k0 = 0; k0 < K; k0 += 32) {
        const bf16x8 a = *(const bf16x8*)(pa + k0), b = *(const bf16x8*)(pb + k0);
        acc = MFMA16(b, a, acc);
    }
    return acc;
}
template <class Epi>
__device__ __forceinline__ void gemm_full(LAS unsigned char* lds, const bf16_t* A, const bf16_t* Bt, int N, int K, const Epi& Emeta, const Epi& Emain) {
    const int lane = tidx() & 63, wid = tidx() >> 6;
    for (int tile = bidx() * 8 + wid; tile < N / 16; tile += gridDim.x * 8) {
        const f32x4 acc = wave_gemm16(A, Bt + (size_t)tile * 16 * K, K, lane);
        Emeta.meta(lane & 15, tile * 16 + 4 * (lane >> 4), acc);
    }
    pg8::Gemm g{A + (size_t)16 * K, Bt, 8192, N, K};
    pg8::StaticOrder S; S.init(8192, N, (int)gridDim.x, (int)bidx());
    pg8::gemm_phase<Epi, pg8::StaticOrder, false>(lds, g, S, Emain, nullptr);
    __syncthreads();
}
#define XB_TMO      128
#define XB_XCNT(j)  (256  + 64 * (j))
#define XB_XSUB(j)  (1280 + 64 * (j))
#define XB_XGEN(j)  (2304 + 64 * (j))
#define XB_TOP      3328
#define XB_TOPGEN   3392
#define XCD_BAR_WORDS 3456
#define XB_SPIN_CAP (1u << 18)

__device__ __forceinline__ unsigned xb_ld(unsigned* p)              { return __hip_atomic_load(p, __ATOMIC_RELAXED, __HIP_MEMORY_SCOPE_AGENT); }
__device__ __forceinline__ unsigned xb_add(unsigned* p, unsigned v) { return __hip_atomic_fetch_add(p, v, __ATOMIC_RELAXED, __HIP_MEMORY_SCOPE_AGENT); }
__device__ __forceinline__ unsigned xb_xcc_id() { return (unsigned)__builtin_amdgcn_s_getreg((3 << 11) | 20) & 0xFu; }
#define XB_SPIN(cond, bar) do { unsigned _sp = 0; while (cond) { __builtin_amdgcn_s_sleep(1); \
    if ((++_sp & 255u) == 0u) { if (xb_ld(&(bar)[XB_TMO])) break; if (_sp > XB_SPIN_CAP) { atomicAdd(&(bar)[XB_TMO], 1u); break; } } } } while (0)

struct XcdBarrier {
    unsigned* bar; unsigned x;
    volatile LAS unsigned* st;
};

__device__ __forceinline__ XcdBarrier xcd_barrier_post(unsigned* bar, volatile LAS unsigned* st) {
    XcdBarrier b; b.bar = bar; b.x = xb_xcc_id(); b.st = st;
    if (threadIdx.x == 0) (void)xb_add(&bar[XB_XCNT(b.x)], 1u);
    return b;
}
__device__ __forceinline__ void xcd_barrier_complete(unsigned* bar, unsigned x, unsigned& nloc, unsigned& nx) {
    const unsigned G = gridDim.x * gridDim.y * gridDim.z;
    unsigned sum, cnt, mine, sp = 0u;
    for (;;) {
        sum = 0u; cnt = 0u; mine = 0u;
#pragma unroll
        for (unsigned j = 0; j < 16; ++j) { const unsigned c = xb_ld(&bar[XB_XCNT(j)]); sum += c; cnt += (c > 0u) ? 1u : 0u; mine = (j == x) ? c : mine; }
        if (sum == G) break;
        __builtin_amdgcn_s_sleep(1);
        if ((++sp & 255u) == 0u) { if (xb_ld(&bar[XB_TMO])) break; if (sp > XB_SPIN_CAP) { atomicAdd(&bar[XB_TMO], 1u); break; } }
    }
    nloc = mine > 0u ? mine : 1u; nx = cnt > 0u ? cnt : 1u;
}

__device__ __forceinline__ void xcd_barrier(const XcdBarrier& b) {
    asm volatile("s_waitcnt vmcnt(0)" ::: "memory");
    __syncthreads();
    if (threadIdx.x == 0) {
        unsigned* bar = b.bar;
        __builtin_amdgcn_s_waitcnt(0);
        unsigned nloc = b.st[0], nx = b.st[1];
        if (nloc == 0u) { xcd_barrier_complete(bar, b.x, nloc, nx); b.st[0] = nloc; b.st[1] = nx; }
        const unsigned old = xb_add(&bar[XB_XSUB(b.x)], 1u);
        const unsigned gen = old / nloc;
        if (old + 1u == (gen + 1u) * nloc) {
            __builtin_amdgcn_fence(__ATOMIC_RELEASE, "agent");
            asm volatile("s_waitcnt vmcnt(0)" ::: "memory");
            const unsigned og = xb_add(&bar[XB_TOP], 1u);
            const unsigned tg = og / nx;
            if (og + 1u == (tg + 1u) * nx) xb_add(&bar[XB_TOPGEN], 1u);
            else XB_SPIN(xb_ld(&bar[XB_TOPGEN]) == tg, bar);
            __builtin_amdgcn_fence(__ATOMIC_ACQUIRE, "agent");
            xb_add(&bar[XB_XGEN(b.x)], 1u);
            asm volatile("s_waitcnt vmcnt(0)" ::: "memory");
        } else {
            XB_SPIN(xb_ld(&bar[XB_XGEN(b.x)]) == gen, bar);
            __builtin_amdgcn_fence(__ATOMIC_ACQUIRE, "agent");
            asm volatile("s_waitcnt vmcnt(0)" ::: "memory");
        }
    }
    __syncthreads();
}
struct TJob { const float* src; int ld, ncols, K; bf16_t* dst; };
__device__ __forceinline__ TJob get_job(const Params& p, int j) {
    TJob J;
    bf16_t* ws16 = (bf16_t*)p.ws;
    if (j < 10) {
        const int jj = j / 5, sub = j % 5;
        const float* base = p.in[2] + (size_t)jj * 2048 * 12336;
        bf16_t* wmain = (bf16_t*)(p.ws + O_WT_HIN) + (size_t)jj * 12288 * 2048;
        bf16_t* wside = (bf16_t*)(p.ws + O_WT_HSIDE) + (size_t)jj * 48 * 2048;
        J.ld = 12336; J.K = 2048;
        if (sub == 0)      { J.src = base;          J.ncols = 6144; J.dst = wmain; }
        else if (sub == 1) { J.src = base + 6176;   J.ncols = 4096; J.dst = wmain + (size_t)6144 * 2048; }
        else if (sub == 2) { J.src = base + 10288;  J.ncols = 2048; J.dst = wmain + (size_t)10240 * 2048; }
        else if (sub == 3) { J.src = base + 6144;   J.ncols = 32;   J.dst = wside; }
        else               { J.src = base + 10272;  J.ncols = 16;   J.dst = wside + (size_t)32 * 2048; }
    } else if (j < 12) { const int jj = j - 10; J.src = p.in[12] + (size_t)jj * 4096 * 2048; J.ld = 2048; J.ncols = 2048; J.K = 4096; J.dst = (bf16_t*)(p.ws + O_WT_HOUT) + (size_t)jj * 2048 * 4096; }
    else if (j < 14) { const int jj = j - 12; J.src = p.in[13] + (size_t)jj * 2048 * 3072; J.ld = 3072; J.ncols = 3072; J.K = 2048; J.dst = (bf16_t*)(p.ws + O_WT_QKV) + (size_t)jj * 3072 * 2048; }
    else if (j < 16) { const int jj = j - 14; J.src = p.in[15] + (size_t)jj * 2048 * 2048; J.ld = 2048; J.ncols = 2048; J.K = 2048; J.dst = (bf16_t*)(p.ws + O_WT_SOUT) + (size_t)jj * 2048 * 2048; }
    else if (j < 20) { const int l = j - 16; J.src = p.in[16] + (size_t)l * 2048 * 11008; J.ld = 11008; J.ncols = 11008; J.K = 2048; J.dst = (bf16_t*)(p.ws + O_WT_UP) + (size_t)l * 11008 * 2048; }
    else { const int l = j - 20; J.src = p.in[19] + (size_t)l * 5504 * 2048; J.ld = 2048; J.ncols = 2048; J.K = 5504; J.dst = (bf16_t*)(p.ws + O_WT_DOWN) + (size_t)l * 2048 * 5504; }
    (void)ws16;
    return J;
}
__device__ __forceinline__ void phase_prep(const Params& p, LAS unsigned char* lds) {
    const int tid = tidx();
    LAS float* ts = (LAS float*)lds;
    for (int j = 0; j < 24; ++j) {
        const TJob J = get_job(p, j);
        const int tn = (J.ncols + 127) / 128, tk = J.K / 128;
        for (int tile = bidx(); tile < tn * tk; tile += gridDim.x) {
            const int kb = tile / tn, nb = tile % tn;
            __syncthreads();
            {
                const int c4 = (tid & 31) * 4, n = nb * 128 + c4, r0 = tid >> 5;
                if (n < J.ncols) {
                    float4 v[8];
#pragma unroll
                    for (int i = 0; i < 8; ++i) v[i] = *(const float4*)(J.src + (size_t)(kb * 128 + r0 + 16 * i) * J.ld + n);
#pragma unroll
                    for (int i = 0; i < 8; ++i) { const int r = r0 + 16 * i; ts[r * 129 + c4] = v[i].x; ts[r * 129 + c4 + 1] = v[i].y; ts[r * 129 + c4 + 2] = v[i].z; ts[r * 129 + c4 + 3] = v[i].w; }
                }
            }
            __syncthreads();
            const int n = tid >> 2, kc = tid & 3;
            if (nb * 128 + n < J.ncols) {
#pragma unroll
                for (int q = 0; q < 4; ++q) {
                    const int kk = kc * 32 + q * 8;
                    u32x4 w;
                    w.x = pack2(ts[(kk + 0) * 129 + n], ts[(kk + 1) * 129 + n]);
                    w.y = pack2(ts[(kk + 2) * 129 + n], ts[(kk + 3) * 129 + n]);
                    w.z = pack2(ts[(kk + 4) * 129 + n], ts[(kk + 5) * 129 + n]);
                    w.w = pack2(ts[(kk + 6) * 129 + n], ts[(kk + 7) * 129 + n]);
                    *(u32x4*)(J.dst + (size_t)(nb * 128 + n) * J.K + kb * 128 + kk) = w;
                }
            }
        }
    }
    __syncthreads();
    const size_t gtid = (size_t)bidx() * NTHREADS + tid, gn = (size_t)gridDim.x * NTHREADS;
    float* h = (float*)(p.ws + O_H); bf16_t* hb = (bf16_t*)(p.ws + O_HB);
    for (size_t i = gtid; i < (size_t)L_TOK * 512; i += gn) {
        const int row = (int)(i >> 9), c4 = (int)(i & 511) * 4;
        const float4 v = row < 16 ? *(const float4*)(p.in[1] + (size_t)row * DM + c4) : *(const float4*)(p.in[0] + (size_t)(row - 16) * DM + c4);
        u32x2 w; w.x = pack2(v.x, v.y); w.y = pack2(v.z, v.w);
        *(u32x2*)(hb + i * 4) = w;
    }
    if (gtid < 24) ((const float**)(p.ws + O_TAB))[gtid] = p.in[gtid];
    float* rope = (float*)(p.ws + O_ROPE);
    for (size_t i = gtid; i < (size_t)L_TOK * 8; i += gn) {
        const int pos = (int)(i >> 3), f = (int)(i & 7);
        const float ang = (float)pos * p.inv_freq[f];
        double rev = (double)ang * 0.15915494309189535;
        rev -= rint(rev);
        rope[pos * 16 + f] = __builtin_amdgcn_cosf((float)rev);
        rope[pos * 16 + 8 + f] = __builtin_amdgcn_sinf((float)rev);
    }
}

__device__ __forceinline__ void phase_ln(const Ctx& p, const float* g, const float* b, bool last) {
    const int lane = tidx() & 63, wid = tidx() >> 6;
    float* h = (float*)(p.ws + O_H); bf16_t* hb = (bf16_t*)(p.ws + O_HB);
    for (int row = bidx() * 8 + wid; row < L_TOK; row += gridDim.x * 8) {
        float4 v[8]; float s = 0.f;
#pragma unroll
        for (int i = 0; i < 8; ++i) { v[i] = *(const float4*)(h + (size_t)row * DM + i * 256 + lane * 4); s += v[i].x + v[i].y + v[i].z + v[i].w; }
        const float mean = wave_sum(s) * (1.f / 2048.f);
        float q = 0.f;
#pragma unroll
        for (int i = 0; i < 8; ++i) { v[i].x -= mean; v[i].y -= mean; v[i].z -= mean; v[i].w -= mean; q += v[i].x * v[i].x + v[i].y * v[i].y + v[i].z * v[i].z + v[i].w * v[i].w; }
        const float rstd = rsqrtf(wave_sum(q) * (1.f / 2048.f) + 1e-5f);
#pragma unroll
        for (int i = 0; i < 8; ++i) {
            const int c = i * 256 + lane * 4;
            const float4 gg = *(const float4*)(g + c), bb = *(const float4*)(b + c);
            float4 y; y.x = v[i].x * rstd * gg.x + bb.x; y.y = v[i].y * rstd * gg.y + bb.y; y.z = v[i].z * rstd * gg.z + bb.z; y.w = v[i].w * rstd * gg.w + bb.w;
            if (last) { if (row >= 16) *(float4*)(p.out + (size_t)(row - 16) * DM + c) = y; }
            else { u32x2 w; w.x = pack2(y.x, y.y); w.y = pack2(y.z, y.w); *(u32x2*)(hb + (size_t)row * DM + c) = w; }
        }
    }
}

__device__ __forceinline__ void unpack8(const u32x4 w, float (&f)[8]) {
    f[0] = bflo(w.x); f[1] = bfhi(w.x); f[2] = bflo(w.y); f[3] = bfhi(w.y); f[4] = bflo(w.z); f[5] = bfhi(w.z); f[6] = bflo(w.w); f[7] = bfhi(w.w);
}
__device__ __forceinline__ void ld8f(const float* q, float (&f)[8]) {
    const float4 a = *(const float4*)q, b = *(const float4*)(q + 4);
    f[0] = a.x; f[1] = a.y; f[2] = a.z; f[3] = a.w; f[4] = b.x; f[5] = b.y; f[6] = b.z; f[7] = b.w;
}
__device__ __forceinline__ void phase_ffn_conv(const Ctx& p, int layer) {
    const bf16_t* up = (const bf16_t*)(p.ws + O_R2); bf16_t* act = (bf16_t*)(p.ws + O_MIX);
    const float* cw = p.in(17) + (size_t)layer * 3 * DFF2; const float* cb = p.in(18) + (size_t)layer * DFF2;
    const size_t gtid = (size_t)bidx() * NTHREADS + tidx(), gn = (size_t)gridDim.x * NTHREADS;
    for (size_t task = gtid; task < (size_t)1026 * 688; task += gn) {
        const int jb = (int)(task % 688), tb = (int)(task / 688), j0 = jb * 8, t0 = tb * 8;
        float wg[3][8], wv[3][8], bg[8], bv[8];
#pragma unroll
        for (int k = 0; k < 3; ++k) { ld8f(cw + (size_t)k * DFF2 + j0, wg[k]); ld8f(cw + (size_t)k * DFF2 + DFF + j0, wv[k]); }
        ld8f(cb + j0, bg); ld8f(cb + DFF + j0, bv);
        u32x4 gr[10], vr[10];
#pragma unroll
        for (int r = 0; r < 10; ++r) {
            const int t = t0 - 2 + r;
            gr[r] = (u32x4){0u, 0u, 0u, 0u}; vr[r] = (u32x4){0u, 0u, 0u, 0u};
            if (t >= 0) { gr[r] = *(const u32x4*)(up + (size_t)t * DFF2 + j0); vr[r] = *(const u32x4*)(up + (size_t)t * DFF2 + DFF + j0); }
        }
        float g2[8], g1[8], v2[8], v1[8];
        unpack8(gr[0], g2); unpack8(vr[0], v2); unpack8(gr[1], g1); unpack8(vr[1], v1);
#pragma unroll
        for (int tt = 0; tt < 8; ++tt) {
            const int t = t0 + tt;
            float g0[8], v0[8], o[8];
            unpack8(gr[tt + 2], g0); unpack8(vr[tt + 2], v0);
#pragma unroll
            for (int i = 0; i < 8; ++i) {
                const float gg = bg[i] + wg[0][i] * g2[i] + wg[1][i] * g1[i] + wg[2][i] * g0[i];
                const float vv = bv[i] + wv[0][i] * v2[i] + wv[1][i] * v1[i] + wv[2][i] * v0[i];
                o[i] = silu_f(gg) * vv;
                g2[i] = g1[i]; g1[i] = g0[i]; v2[i] = v1[i]; v1[i] = v0[i];
            }
            u32x4 w; w.x = pack2(o[0], o[1]); w.y = pack2(o[2], o[3]); w.z = pack2(o[4], o[5]); w.w = pack2(o[6], o[7]);
            *(u32x4*)(act + (size_t)t * DFF + j0) = w;
        }
    }
}
__device__ __forceinline__ void phase_hyb_prep(const Ctx& p, int jj, LAS unsigned char* lds) {
    const bf16_t* u = (const bf16_t*)(p.ws + O_U);
    const float* side = (const float*)(p.ws + O_SIDE);
    const int tid = tidx(), lane = tid & 63, wid = tid >> 6;
    const size_t gtid = (size_t)bidx() * NTHREADS + tid, gn = (size_t)gridDim.x * NTHREADS;
    {
        bf16_t* xc = (bf16_t*)(p.ws + O_XC);
        const float* cw = p.in(3) + (size_t)jj * 4 * 4096; const float* cb = p.in(4) + (size_t)jj * 4096;
        for (size_t task = gtid; task < (size_t)1026 * 512; task += gn) {
            const int cbk = (int)(task & 511), tb = (int)(task >> 9), c0 = cbk * 8, t0 = tb * 8;
            float w[4][8], bb[8], x3[8], x2[8], x1[8];
#pragma unroll
            for (int k = 0; k < 4; ++k) ld8f(cw + (size_t)k * 4096 + c0, w[k]);
            ld8f(cb + c0, bb);
            u32x4 xr[11];
#pragma unroll
            for (int r = 0; r < 11; ++r) { const int t = t0 - 3 + r; xr[r] = (u32x4){0u, 0u, 0u, 0u}; if (t >= 0) xr[r] = *(const u32x4*)(u + (size_t)t * HYB_N + UXBC + c0); }
            unpack8(xr[0], x3); unpack8(xr[1], x2); unpack8(xr[2], x1);
#pragma unroll
            for (int tt = 0; tt < 8; ++tt) {
                const int t = t0 + tt;
                float x0[8], o[8];
                unpack8(xr[tt + 3], x0);
#pragma unroll
                for (int i = 0; i < 8; ++i) {
                    const float y = bb[i] + w[0][i] * x3[i] + w[1][i] * x2[i] + w[2][i] * x1[i] + w[3][i] * x0[i];
                    o[i] = silu_f(y);
                    x3[i] = x2[i]; x2[i] = x1[i]; x1[i] = x0[i];
                }
                u32x4 ww; ww.x = pack2(o[0], o[1]); ww.y = pack2(o[2], o[3]); ww.z = pack2(o[4], o[5]); ww.w = pack2(o[6], o[7]);
                *(u32x4*)(xc + (size_t)t * 4096 + c0) = ww;
            }
        }
    }
    {
        float* dt = (float*)(p.ws + O_DT); float* acs = (float*)(p.ws + O_ACS); float* cdec = (float*)(p.ws + O_CDEC);
        for (int c = bidx(); c < 65; c += gridDim.x)
        for (int head = wid; head < 32; head += 8) {
            const float bias = p.in(5)[jj * 32 + head], a = -__expf(p.in(6)[jj * 32 + head]);
            const int t0 = c * 128 - 112 + 2 * lane;
            float d0 = 0.f, d1 = 0.f;
            if (t0 >= 0) {
                const float x0 = side[(size_t)t0 * 64 + head] + bias, x1 = side[(size_t)(t0 + 1) * 64 + head] + bias;
                d0 = x0 > 20.f ? x0 : log1pf(__expf(x0)); d1 = x1 > 20.f ? x1 : log1pf(__expf(x1));
            }
            const float a0 = d0 * a, a1 = d1 * a;
            float s = a0 + a1;
#pragma unroll
            for (int o = 1; o < 64; o <<= 1) { const float v = __shfl_up(s, o); if (lane >= o) s += v; }
            const float ex = s - (a0 + a1);
            if (t0 >= 0) {
                dt[(size_t)t0 * 32 + head] = d0; dt[(size_t)(t0 + 1) * 32 + head] = d1;
                acs[(size_t)t0 * 32 + head] = ex + a0; acs[(size_t)(t0 + 1) * 32 + head] = s;
            }
            if (lane == 63) cdec[c * 32 + head] = __expf(s);
        }
    }
    {
        bf16_t* qt = (bf16_t*)(p.ws + O_QT); bf16_t* kt = (bf16_t*)(p.ws + O_KT); float* glast = (float*)(p.ws + O_GLAST);
        const float* w2 = p.in(9) + (size_t)jj * 16 * 1024; const float* gb = p.in(10) + (size_t)jj * 1024;
        LAS float* tot = (LAS float*)lds;
        const int d4 = tid & 15, pg = tid >> 4;
        for (int task = bidx(); task < 129 * 16; task += gridDim.x) {
            const int c = task >> 4, dbase = (task & 15) * 64 + d4 * 4, tbase = c * 64 - 48 + 2 * pg;
            f32x4 w[16];
#pragma unroll
            for (int r = 0; r < 16; ++r) w[r] = *(const f32x4*)(w2 + r * 1024 + dbase);
            const f32x4 b = *(const f32x4*)(gb + dbase);
            f32x4 g0 = {0.f, 0.f, 0.f, 0.f}, g1 = {0.f, 0.f, 0.f, 0.f};
            if (tbase >= 0) {
#pragma unroll
                for (int pos = 0; pos < 2; ++pos) {
                    const float* gl = side + (size_t)(tbase + pos) * 64 + 32;
                    f32x4 x = b;
#pragma unroll
                    for (int r4 = 0; r4 < 4; ++r4) { const f32x4 gv = *(const f32x4*)(gl + r4 * 4); x += w[r4 * 4] * gv[0] + w[r4 * 4 + 1] * gv[1] + w[r4 * 4 + 2] * gv[2] + w[r4 * 4 + 3] * gv[3]; }
                    f32x4 ls;
#pragma unroll
                    for (int e = 0; e < 4; ++e) ls[e] = (fminf(x[e], 0.f) - log1pf(__expf(-fabsf(x[e])))) * (1.f / 16.f);
                    if (pos == 0) g0 = ls; else g1 = ls;
                }
            }
            __syncthreads();
            *(LAS f32x4*)(tot + pg * 64 + d4 * 4) = g0 + g1;
            __syncthreads();
            f32x4 pre = {0.f, 0.f, 0.f, 0.f};
            for (int g = 0; g < pg; ++g) pre += *(const LAS f32x4*)(tot + g * 64 + d4 * 4);
            const f32x4 gc0 = pre + g0, gc1 = gc0 + g1;
            if (tbase >= 0) {
#pragma unroll
                for (int pos = 0; pos < 2; ++pos) {
                    const f32x4 gc = pos == 0 ? gc0 : gc1;
                    const size_t t = (size_t)(tbase + pos);
                    const u32x2 qw = *(const u32x2*)(u + t * HYB_N + UQ + dbase), kw = *(const u32x2*)(u + t * HYB_N + UK + dbase);
                    const float q[4] = {bflo(qw.x), bfhi(qw.x), bflo(qw.y), bfhi(qw.y)}, k[4] = {bflo(kw.x), bfhi(kw.x), bflo(kw.y), bfhi(kw.y)};
                    u32x2 qo, ko;
                    qo.x = pack2(q[0] * 0.0625f * __expf(gc[0]), q[1] * 0.0625f * __expf(gc[1])); qo.y = pack2(q[2] * 0.0625f * __expf(gc[2]), q[3] * 0.0625f * __expf(gc[3]));
                    ko.x = pack2(k[0] * __expf(-gc[0]), k[1] * __expf(-gc[1])); ko.y = pack2(k[2] * __expf(-gc[2]), k[3] * __expf(-gc[3]));
                    *(u32x2*)(qt + t * 1024 + dbase) = qo; *(u32x2*)(kt + t * 1024 + dbase) = ko;
                }
            }
            if (pg == 31) { f32x4 e; e[0] = __expf(gc1[0]); e[1] = __expf(gc1[1]); e[2] = __expf(gc1[2]); e[3] = __expf(gc1[3]); *(f32x4*)(glast + c * 1024 + dbase) = e; }
        }
    }
}

__device__ __forceinline__ void phase_hyb_local(const Ctx& p, LAS unsigned char* lds) {
    const int tid = tidx(), lane = tid & 63, wid = tid >> 6, fr = lane & 15, fq = lane >> 4;
    const bf16_t* xc = (const bf16_t*)(p.ws + O_XC);
    const float* dt = (const float*)(p.ws + O_DT); const float* acs = (const float*)(p.ws + O_ACS);
    const int NSSD = 65 * 8, NGLA = 129 * 16;
    for (int task = bidx(); task < NSSD + NGLA; task += gridDim.x) {
        __syncthreads();
        if (task < NSSD) {
            const int c = task >> 3, g = task & 7, tbase = c * 128 - 112;
            LAS bf16_t* Bs = (LAS bf16_t*)lds;
            LAS bf16_t* Xs = Bs + 128 * 136;
            const int tlast = tbase + 127;
            for (int item = tid; item < 128 * 16; item += NTHREADS) {
                const int j = item >> 4, cb = item & 15, t = tbase + j;
                u32x4 w = {0u, 0u, 0u, 0u};
                if (t >= 0) w = *(const u32x4*)(xc + (size_t)t * 4096 + 2048 + g * 128 + cb * 8);
                *(LAS u32x4*)(Bs + j * 136 + cb * 8) = w;
            }
            for (int item = tid; item < 128 * 32; item += NTHREADS) {
                const int j = item >> 5, cb = item & 31, hh = cb >> 3, t = tbase + j, head = g * 4 + hh;
                u32x4 w = {0u, 0u, 0u, 0u};
                if (t >= 0) {
                    float f[8]; unpack8(*(const u32x4*)(xc + (size_t)t * 4096 + g * 256 + cb * 8), f);
                    const float sc = dt[(size_t)t * 32 + head] * __expf(acs[(size_t)tlast * 32 + head] - acs[(size_t)t * 32 + head]);
                    w.x = pack2(f[0] * sc, f[1] * sc); w.y = pack2(f[2] * sc, f[3] * sc); w.z = pack2(f[4] * sc, f[5] * sc); w.w = pack2(f[6] * sc, f[7] * sc);
                }
                *(LAS u32x4*)(Xs + j * 264 + cb * 8) = w;
            }
            __syncthreads();
            float* loc = (float*)(p.ws + O_SSDLOC) + ((size_t)c * 32 + g * 4) * 64 * 128;
            const int pt = wid & 3, nh = wid >> 2;
            for (int hh = 0; hh < 4; ++hh) {
                f32x4 acc[4];
#pragma unroll
                for (int nt = 0; nt < 4; ++nt) acc[nt] = (f32x4){0.f, 0.f, 0.f, 0.f};
#pragma unroll
                for (int ks = 0; ks < 4; ++ks) {
                    const bf16x8 xf = ldfrag_tr(Xs, 264, hh * 64 + pt * 16, ks * 32, lane);
#pragma unroll
                    for (int nt = 0; nt < 4; ++nt) { const bf16x8 bf = ldfrag_tr(Bs, 136, nh * 64 + nt * 16, ks * 32, lane); acc[nt] = MFMA16(bf, xf, acc[nt]); }
                }
#pragma unroll
                for (int nt = 0; nt < 4; ++nt) *(f32x4*)(loc + ((size_t)hh * 64 + pt * 16 + fr) * 128 + nh * 64 + nt * 16 + 4 * fq) = acc[nt];
            }
        } else {
            const int gt = task - NSSD, c = gt >> 4, h = (gt >> 2) & 3, vs = gt & 3, tbase = c * 64 - 48;
            const bf16_t* u = (const bf16_t*)(p.ws + O_U); const bf16_t* kt = (const bf16_t*)(p.ws + O_KT);
            LAS bf16_t* Ks = (LAS bf16_t*)lds;
            LAS bf16_t* Vs = Ks + 64 * 264;
            for (int item = tid; item < 64 * 32; item += NTHREADS) {
                const int j = item >> 5, cb = item & 31, t = tbase + j;
                u32x4 w = {0u, 0u, 0u, 0u};
                if (t >= 0) w = *(const u32x4*)(kt + (size_t)t * 1024 + h * 256 + cb * 8);
                *(LAS u32x4*)(Ks + j * 264 + cb * 8) = w;
            }
            for (int item = tid; item < 64 * 16; item += NTHREADS) {
                const int j = item >> 4, cb = item & 15, t = tbase + j;
                u32x4 w = {0u, 0u, 0u, 0u};
                if (t >= 0) w = *(const u32x4*)(u + (size_t)t * HYB_N + UV + h * 512 + vs * 128 + cb * 8);
                *(LAS u32x4*)(Vs + j * 136 + cb * 8) = w;
            }
            __syncthreads();
            const float* glast = (const float*)(p.ws + O_GLAST) + c * 1024 + h * 256;
            bf16_t* kv = (bf16_t*)(p.ws + O_R2) + (((size_t)c * 4 + h) * 512 + vs * 128 + wid * 16 + fr) * 256;
            const bf16x8 vf0 = ldfrag_tr(Vs, 136, wid * 16, 0, lane), vf1 = ldfrag_tr(Vs, 136, wid * 16, 32, lane);
#pragma unroll
            for (int nt = 0; nt < 16; ++nt) {
                f32x4 acc = {0.f, 0.f, 0.f, 0.f};
                acc = MFMA16(ldfrag_tr(Ks, 264, nt * 16, 0, lane), vf0, acc);
                acc = MFMA16(ldfrag_tr(Ks, 264, nt * 16, 32, lane), vf1, acc);
                const f32x4 gl = *(const f32x4*)(glast + nt * 16 + 4 * fq);
                u32x2 w; w.x = pack2(acc[0] * gl[0], acc[1] * gl[1]); w.y = pack2(acc[2] * gl[2], acc[3] * gl[3]);
                *(u32x2*)(kv + nt * 16 + 4 * fq) = w;
            }
        }
    }
}

__device__ __forceinline__ void phase_hyb_scan(const Ctx& p) {
    const size_t gtid = (size_t)bidx() * NTHREADS + tidx(), gn = (size_t)gridDim.x * NTHREADS;
    for (size_t task = gtid; task < 131072; task += gn) {
        if (task < 65536) {
            const size_t e = task * 4; const int head = (int)(e >> 13);
            const float* loc = (const float*)(p.ws + O_SSDLOC) + e; bf16_t* prev = (bf16_t*)(p.ws + O_SSDPREV) + e;
            const float* cdec = (const float*)(p.ws + O_CDEC) + head;
            float zz = 0.f; asm volatile("" : "+v"(zz));
            float4 run = {zz, zz, zz, zz};
            for (int c0 = 0; c0 < 65; c0 += 13) {
                float4 l[13]; float dcy[13];
#pragma unroll
                for (int i = 0; i < 13; ++i) { l[i] = *(const float4*)(loc + (size_t)(c0 + i) * 262144); dcy[i] = cdec[(c0 + i) * 32]; }
#pragma unroll
                for (int i = 0; i < 13; ++i) {
                    u32x2 w; w.x = pack2(run.x, run.y); w.y = pack2(run.z, run.w);
                    *(u32x2*)(prev + (size_t)(c0 + i) * 262144) = w;
                    run.x = run.x * dcy[i] + l[i].x; run.y = run.y * dcy[i] + l[i].y; run.z = run.z * dcy[i] + l[i].z; run.w = run.w * dcy[i] + l[i].w;
                }
            }
        } else {
            const size_t e = (task - 65536) * 8; const int h = (int)(e >> 17), d0 = (int)(e & 255);
            const bf16_t* kv = (const bf16_t*)(p.ws + O_R2) + e; bf16_t* sp = (bf16_t*)(p.ws + O_R2 + GLA_ST_BYTES) + e;
            const float* glast = (const float*)(p.ws + O_GLAST) + h * 256 + d0;
            float run[8]; float zz = 0.f; asm volatile("" : "+v"(zz));
#pragma unroll
            for (int i = 0; i < 8; ++i) run[i] = zz;
            for (int c0 = 0; c0 < 129; c0 += 8) {
                u32x4 lw[8]; float4 ga[8], gb2[8];
#pragma unroll
                for (int i = 0; i < 8; ++i) { const int c = c0 + i < 129 ? c0 + i : 128; lw[i] = *(const u32x4*)(kv + (size_t)c * 524288); ga[i] = *(const float4*)(glast + c * 1024); gb2[i] = *(const float4*)(glast + c * 1024 + 4); }
#pragma unroll
                for (int i = 0; i < 8; ++i) {
                    if (c0 + i < 129) {
                        float l[8]; unpack8(lw[i], l);
                        u32x4 w; w.x = pack2(run[0], run[1]); w.y = pack2(run[2], run[3]); w.z = pack2(run[4], run[5]); w.w = pack2(run[6], run[7]);
                        *(u32x4*)(sp + (size_t)(c0 + i) * 524288) = w;
                        run[0] = run[0] * ga[i].x + l[0]; run[1] = run[1] * ga[i].y + l[1]; run[2] = run[2] * ga[i].z + l[2]; run[3] = run[3] * ga[i].w + l[3];
                        run[4] = run[4] * gb2[i].x + l[4]; run[5] = run[5] * gb2[i].y + l[5]; run[6] = run[6] * gb2[i].z + l[6]; run[7] = run[7] * gb2[i].w + l[7];
                    }
                }
            }
        }
    }
}
__device__ __forceinline__ void phase_hyb_out(const Ctx& p, int jj, LAS unsigned char* lds) {
    const bf16_t* xc = (const bf16_t*)(p.ws + O_XC); const bf16_t* u = (const bf16_t*)(p.ws + O_U);
    const float* dt = (const float*)(p.ws + O_DT); const float* acs = (const float*)(p.ws + O_ACS);
    bf16_t* mix = (bf16_t*)(p.ws + O_MIX);
    for (int task0 = bidx(); task0 < 1036; task0 += gridDim.x) {
        bool is_ssd; int c, sub;
        if (task0 < 8) { is_ssd = true; c = 0; sub = task0; }
        else if (task0 < 12) { is_ssd = false; c = 0; sub = task0 - 8; }
        else if (task0 < 524) { is_ssd = true; c = 1 + ((task0 - 12) >> 3); sub = (task0 - 12) & 7; }
        else { is_ssd = false; c = 1 + ((task0 - 524) >> 2); sub = (task0 - 524) & 3; }
        const int tid = tidx(), lane = tid & 63, wid = tid >> 6, fr = lane & 15, fq = lane >> 4;
        __syncthreads();
        if (is_ssd) {
            const int g = sub, tbase = c * 128 - 112;
            LAS bf16_t* Cs = (LAS bf16_t*)lds;
            LAS bf16_t* Bs = Cs + 128 * 136;
            LAS bf16_t* Xt = Bs + 128 * 136;
            LAS bf16_t* Pv = Xt + 128 * 72;
            LAS float* Acs = (LAS float*)(Pv + 64 * 136);
            for (int item = tid; item < 128 * 32; item += NTHREADS) {
                const int j = item >> 5, cb = item & 31, t = tbase + j;
                u32x4 w = {0u, 0u, 0u, 0u};
                if (t >= 0) w = *(const u32x4*)(xc + (size_t)t * 4096 + 2048 + (cb < 16 ? 0 : 1024) + g * 128 + (cb & 15) * 8);
                *(LAS u32x4*)((cb < 16 ? Bs : Cs) + j * 136 + (cb & 15) * 8) = w;
            }
            { const int j = tid & 127, hh = tid >> 7, t = tbase + j; Acs[hh * 128 + j] = t >= 0 ? acs[(size_t)t * 32 + g * 4 + hh] : 0.f; }
            __syncthreads();
            const int i_row = wid * 16 + fr, ti = tbase + i_row;
            f32x4 cb_acc[8];
#pragma unroll
            for (int nt = 0; nt < 8; ++nt) cb_acc[nt] = (f32x4){0.f, 0.f, 0.f, 0.f};
#pragma unroll
            for (int ks = 0; ks < 4; ++ks) {
                const bf16x8 cf = ldfrag(Cs, 136, wid * 16, ks * 32, lane);
#pragma unroll
                for (int nt = 0; nt < 8; ++nt) cb_acc[nt] = MFMA16(ldfrag(Bs, 136, nt * 16, ks * 32, lane), cf, cb_acc[nt]);
            }
            f32x4 yv[4][4];
#pragma unroll
            for (int k = 0; k < 4; ++k)
#pragma unroll
                for (int pt = 0; pt < 4; ++pt) yv[k][pt] = (f32x4){0.f, 0.f, 0.f, 0.f};
            float ssq = 0.f;
#pragma unroll 1
            for (int hh = 0; hh < 4; ++hh) {
                const int head = g * 4 + hh;
                __syncthreads();
                for (int item = tid; item < 128 * 8; item += NTHREADS) {
                    const int j = item >> 3, cb = item & 7, t = tbase + j;
                    u32x4 w = {0u, 0u, 0u, 0u};
                    if (t >= 0) { float f[8]; unpack8(*(const u32x4*)(xc + (size_t)t * 4096 + head * 64 + cb * 8), f); const float sc = dt[(size_t)t * 32 + head];
                        w.x = pack2(f[0] * sc, f[1] * sc); w.y = pack2(f[2] * sc, f[3] * sc); w.z = pack2(f[4] * sc, f[5] * sc); w.w = pack2(f[6] * sc, f[7] * sc); }
                    *(LAS u32x4*)(Xt + j * 72 + cb * 8) = w;
                }
                { const bf16_t* pv = (const bf16_t*)(p.ws + O_SSDPREV) + ((size_t)c * 32 + head) * 64 * 128;
                  for (int item = tid; item < 64 * 16; item += NTHREADS) { const int pp = item >> 4, cb = item & 15; *(LAS u32x4*)(Pv + pp * 136 + cb * 8) = *(const u32x4*)(pv + pp * 128 + cb * 8); } }
                const float ai = Acs[hh * 128 + i_row];
#pragma unroll
                for (int nt = 0; nt < 8; ++nt) {
                    float m[4];
#pragma unroll
                    for (int q = 0; q < 4; ++q) { const int j = nt * 16 + 4 * fq + q; m[q] = j <= i_row ? cb_acc[nt][q] * __expf(ai - Acs[hh * 128 + j]) : 0.f; }
                    u32x2 w; w.x = pack2(m[0], m[1]); w.y = pack2(m[2], m[3]);
                    *(LAS u32x2*)(Bs + i_row * 136 + nt * 16 + 4 * fq) = w;
                }
                __syncthreads();
                f32x4 yd[4], yo[4];
#pragma unroll
                for (int pt = 0; pt < 4; ++pt) { yd[pt] = (f32x4){0.f, 0.f, 0.f, 0.f}; yo[pt] = (f32x4){0.f, 0.f, 0.f, 0.f}; }
#pragma unroll
                for (int ks = 0; ks < 4; ++ks) {
                    const bf16x8 mf = ldfrag(Bs, 136, wid * 16, ks * 32, lane), cf = ldfrag(Cs, 136, wid * 16, ks * 32, lane);
#pragma unroll
                    for (int pt = 0; pt < 4; ++pt) {
                        yd[pt] = MFMA16(ldfrag_tr(Xt, 72, pt * 16, ks * 32, lane), mf, yd[pt]);
                        yo[pt] = MFMA16(ldfrag(Pv, 136, pt * 16, ks * 32, lane), cf, yo[pt]);
                    }
                }
                const float ea = __expf(ai), dsk = p.in(7)[jj * 32 + head];
#pragma unroll
                for (int pt = 0; pt < 4; ++pt) {
                    const int ch = head * 64 + pt * 16 + 4 * fq;
                    float xs[4] = {0.f, 0.f, 0.f, 0.f}, zz[4] = {0.f, 0.f, 0.f, 0.f};
                    if (ti >= 0) {
                        const u32x2 xw = *(const u32x2*)(xc + (size_t)ti * 4096 + ch), zw = *(const u32x2*)(u + (size_t)ti * HYB_N + UZ + ch);
                        xs[0] = bflo(xw.x); xs[1] = bfhi(xw.x); xs[2] = bflo(xw.y); xs[3] = bfhi(xw.y);
                        zz[0] = bflo(zw.x); zz[1] = bfhi(zw.x); zz[2] = bflo(zw.y); zz[3] = bfhi(zw.y);
                    }
#pragma unroll
                    for (int q = 0; q < 4; ++q) { const float y = (yd[pt][q] + ea * yo[pt][q] + dsk * xs[q]) * silu_f(zz[q]); ssq += y * y;
#pragma unroll
                        for (int k = 0; k < 4; ++k) yv[k][pt][q] = (k == hh) ? y : yv[k][pt][q]; }
                }
            }
            ssq += __shfl_xor(ssq, 16); ssq += __shfl_xor(ssq, 32);
            const float rs = rsqrtf(ssq * (1.f / 256.f) + 1e-6f);
            if (ti >= 0) {
                const float* nw = p.in(8) + (size_t)jj * 2048;
#pragma unroll
                for (int hh = 0; hh < 4; ++hh)
#pragma unroll
                    for (int pt = 0; pt < 4; ++pt) {
                        const int ch = (g * 4 + hh) * 64 + pt * 16 + 4 * fq;
                        const f32x4 wv = *(const f32x4*)(nw + ch);
                        u32x2 w; w.x = pack2(yv[hh][pt][0] * rs * wv[0], yv[hh][pt][1] * rs * wv[1]); w.y = pack2(yv[hh][pt][2] * rs * wv[2], yv[hh][pt][3] * rs * wv[3]);
                        *(u32x2*)(mix + (size_t)ti * 4096 + ch) = w;
                    }
            }
        } else {
            const int h = sub, tbase = c * 64 - 48;
            const bf16_t* qt = (const bf16_t*)(p.ws + O_QT); const bf16_t* kt = (const bf16_t*)(p.ws + O_KT);
            LAS bf16_t* Qs = (LAS bf16_t*)lds;
            LAS bf16_t* Ps = Qs + 64 * 264;
            LAS float* Ssq = (LAS float*)(Ps + 64 * 72);
            LAS bf16_t* Ks = (LAS bf16_t*)(Ssq + 512);
            LAS bf16_t* Vs = Ks;
            for (int item = tid; item < 64 * 64; item += NTHREADS) {
                const int j = item >> 6, cb = item & 63, t = tbase + j;
                u32x4 w = {0u, 0u, 0u, 0u};
                if (t >= 0) w = *(const u32x4*)((cb < 32 ? qt : kt) + (size_t)t * 1024 + h * 256 + (cb & 31) * 8);
                *(LAS u32x4*)((cb < 32 ? Qs : Ks) + j * 264 + (cb & 31) * 8) = w;
            }
            u32x4 vreg[8];
#pragma unroll
            for (int r = 0; r < 8; ++r) { const int item = tid + r * NTHREADS, j = item >> 6, cb = item & 63, t = tbase + j;
                vreg[r] = (u32x4){0u, 0u, 0u, 0u};
                if (t >= 0) vreg[r] = *(const u32x4*)(u + (size_t)t * HYB_N + UV + h * 512 + cb * 8); }
            __syncthreads();
#pragma unroll
            for (int rep = 0; rep < 2; ++rep) {
                const int tix = wid + rep * 8, it = tix >> 2, jt = tix & 3;
                f32x4 acc = {0.f, 0.f, 0.f, 0.f};
                if (jt <= it) {
#pragma unroll
                    for (int ks = 0; ks < 8; ++ks) acc = MFMA16(ldfrag(Ks, 264, jt * 16, ks * 32, lane), ldfrag(Qs, 264, it * 16, ks * 32, lane), acc);
                }
                const int i = it * 16 + fr;
                float m[4];
#pragma unroll
                for (int q = 0; q < 4; ++q) { const int j = jt * 16 + 4 * fq + q; m[q] = (j <= i) ? acc[q] : 0.f; }
                u32x2 w; w.x = pack2(m[0], m[1]); w.y = pack2(m[2], m[3]);
                *(LAS u32x2*)(Ps + i * 72 + jt * 16 + 4 * fq) = w;
            }
            __syncthreads();
#pragma unroll
            for (int r = 0; r < 8; ++r) { const int item = tid + r * NTHREADS, j = item >> 6, cb = item & 63; *(LAS u32x4*)(Vs + j * 520 + cb * 8) = vreg[r]; }
            __syncthreads();
            f32x4 o[4][4];
            float ssq[4] = {0.f, 0.f, 0.f, 0.f};
            const bf16_t* sp = (const bf16_t*)(p.ws + O_R2 + GLA_ST_BYTES) + ((size_t)c * 4 + h) * 512 * 256;
#pragma unroll
            for (int vs = 0; vs < 4; ++vs) {
#pragma unroll
                for (int it = 0; it < 4; ++it) o[vs][it] = (f32x4){0.f, 0.f, 0.f, 0.f};
#pragma unroll
                for (int ks = 0; ks < 2; ++ks) {
                    const bf16x8 vf = ldfrag_tr(Vs, 520, vs * 128 + wid * 16, ks * 32, lane);
#pragma unroll
                    for (int it = 0; it < 4; ++it) o[vs][it] = MFMA16(vf, ldfrag(Ps, 72, it * 16, ks * 32, lane), o[vs][it]);
                }
                const bf16_t* spw = sp + (size_t)(vs * 128 + wid * 16) * 256;
#pragma unroll
                for (int ks = 0; ks < 8; ++ks) {
                    const bf16x8 sf = gfrag(spw, 256, 0, ks * 32, lane);
#pragma unroll
                    for (int it = 0; it < 4; ++it) o[vs][it] = MFMA16(sf, ldfrag(Qs, 264, it * 16, ks * 32, lane), o[vs][it]);
                }
#pragma unroll
                for (int it = 0; it < 4; ++it) ssq[it] += o[vs][it][0] * o[vs][it][0] + o[vs][it][1] * o[vs][it][1] + o[vs][it][2] * o[vs][it][2] + o[vs][it][3] * o[vs][it][3];
            }
#pragma unroll
            for (int it = 0; it < 4; ++it) { float s = ssq[it]; s += __shfl_xor(s, 16); s += __shfl_xor(s, 32); if (fq == 0) Ssq[wid * 64 + it * 16 + fr] = s; }
            __syncthreads();
            const float* nw = p.in(11) + (size_t)jj * 2048 + h * 512;
#pragma unroll
            for (int it = 0; it < 4; ++it) {
                const int i = it * 16 + fr, t = tbase + i;
                float s = 0.f;
#pragma unroll
                for (int w8 = 0; w8 < 8; ++w8) s += Ssq[w8 * 64 + i];
                const float rs = rsqrtf(s * (1.f / 512.f) + 1e-6f);
                if (t >= 0) {
#pragma unroll
                    for (int vs = 0; vs < 4; ++vs) {
                        const int v0 = vs * 128 + wid * 16 + 4 * fq;
                        const f32x4 wv = *(const f32x4*)(nw + v0);
                        const u32x2 rw = *(const u32x2*)(u + (size_t)t * HYB_N + UR + h * 512 + v0);
                        const float r0 = bflo(rw.x), r1 = bfhi(rw.x), r2 = bflo(rw.y), r3 = bfhi(rw.y);
                        u32x2 w;
                        w.x = pack2(o[vs][it][0] * rs * wv[0] * silu_f(r0), o[vs][it][1] * rs * wv[1] * silu_f(r1));
                        w.y = pack2(o[vs][it][2] * rs * wv[2] * silu_f(r2), o[vs][it][3] * rs * wv[3] * silu_f(r3));
                        *(u32x2*)(mix + (size_t)t * 4096 + 2048 + h * 512 + v0) = w;
                    }
                }
            }
        }
    }
}
__device__ __forceinline__ void rot_pair(const u32x4 a, const u32x4 b, const float* cs, u32x4& oa, u32x4& ob) {
    float x1[8], x2[8], c[8], s[8]; unpack8(a, x1); unpack8(b, x2); ld8f(cs, c); ld8f(cs + 8, s);
    float r1[8], r2[8];
#pragma unroll
    for (int i = 0; i < 8; ++i) { r1[i] = x1[i] * c[i] - x2[i] * s[i]; r2[i] = x2[i] * c[i] + x1[i] * s[i]; }
    oa.x = pack2(r1[0], r1[1]); oa.y = pack2(r1[2], r1[3]); oa.z = pack2(r1[4], r1[5]); oa.w = pack2(r1[6], r1[7]);
    ob.x = pack2(r2[0], r2[1]); ob.y = pack2(r2[2], r2[3]); ob.z = pack2(r2[4], r2[5]); ob.w = pack2(r2[6], r2[7]);
}
__device__ __forceinline__ void phase_attn(const Ctx& p, int jj, LAS unsigned char* lds) {
    const int tid = tidx(), lane = tid & 63, wid = tid >> 6, fr = lane & 15, fq = lane >> 4;
    const bf16_t* qkv = (const bf16_t*)(p.ws + O_U);
    const float* rope = (const float*)(p.ws + O_ROPE);
    bf16_t* ao = (bf16_t*)(p.ws + O_MIX);
    LAS bf16_t* Ks = (LAS bf16_t*)lds;
    LAS bf16_t* Vt = Ks + 272 * 72;
    LAS bf16_t* Pw = Vt + 64 * 280 + wid * (16 * 168);
    for (int task0 = bidx(); task0 < 520; task0 += gridDim.x) {
        const int task = task0 < 8 ? 512 + task0 : task0 - 8;
        const bool meta = task >= 512;
        const int b = meta ? 0 : (task >> 3), kh = task & 7;
        const int nkeys = meta ? 32 : 272;
        __syncthreads();
        for (int item = tid; item < nkeys * 8; item += NTHREADS) {
            const int key = item >> 3, cb = item & 7;
            const int tok = key < 16 ? key : 16 + 128 * (b - 1) + (key - 16);
            const bool valid = meta ? (key < 16) : (key < 16 || tok >= 16);
            {
                u32x4 w = {0u, 0u, 0u, 0u};
                if (valid) w = *(const u32x4*)(qkv + (size_t)tok * QKV_N + 2560 + kh * 64 + cb * 8);
                const bf16_t e[8] = {(bf16_t)(w.x & 0xffff), (bf16_t)(w.x >> 16), (bf16_t)(w.y & 0xffff), (bf16_t)(w.y >> 16), (bf16_t)(w.z & 0xffff), (bf16_t)(w.z >> 16), (bf16_t)(w.w & 0xffff), (bf16_t)(w.w >> 16)};
#pragma unroll
                for (int i = 0; i < 8; ++i) Vt[(cb * 8 + i) * 280 + key] = e[i];
            }
            if (cb == 1) continue;
            const bf16_t* src = qkv + (size_t)tok * QKV_N + 2048 + kh * 64;
            if (cb == 0) {
                u32x4 oa = {0u, 0u, 0u, 0u}, ob = {0u, 0u, 0u, 0u};
                if (valid) rot_pair(*(const u32x4*)src, *(const u32x4*)(src + 8), rope + (size_t)tok * 16, oa, ob);
                *(LAS u32x4*)(Ks + key * 72) = oa; *(LAS u32x4*)(Ks + key * 72 + 8) = ob;
            } else {
                u32x4 w = {0u, 0u, 0u, 0u};
                if (valid) w = *(const u32x4*)(src + cb * 8);
                *(LAS u32x4*)(Ks + key * 72 + cb * 8) = w;
            }
        }
        __syncthreads();
        if (meta && wid >= 4) continue;
        const int ng = meta ? 1 : 4;
        for (int gi = 0; gi < ng; ++gi) {
            const int g = meta ? wid : gi, hq = kh * 4 + g;
            const int tq = meta ? fr : 16 + 128 * b + 16 * wid + fr;
            u32x4 q0 = *(const u32x4*)(qkv + (size_t)tq * QKV_N + hq * 64 + 8 * fq), q1 = *(const u32x4*)(qkv + (size_t)tq * QKV_N + hq * 64 + 32 + 8 * fq);
            {
                u32x4 ot; ot.x = __shfl_xor((int)q0.x, 16); ot.y = __shfl_xor((int)q0.y, 16); ot.z = __shfl_xor((int)q0.z, 16); ot.w = __shfl_xor((int)q0.w, 16);
                if (fq < 2) {
                    float mine[8], oth[8], c[8], s[8]; unpack8(q0, mine); unpack8(ot, oth); ld8f(rope + (size_t)tq * 16, c); ld8f(rope + (size_t)tq * 16 + 8, s);
                    const float sg = fq == 0 ? -1.f : 1.f;
                    float r[8];
#pragma unroll
                    for (int i = 0; i < 8; ++i) r[i] = mine[i] * c[i] + sg * oth[i] * s[i];
                    q0.x = pack2(r[0], r[1]); q0.y = pack2(r[2], r[3]); q0.z = pack2(r[4], r[5]); q0.w = pack2(r[6], r[7]);
                }
            }
            const bf16x8 qa0 = __builtin_bit_cast(bf16x8, q0), qa1 = __builtin_bit_cast(bf16x8, q1);
            const float sink = p.in(14)[jj * 32 + hq];
            const int nt = meta ? 1 : 10;
            f32x4 sc[10];
            float mx = sink;
#pragma unroll
            for (int t = 0; t < 10; ++t) {
                if (t < nt) {
                    const int krow = t == 0 ? 0 : 16 + 16 * (wid + t - 1);
                    f32x4 a = {0.f, 0.f, 0.f, 0.f};
                    a = MFMA16(ldfrag(Ks, 72, krow, 0, lane), qa0, a);
                    a = MFMA16(ldfrag(Ks, 72, krow, 32, lane), qa1, a);
#pragma unroll
                    for (int j = 0; j < 4; ++j) {
                        bool vis;
                        if (t == 0) vis = meta ? (4 * fq + j <= fr) : true;
                        else { const int rel = 16 * (t - 1) + 4 * fq + j - fr; vis = rel >= 1 && rel <= 128 && (b > 0 || 16 * wid + 16 * (t - 1) + 4 * fq + j >= 128); }
                        const float v = vis ? a[j] * 0.125f : -INFINITY;
                        a[j] = v; mx = fmaxf(mx, v);
                    }
                    sc[t] = a;
                }
            }
            mx = fmaxf(mx, __shfl_xor(mx, 16)); mx = fmaxf(mx, __shfl_xor(mx, 32));
            float den = 0.f;
#pragma unroll
            for (int t = 0; t < 10; ++t) {
                if (t < nt) {
                    float e[4];
#pragma unroll
                    for (int j = 0; j < 4; ++j) { e[j] = __expf(sc[t][j] - mx); den += e[j]; }
                    u32x2 w; w.x = pack2(e[0], e[1]); w.y = pack2(e[2], e[3]);
                    *(LAS u32x2*)(Pw + fr * 168 + t * 16 + 4 * fq) = w;
                }
            }
            if (meta) { unsigned zz = 0u; asm volatile("" : "+v"(zz)); u32x2 z = {zz, zz}; *(LAS u32x2*)(Pw + fr * 168 + 16 + 4 * fq) = z; }
            den += __shfl_xor(den, 16); den += __shfl_xor(den, 32);
            den += __expf(sink - mx);
            const float rden = 1.f / den;
            LDS_FENCE();
            f32x4 oacc[4];
#pragma unroll
            for (int dtl = 0; dtl < 4; ++dtl) oacc[dtl] = (f32x4){0.f, 0.f, 0.f, 0.f};
            const int nks = meta ? 1 : 5;
#pragma unroll
            for (int ks = 0; ks < 5; ++ks) {
                if (ks < nks) {
                    const int pc = 32 * ks + 8 * fq;
                    const bf16x8 pf = *(const LAS bf16x8*)(Pw + fr * 168 + pc);
                    const int vcol = (pc < 16 || meta) ? pc : pc + 16 * wid;
#pragma unroll
                    for (int dtl = 0; dtl < 4; ++dtl) {
                        const bf16x8 vf = *(const LAS bf16x8*)(Vt + (dtl * 16 + fr) * 280 + vcol);
                        oacc[dtl] = MFMA16(vf, pf, oacc[dtl]);
                    }
                }
            }
            LDS_FENCE();
#pragma unroll
            for (int dtl = 0; dtl < 4; ++dtl) {
                u32x2 w; w.x = pack2(oacc[dtl][0] * rden, oacc[dtl][1] * rden); w.y = pack2(oacc[dtl][2] * rden, oacc[dtl][3] * rden);
                *(u32x2*)(ao + (size_t)tq * DM + hq * 64 + dtl * 16 + 4 * fq) = w;
            }
        }
    }
}
enum { K_PREP = 0, K_HIN, K_HPREP, K_HLOCAL, K_HSCAN, K_HOUT, K_GOUT, K_LN1, K_UP, K_CONV, K_DOWN, K_LN2, K_QKV, K_ATTN };
constexpr int N_PHASES = 1 + 2 * 11 + 2 * 8;
__host__ __device__ __forceinline__ void decode_phase(int ph, int& kind, int& layer) {
    if (ph == 0) { kind = K_PREP; layer = 0; return; }
    int r = ph - 1; layer = 0;
    if (r >= 19) { r -= 19; layer = 2; }
    if (r < 11) { kind = K_HIN + r; return; }
    r -= 11; layer += 1;
    kind = r == 0 ? K_QKV : (r == 1 ? K_ATTN : K_GOUT + (r - 2));
}
__global__ void __launch_bounds__(512, 2) fwd_megakernel(Params pin) {
    extern __shared__ __attribute__((aligned(16))) unsigned char shm[];
    LAS unsigned char* lds = (LAS unsigned char*)shm;
    cg::grid_group grid = cg::this_grid();
    volatile LAS unsigned* xst = (volatile LAS unsigned*)(lds + LDS_MAIN);
    if (threadIdx.x == 0) { xst[0] = 0u; xst[1] = 0u; }
    __syncthreads();
    XcdBarrier xb = xcd_barrier_post((unsigned*)(pin.ws + O_BAR), xst);
    if (pin.ph_lo == 0) { phase_prep(pin, lds); if (pin.ph_hi > 1) grid.sync(); }
    for (int ph = pin.ph_lo < 1 ? 1 : pin.ph_lo; ph < pin.ph_hi; ++ph) {
        Ctx p; { unsigned lo = (unsigned)(size_t)pin.ws, hi = (unsigned)((size_t)pin.ws >> 32); asm volatile("" : "+s"(lo), "+s"(hi)); p.ws = (unsigned char*)(__attribute__((address_space(1))) unsigned char*)(((size_t)hi << 32) | lo); p.out = pin.out; }
        ph = __builtin_amdgcn_readfirstlane(ph);
        int kind, layer; decode_phase(ph, kind, layer);
        const int jj = layer >> 1;
        bf16_t* hb = (bf16_t*)(p.ws + O_HB); float* h = (float*)(p.ws + O_H);
        bf16_t* mix = (bf16_t*)(p.ws + O_MIX);
        switch (kind) {
        case K_HIN: case K_QKV: case K_UP: {
            const bf16_t* w; bf16_t* O; int N;
            if (kind == K_HIN) { w = (const bf16_t*)(p.ws + O_WT_HIN) + (size_t)jj * 12288 * 2048; O = (bf16_t*)(p.ws + O_U); N = HYB_N;
                const int lane = tidx() & 63, wid = tidx() >> 6; const bf16_t* ws_ = (const bf16_t*)(p.ws + O_WT_HSIDE) + (size_t)jj * 48 * 2048; float* side = (float*)(p.ws + O_SIDE);
                for (int rt = bidx() * 8 + wid; rt < 513; rt += gridDim.x * 8) {
                    for (int ct = 0; ct < 3; ++ct) {
                        const f32x4 acc = wave_gemm16(hb + (size_t)rt * 16 * 2048, ws_ + (size_t)ct * 16 * 2048, 2048, lane);
                        *(f32x4*)(side + (size_t)(rt * 16 + (lane & 15)) * 64 + ct * 16 + 4 * (lane >> 4)) = acc; } }
            } else if (kind == K_QKV) { w = (const bf16_t*)(p.ws + O_WT_QKV) + (size_t)jj * 3072 * 2048; O = (bf16_t*)(p.ws + O_U); N = QKV_N; }
            else { w = (const bf16_t*)(p.ws + O_WT_UP) + (size_t)layer * 11008 * 2048; O = (bf16_t*)(p.ws + O_R2); N = DFF2; }
            EpiStoreBf16 em{O, N}, e{O + (size_t)16 * N, N};
            gemm_full(lds, hb, w, N, 2048, em, e);
        } break;
        case K_GOUT: case K_DOWN: {
            const bf16_t* w; int K;
            if (kind == K_DOWN) { w = (const bf16_t*)(p.ws + O_WT_DOWN) + (size_t)layer * 2048 * 5504; K = DFF; }
            else if ((layer & 1) == 0) { w = (const bf16_t*)(p.ws + O_WT_HOUT) + (size_t)jj * 2048 * 4096; K = 4096; }
            else { w = (const bf16_t*)(p.ws + O_WT_SOUT) + (size_t)jj * 2048 * 2048; K = 2048; }
            EpiResF32 em{h, hb}, e{h + (size_t)16 * DM, hb + (size_t)16 * DM};
            gemm_full(lds, mix, w, 2048, K, em, e);
        } break;
        case K_HPREP: phase_hyb_prep(p, jj, lds); break;
        case K_HLOCAL: phase_hyb_local(p, lds); break;
        case K_HSCAN: phase_hyb_scan(p); break;
        case K_HOUT: phase_hyb_out(p, jj, lds); break;
        case K_ATTN: phase_attn(p, jj, lds); break;
        case K_LN1: phase_ln(p, p.in(20) + (size_t)layer * DM, p.in(21) + (size_t)layer * DM, false); break;
        case K_LN2: phase_ln(p, p.in(22) + (size_t)layer * DM, p.in(23) + (size_t)layer * DM, layer == 3); break;
        case K_CONV: phase_ffn_conv(p, layer); break;
        default: break;
        }
        if (ph + 1 < pin.ph_hi) xcd_barrier(xb);
    }
}

extern "C" void kernel_launch(void* const* d_in, const int* in_sizes, int n_in, void* d_out, int out_size, void* d_ws, size_t ws_size, hipStream_t stream) {
    static int grid = 0;
    if (grid == 0) {
        if (n_in != 24 || ws_size < WS_END) { fprintf(stderr, "kernel_launch: unexpected inputs (n_in %d, ws %zu, need %zu)\n", n_in, ws_size, (size_t)WS_END); grid = -1; return; }
        int dev = 0, cus = 0, per_cu = 0;
        (void)hipGetDevice(&dev);
        (void)hipDeviceGetAttribute(&cus, hipDeviceAttributeMultiprocessorCount, dev);
        if (hipFuncSetAttribute((const void*)fwd_megakernel, hipFuncAttributeMaxDynamicSharedMemorySize, LDS_BYTES) != hipSuccess) { fprintf(stderr, "kernel_launch: hipFuncSetAttribute failed\n"); grid = -1; return; }
        if (hipOccupancyMaxActiveBlocksPerMultiprocessor(&per_cu, (const void*)fwd_megakernel, NTHREADS, LDS_BYTES) != hipSuccess || per_cu < 1) { fprintf(stderr, "kernel_launch: occupancy query gave %d\n", per_cu); per_cu = 1; }
        (void)hipGetLastError();
        grid = cus * per_cu;
        if (grid > 256) grid = 256;
        fprintf(stderr, "kernel_launch: grid %d (cus %d, per_cu %d), ws need %zu of %zu\n", grid, cus, per_cu, (size_t)WS_END, ws_size);
    }
    if (grid < 0) return;
    Params p{};
    for (int i = 0; i < 24; ++i) p.in[i] = (const float*)d_in[i];
    p.out = (float*)d_out; p.ws = (unsigned char*)d_ws;
    for (int i = 0; i < 8; ++i) p.inv_freq[i] = powf(500000.0f, -(float)i / 8.0f);
#if PER_PHASE_LAUNCH
    for (int ph = 0; ph < N_PHASES; ++ph) {
        p.ph_lo = ph; p.ph_hi = ph + 1;
        hipLaunchKernelGGL(fwd_megakernel, dim3(grid), dim3(NTHREADS), LDS_BYTES, stream, p);
        { int kind, layer; decode_phase(ph, kind, layer); if ((DUP_MASK >> kind) & 1) hipLaunchKernelGGL(fwd_megakernel, dim3(grid), dim3(NTHREADS), LDS_BYTES, stream, p); }
    }
#else
    p.ph_lo = 0; p.ph_hi = N_PHASES;
    if (hipMemsetAsync((unsigned char*)d_ws + O_BAR, 0, XCD_BAR_WORDS * 4, stream) != hipSuccess) fprintf(stderr, "kernel_launch: memset failed\n");
    void* args[] = {&p};
    hipError_t e = hipLaunchCooperativeKernel((const void*)fwd_megakernel, dim3(grid), dim3(NTHREADS), args, LDS_BYTES, stream);
    if (e != hipSuccess) fprintf(stderr, "cooperative launch failed: %s (grid %d)\n", hipGetErrorString(e), grid);
#endif
}
```

```cpp
#include <hip/hip_runtime.h>
#include <hip/hip_cooperative_groups.h>
#include <cstdio>
#include <cmath>
namespace cg = cooperative_groups;
#ifndef PER_PHASE_LAUNCH
#define PER_PHASE_LAUNCH 0
#endif
__device__ __forceinline__ int tidx() { int t = threadIdx.x; asm volatile("" : "+v"(t)); return t; }
__device__ __forceinline__ int bidx() { int b = blockIdx.x; asm volatile("" : "+s"(b)); return b; }
#ifndef DUP_MASK
#define DUP_MASK 0
#endif
namespace pg8 {
#define PG8_LAS __attribute__((address_space(3)))
typedef unsigned short bf16_t;
typedef short bf16x8 __attribute__((ext_vector_type(8)));
typedef float f32x4 __attribute__((ext_vector_type(4)));
typedef unsigned u32x4 __attribute__((ext_vector_type(4)));
constexpr int BM = 256, BK = 64, HALF = 128, HTB = HALF * BK * 2  , STAGE_BYTES = 8 * HTB, NXCD = 8, WGM = 8;

__host__ __device__ __forceinline__ int lds_byte(int r, int c) { const int st = (r >> 4) * 2 + (c >> 5), rr = r & 15, cc = c & 31, ob = rr * 64 + cc * 2; return st * 1024 + (ob ^ (((ob >> 9) & 1) << 5)); }
__host__ __device__ __forceinline__ void stage_rc(int b, int& R, int& C) { const int st = b / 1024, sb = b % 1024, swz = sb ^ (((sb >> 9) & 1) << 5); R = (st >> 1) * 16 + swz / 64; C = (st & 1) * 32 + (swz % 64) / 2; }
__host__ __device__ __forceinline__ int perm32(int rho) { const int n = rho >> 4, i = rho & 15; return 8 * (i >> 2) + 4 * n + (i & 3); }

struct Unit { int pm, pn; };
struct Gemm { const bf16_t* A; const bf16_t* Bt; int M, N, K; };

struct StaticOrder {
    int nM, nN, nwg, G, c;
    __host__ __device__ void init(int M, int N, int G_, int c_) { nM = M / BM; nN = N / BM; nwg = nM * nN; G = G_; c = c_; }
    __host__ __device__ bool next(int i, Unit& u) const {
        const long L = (long)i * G + c; if (L >= nwg) return false;
        int wgid = (int)L; { const int q = nwg / NXCD, r = nwg % NXCD, xcd = wgid % NXCD, off = wgid / NXCD; wgid = (xcd < r ? xcd * (q + 1) : r * (q + 1) + (xcd - r) * q) + off; }
        const int nig = WGM * nN, gid = wgid / nig, fm = gid * WGM, gsz = (nM - fm) < WGM ? (nM - fm) : WGM;
        u.pm = fm + ((wgid % nig) % gsz); u.pn = (wgid % nig) / gsz; return true;
    }
    __device__ __forceinline__ void a_ready(const Unit&) const {}
    __device__ __forceinline__ void done(const Unit&) const {}
};
__device__ __forceinline__ unsigned cvt_pk_bf16(float lo, float hi) { unsigned r; asm volatile("v_cvt_pk_bf16_f32 %0, %1, %2" : "=v"(r) : "v"(lo), "v"(hi)); return r; }
typedef float f32x2 __attribute__((ext_vector_type(2)));

template <class Epi, class Sched, bool STAMP = false>
__device__ __forceinline__ void gemm_phase(PG8_LAS unsigned char* lds, const Gemm g, const Sched& S, const Epi& E, unsigned long long* stamps) {
    const int tid = tidx(), wid = __builtin_amdgcn_readfirstlane(tid >> 6), lane = tid & 63, wr = wid >> 2, wc = wid & 3, fr = lane & 15, fq = lane >> 4;
    const int K = g.K, nt = K / BK;
    int ts_lo = 0, ts_hi = 0, nts = 0; const unsigned long long rt_entry = STAMP ? (unsigned long long)wall_clock64() : 0ull;
#define PG8_STAMP() do { if (STAMP && wid == 0 && nts < 64) { const unsigned long long _c = (unsigned long long)clock64(); \
        ts_lo = (lane == nts) ? (int)(unsigned)_c : ts_lo; ts_hi = (lane == nts) ? (int)(unsigned)(_c >> 32) : ts_hi; ++nts; } } while (0)
    PG8_STAMP();
    unsigned voffA[2], voffB[2];
#pragma unroll
    for (int i = 0; i < 2; ++i) { int R, C; stage_rc(tid * 16 + i * 8192, R, C); const int Rb = Epi::PERM ? ((R & ~31) + perm32(R & 31)) : R;
        voffA[i] = (unsigned)(R * K + C) * 2u; voffB[i] = (unsigned)(Rb * K + C) * 2u; }
    const size_t kstep = (size_t)(BK * 2);
    const size_t hstep = (size_t)HALF * K * 2;
    const size_t tstep = 2 * hstep;
    const unsigned ldsw = (unsigned)wid * 1024u;
    const int aoff = lds_byte(wr * 64 + fr, fq * 8), boff = lds_byte(wc * 32 + fr, fq * 8);
#define PG8_SA(b, h) (((b) * 2 + (h)) * HTB)
#define PG8_SB(b, h) ((4 + (b) * 2 + (h)) * HTB)
#define PG8_STAGE(bufoff, gbase, voff) do { _Pragma("unroll") for (int _i = 0; _i < 2; ++_i) \
        __builtin_amdgcn_global_load_lds((const unsigned*)((const char*)(gbase) + (voff)[_i]), (PG8_LAS unsigned*)(lds + (bufoff) + ldsw + _i * 8192), 16, 0, 0); } while (0)
#define PG8_LDA(dst, b, h) do { _Pragma("unroll") for (int m = 0; m < 4; ++m) _Pragma("unroll") for (int k = 0; k < 2; ++k) dst[m][k] = *(const PG8_LAS bf16x8*)(lds + PG8_SA(b, h) + aoff + m * 2048 + k * 1024); } while (0)
#define PG8_LDB(dst, b, h) do { _Pragma("unroll") for (int n = 0; n < 2; ++n) _Pragma("unroll") for (int k = 0; k < 2; ++k) dst[n][k] = *(const PG8_LAS bf16x8*)(lds + PG8_SB(b, h) + boff + n * 2048 + k * 1024); } while (0)
#define PG8_MMA(ai, bj, At, Bt) do { __builtin_amdgcn_s_setprio(1); _Pragma("unroll") for (int m = 0; m < 4; ++m) _Pragma("unroll") for (int n = 0; n < 2; ++n) _Pragma("unroll") for (int k = 0; k < 2; ++k) \
        acc[ai][bj][m][n] = __builtin_amdgcn_mfma_f32_16x16x32_bf16(Bt[n][k], At[m][k], acc[ai][bj][m][n], 0, 0, 0); __builtin_amdgcn_s_setprio(0); } while (0)
#define PG8_WAIT_V(n) asm volatile("s_waitcnt vmcnt(" #n ")" ::: "memory")
#define PG8_WAIT_L(n) asm volatile("s_waitcnt lgkmcnt(" #n ")" ::: "memory")
#define PG8_BAR __builtin_amdgcn_s_barrier()
#define PG8_SCHED __builtin_amdgcn_sched_barrier(0)
    Unit cur, nxt; int ui = 0;
    if (!S.next(0, cur)) return;
    f32x4 acc[2][2][4][2];
#pragma unroll
    for (int a = 0; a < 2; ++a)
#pragma unroll
        for (int b = 0; b < 2; ++b)
#pragma unroll
            for (int m = 0; m < 4; ++m)
#pragma unroll
                for (int n = 0; n < 2; ++n) acc[a][b][m][n] = (f32x4){0.f, 0.f, 0.f, 0.f};
    bf16x8 At[4][2], B0[2][2], B1[2][2];
    const char* cA = (const char*)g.A + (size_t)cur.pm * tstep; const char* cB = (const char*)g.Bt + (size_t)cur.pn * tstep;
    S.a_ready(cur);
    PG8_STAGE(PG8_SB(0, 0), cB, voffB); PG8_STAGE(PG8_SA(0, 0), cA, voffA); PG8_STAGE(PG8_SB(0, 1), cB + hstep, voffB); PG8_STAGE(PG8_SA(0, 1), cA + hstep, voffA);
    if (wr == 1) PG8_BAR;
    PG8_WAIT_V(4); PG8_BAR;
    PG8_STAGE(PG8_SB(1, 0), cB + kstep, voffB); PG8_STAGE(PG8_SA(1, 0), cA + kstep, voffA); PG8_STAGE(PG8_SB(1, 1), cB + hstep + kstep, voffB);
    PG8_WAIT_V(6); PG8_BAR;
    PG8_STAMP();
    for (;;) {
        const bool has_next = S.next(ui + 1, nxt);
        const char* nA = has_next ? (const char*)g.A + (size_t)nxt.pm * tstep : cA; const char* nB = has_next ? (const char*)g.Bt + (size_t)nxt.pn * tstep : cB;
        for (int t = 0; t < nt; t += 2) {
            const bool last = (t == nt - 2);
            const char* a1 = cA + (size_t)(t + 1) * kstep;
            const char* a2 = last ? nA : cA + (size_t)(t + 2) * kstep; const char* b2 = last ? nB : cB + (size_t)(t + 2) * kstep;
            const char* a3 = a2 + kstep; const char* b3 = b2 + kstep;
            if (last && has_next) S.a_ready(nxt);
            PG8_LDB(B0, 0, 0); PG8_SCHED; PG8_LDA(At, 0, 0); PG8_STAGE(PG8_SA(1, 1), a1 + hstep, voffA);
            PG8_WAIT_L(8); PG8_BAR; PG8_WAIT_L(0); PG8_MMA(0, 0, At, B0); PG8_BAR; PG8_SCHED;
            PG8_LDB(B1, 0, 1); PG8_STAGE(PG8_SB(0, 0), b2, voffB);
            PG8_BAR; PG8_WAIT_L(0); PG8_MMA(0, 1, At, B1); PG8_BAR;
            PG8_LDA(At, 0, 1); PG8_STAGE(PG8_SA(0, 0), a2, voffA);
            PG8_BAR; PG8_WAIT_L(0); PG8_MMA(1, 0, At, B0); PG8_BAR; PG8_SCHED;
            PG8_STAGE(PG8_SB(0, 1), b2 + hstep, voffB);
            PG8_WAIT_V(6); PG8_BAR; PG8_MMA(1, 1, At, B1); PG8_BAR;
            PG8_LDB(B0, 1, 0); PG8_SCHED; PG8_LDA(At, 1, 0); PG8_STAGE(PG8_SA(0, 1), a2 + hstep, voffA);
            PG8_WAIT_L(8); PG8_BAR; PG8_WAIT_L(0); PG8_MMA(0, 0, At, B0); PG8_BAR; PG8_SCHED;
            PG8_LDB(B1, 1, 1); PG8_STAGE(PG8_SB(1, 0), b3, voffB);
            PG8_BAR; PG8_WAIT_L(0); PG8_MMA(0, 1, At, B1); PG8_BAR;
            PG8_LDA(At, 1, 1); PG8_STAGE(PG8_SA(1, 0), a3, voffA);
            PG8_BAR; PG8_WAIT_L(0); PG8_MMA(1, 0, At, B0); PG8_BAR; PG8_SCHED;
            PG8_STAGE(PG8_SB(1, 1), b3 + hstep, voffB);
            PG8_WAIT_V(6); PG8_BAR; PG8_MMA(1, 1, At, B1); PG8_BAR;
        }
        PG8_STAMP();
        if constexpr (!Epi::AFTER_DRAIN) { E(acc, cur, wr, wc, fr, fq); S.done(cur); }
        PG8_STAMP();
        if (!has_next) break;
#pragma unroll
        for (int a = 0; a < 2; ++a)
#pragma unroll
            for (int b = 0; b < 2; ++b)
#pragma unroll
                for (int m = 0; m < 4; ++m)
#pragma unroll
                    for (int n = 0; n < 2; ++n) acc[a][b][m][n] = (f32x4){0.f, 0.f, 0.f, 0.f};
        cur = nxt; cA = nA; cB = nB; ++ui;
    }
    PG8_WAIT_V(0);
    if (wr == 0) PG8_BAR;
    PG8_BAR;
    if constexpr (Epi::AFTER_DRAIN) { E.fused(acc, cur, wr, wc, fr, fq, lds, wid, lane); S.done(cur); }
    PG8_STAMP();
    if (STAMP && wid == 0) { stamps[lane] = lane < nts ? (((unsigned long long)(unsigned)ts_hi << 32) | (unsigned)ts_lo) : 0ull;
        if (lane == 62) stamps[62] = rt_entry; if (lane == 63) stamps[63] = (unsigned long long)wall_clock64(); }
#undef PG8_STAMP
#undef PG8_SA
#undef PG8_SB
#undef PG8_STAGE
#undef PG8_LDA
#undef PG8_LDB
#undef PG8_MMA
#undef PG8_WAIT_V
#undef PG8_WAIT_L
#undef PG8_BAR
#undef PG8_SCHED
}
}
using pg8::bf16_t; using pg8::bf16x8; using pg8::f32x4; using pg8::u32x4;
#define LAS __attribute__((address_space(3)))
typedef unsigned u32x2 __attribute__((ext_vector_type(2)));

constexpr int L_TOK = 8208, DM = 2048;
constexpr int HYB_N = 12288, DFF = 5504, DFF2 = 11008, QKV_N = 3072;
constexpr int UZ = 0, UXBC = 2048, UQ = 6144, UK = 7168, UV = 8192, UR = 10240;
constexpr float ALPHA = 1.6817928305074292f;
constexpr int NTHREADS = 512;
constexpr int LDS_MAIN = 143360;
constexpr int LDS_BYTES = LDS_MAIN + 256;

constexpr size_t al256(size_t x) { return (x + 255) & ~(size_t)255; }
constexpr size_t O_WT_HIN   = 0;
constexpr size_t O_WT_HSIDE = O_WT_HIN   + al256(2ull * 12288 * 2048 * 2);
constexpr size_t O_WT_HOUT  = O_WT_HSIDE + al256(2ull * 48 * 2048 * 2);
constexpr size_t O_WT_QKV   = O_WT_HOUT  + al256(2ull * 2048 * 4096 * 2);
constexpr size_t O_WT_SOUT  = O_WT_QKV   + al256(2ull * 3072 * 2048 * 2);
constexpr size_t O_WT_UP    = O_WT_SOUT  + al256(2ull * 2048 * 2048 * 2);
constexpr size_t O_WT_DOWN  = O_WT_UP    + al256(4ull * 11008 * 2048 * 2);
constexpr size_t O_H        = O_WT_DOWN  + al256(4ull * 2048 * 5504 * 2);
constexpr size_t O_HB       = O_H        + al256((size_t)L_TOK * 2048 * 4);
constexpr size_t O_U        = O_HB       + al256((size_t)L_TOK * 2048 * 2);
constexpr size_t O_R2       = O_U        + al256((size_t)L_TOK * 12288 * 2);
constexpr size_t GLA_ST_BYTES = 129ull * 4 * 512 * 256 * 2;
constexpr size_t O_MIX      = O_R2       + al256(2 * GLA_ST_BYTES);
constexpr size_t O_XC       = O_MIX      + al256((size_t)L_TOK * 5504 * 2);
constexpr size_t O_SIDE     = O_XC       + al256((size_t)L_TOK * 4096 * 2);
constexpr size_t O_DT       = O_SIDE     + al256((size_t)L_TOK * 64 * 4);
constexpr size_t O_ACS      = O_DT       + al256((size_t)L_TOK * 32 * 4);
constexpr size_t O_QT       = O_ACS      + al256((size_t)L_TOK * 32 * 4);
constexpr size_t O_KT       = O_QT       + al256((size_t)L_TOK * 1024 * 2);
constexpr size_t O_GLAST    = O_KT       + al256((size_t)L_TOK * 1024 * 2);
constexpr size_t O_CDEC     = O_GLAST    + al256(129ull * 1024 * 4);
constexpr size_t O_SSDLOC   = O_CDEC     + al256(65ull * 32 * 4);
constexpr size_t O_SSDPREV  = O_SSDLOC   + al256(65ull * 32 * 64 * 128 * 4);
constexpr size_t O_ROPE     = O_SSDPREV  + al256(65ull * 32 * 64 * 128 * 2);
constexpr size_t O_TAB      = O_ROPE     + al256((size_t)L_TOK * 16 * 4);
constexpr size_t O_BAR      = O_TAB      + 256;
constexpr size_t WS_END     = O_BAR      + al256(4096 * 4);
static_assert(WS_END <= 1442840576ull, "workspace too large");

struct Params {
    const float* in[24];
    float* out;
    unsigned char* ws;
    float inv_freq[8];
    int ph_lo, ph_hi;
};

struct Ctx { unsigned char* ws; float* out;
    __device__ __forceinline__ const float* in(int k) const { const size_t a = ((const size_t*)(ws + O_TAB))[k]; return (const float*)(const __attribute__((address_space(1))) float*)a; } };

__device__ __forceinline__ bf16_t f2bf(float f) { unsigned u = __float_as_uint(f); u += 0x7FFFu + ((u >> 16) & 1u); return (bf16_t)(u >> 16); }
__device__ __forceinline__ float bf2f(bf16_t b) { return __uint_as_float(((unsigned)b) << 16); }
__device__ __forceinline__ unsigned pack2(float lo, float hi) { unsigned r; asm("v_cvt_pk_bf16_f32 %0, %1, %2" : "=v"(r) : "v"(lo), "v"(hi)); return r; }
__device__ __forceinline__ float bflo(unsigned w) { return __uint_as_float(w << 16); }
__device__ __forceinline__ float bfhi(unsigned w) { return __uint_as_float(w & 0xffff0000u); }
__device__ __forceinline__ float silu_f(float x) { return x / (1.f + __expf(-x)); }
__device__ __forceinline__ float wave_sum(float v) {
#pragma unroll
    for (int o = 32; o > 0; o >>= 1) v += __shfl_xor(v, o);
    return v;
}
__device__ __forceinline__ bf16x8 ldfrag(const LAS bf16_t* base, int ld, int row0, int k0, int lane) {
    return *(const LAS bf16x8*)(base + (row0 + (lane & 15)) * ld + k0 + 8 * (lane >> 4));
}
__device__ __forceinline__ bf16x8 gfrag(const bf16_t* base, size_t ld, int row0, int k0, int lane) {
    return *(const bf16x8*)(base + (size_t)(row0 + (lane & 15)) * ld + k0 + 8 * (lane >> 4));
}
typedef short s16x4 __attribute__((ext_vector_type(4)));
__device__ __forceinline__ bf16x8 ldfrag_tr(const LAS bf16_t* base, int ld, int n0, int k0, int lane) {
    const int g = lane >> 4, i = lane & 15, q = i >> 2, pp = i & 3;
    const LAS bf16_t* a = base + (k0 + 8 * g + q) * ld + n0 + 4 * pp;
    const s16x4 r1 = __builtin_amdgcn_ds_read_tr16_b64_v4i16((LAS s16x4*)a);
    const s16x4 r2 = __builtin_amdgcn_ds_read_tr16_b64_v4i16((LAS s16x4*)(a + 4 * ld));
    return __builtin_shufflevector(r1, r2, 0, 1, 2, 3, 4, 5, 6, 7);
}
#define MFMA16(a, b, c) __builtin_amdgcn_mfma_f32_16x16x32_bf16((a), (b), (c), 0, 0, 0)
#define LDS_FENCE() asm volatile("s_waitcnt lgkmcnt(0)" ::: "memory")

struct EpiStoreBf16 {
    static constexpr bool PERM = true, AFTER_DRAIN = false;
    bf16_t* O; int ldc;
    __device__ __forceinline__ void operator()(const f32x4 (&acc)[2][2][4][2], const pg8::Unit& u, int wr, int wc, int fr, int fq) const {
        const int row0 = u.pm * 256 + wr * 64 + fr, col0 = u.pn * 256 + wc * 32 + 8 * fq;
#pragma unroll
        for (int ai = 0; ai < 2; ++ai)
#pragma unroll
            for (int m = 0; m < 4; ++m) { bf16_t* rowp = O + (size_t)(row0 + ai * 128 + m * 16) * ldc + col0;
#pragma unroll
                for (int bj = 0; bj < 2; ++bj) { const f32x4 v0 = acc[ai][bj][m][0], v1 = acc[ai][bj][m][1];
                    u32x4 w; w.x = pg8::cvt_pk_bf16(v0[0], v0[1]); w.y = pg8::cvt_pk_bf16(v0[2], v0[3]); w.z = pg8::cvt_pk_bf16(v1[0], v1[1]); w.w = pg8::cvt_pk_bf16(v1[2], v1[3]);
                    *(u32x4*)(rowp + bj * 128) = w; } }
    }
    __device__ __forceinline__ void meta(int row, int col, f32x4 v) const {
        u32x2 w; w.x = pg8::cvt_pk_bf16(v[0], v[1]); w.y = pg8::cvt_pk_bf16(v[2], v[3]);
        *(u32x2*)(O + (size_t)row * ldc + col) = w;
    }
};
struct EpiResF32 {
    static constexpr bool PERM = false, AFTER_DRAIN = false;
    float* H; const bf16_t* HB;
    __device__ __forceinline__ void operator()(const f32x4 (&acc)[2][2][4][2], const pg8::Unit& u, int wr, int wc, int fr, int fq) const {
        const int row0 = u.pm * 256 + wr * 64 + fr, col0 = u.pn * 256 + wc * 32 + 4 * fq;
#pragma unroll
        for (int ai = 0; ai < 2; ++ai)
#pragma unroll
            for (int m = 0; m < 4; ++m) { const size_t ro = (size_t)(row0 + ai * 128 + m * 16) * DM + col0;
#pragma unroll
                for (int bj = 0; bj < 2; ++bj)
#pragma unroll
                    for (int n = 0; n < 2; ++n) { const size_t o = ro + bj * 128 + n * 16; const u32x2 hw = *(const u32x2*)(HB + o);
                        const f32x4 hv = {bflo(hw.x), bfhi(hw.x), bflo(hw.y), bfhi(hw.y)}; *(f32x4*)(H + o) = hv * ALPHA + acc[ai][bj][m][n]; } }
    }
    __device__ __forceinline__ void meta(int row, int col, f32x4 v) const {
        const size_t o = (size_t)row * DM + col; const u32x2 hw = *(const u32x2*)(HB + o);
        const f32x4 hv = {bflo(hw.x), bfhi(hw.x), bflo(hw.y), bfhi(hw.y)}; *(f32x4*)(H + o) = hv * ALPHA + v;
    }
};
__device__ __forceinline__ f32x4 wave_gemm16(const bf16_t* A, const bf16_t* Bt, int K, int lane) {
    f32x4 acc = {0.f, 0.f, 0.f, 0.f};
    const bf16_t* pa = A + (size_t)(lane & 15) * K + 8 * (lane >> 4);
    const bf16_t* pb = Bt + (size_t)(lane & 15) * K + 8 * (lane >> 4);
#pragma unroll 16
    for (int k0 = 0; k0 < K; k0 += 32) {
        const bf16x8 a = *(const bf16x8*)(pa + k0), b = *(const bf16x8*)(pb + k0);
        acc = MFMA16(b, a, acc);
    }
    return acc;
}
template <class Epi>
__device__ __forceinline__ void gemm_full(LAS unsigned char* lds, const bf16_t* A, const bf16_t* Bt, int N, int K, const Epi& Emeta, const Epi& Emain) {
    const int lane = tidx() & 63, wid = tidx() >> 6;
    for (int tile = bidx() * 8 + wid; tile < N / 16; tile += gridDim.x * 8) {
        const f32x4 acc = wave_gemm16(A, Bt + (size_t)tile * 16 * K, K, lane);
        Emeta.meta(lane & 15, tile * 16 + 4 * (lane >> 4), acc);
    }
    pg8::Gemm g{A + (size_t)16 * K, Bt, 8192, N, K};
    pg8::StaticOrder S; S.init(8192, N, (int)gridDim.x, (int)bidx());
    pg8::gemm_phase<Epi, pg8::StaticOrder, false>(lds, g, S, Emain, nullptr);
    __syncthreads();
}
#define XB_TMO      128
#define XB_XCNT(j)  (256  + 64 * (j))
#define XB_XSUB(j)  (1280 + 64 * (j))
#define XB_XGEN(j)  (2304 + 64 * (j))
#define XB_TOP      3328
#define XB_TOPGEN   3392
#define XCD_BAR_WORDS 3456
#define XB_SPIN_CAP (1u << 18)

__device__ __forceinline__ unsigned xb_ld(unsigned* p)              { return __hip_atomic_load(p, __ATOMIC_RELAXED, __HIP_MEMORY_SCOPE_AGENT); }
__device__ __forceinline__ unsigned xb_add(unsigned* p, unsigned v) { return __hip_atomic_fetch_add(p, v, __ATOMIC_RELAXED, __HIP_MEMORY_SCOPE_AGENT); }
__device__ __forceinline__ unsigned xb_xcc_id() { return (unsigned)__builtin_amdgcn_s_getreg((3 << 11) | 20) & 0xFu; }
#define XB_SPIN(cond, bar) do { unsigned _sp = 0; while (cond) { __builtin_amdgcn_s_sleep(1); \
    if ((++_sp & 255u) == 0u) { if (xb_ld(&(bar)[XB_TMO])) break; if (_sp > XB_SPIN_CAP) { atomicAdd(&(bar)[XB_TMO], 1u); break; } } } } while (0)

struct XcdBarrier {
    unsigned* bar; unsigned x;
    volatile LAS unsigned* st;
};

__device__ __forceinline__ XcdBarrier xcd_barrier_post(unsigned* bar, volatile LAS unsigned* st) {
    XcdBarrier b; b.bar = bar; b.x = xb_xcc_id(); b.st = st;
    if (threadIdx.x == 0) (void)xb_add(&bar[XB_XCNT(b.x)], 1u);
    return b;
}
__device__ __forceinline__ void xcd_barrier_complete(unsigned* bar, unsigned x, unsigned& nloc, unsigned& nx) {
    const unsigned G = gridDim.x * gridDim.y * gridDim.z;
    unsigned sum, cnt, mine, sp = 0u;
    for (;;) {
        sum = 0u; cnt = 0u; mine = 0u;
#pragma unroll
        for (unsigned j = 0; j < 16; ++j) { const unsigned c = xb_ld(&bar[XB_XCNT(j)]); sum += c; cnt += (c > 0u) ? 1u : 0u; mine = (j == x) ? c : mine; }
        if (sum == G) break;
        __builtin_amdgcn_s_sleep(1);
        if ((++sp & 255u) == 0u) { if (xb_ld(&bar[XB_TMO])) break; if (sp > XB_SPIN_CAP) { atomicAdd(&bar[XB_TMO], 1u); break; } }
    }
    nloc = mine > 0u ? mine : 1u; nx = cnt > 0u ? cnt : 1u;
}

__device__ __forceinline__ void xcd_barrier(const XcdBarrier& b) {
    asm volatile("s_waitcnt vmcnt(0)" ::: "memory");
    __syncthreads();
    if (threadIdx.x == 0) {
        unsigned* bar = b.bar;
        __builtin_amdgcn_s_waitcnt(0);
        unsigned nloc = b.st[0], nx = b.st[1];
        if (nloc == 0u) { xcd_barrier_complete(bar, b.x, nloc, nx); b.st[0] = nloc; b.st[1] = nx; }
        const unsigned old = xb_add(&bar[XB_XSUB(b.x)], 1u);
        const unsigned gen = old / nloc;
        if (old + 1u == (gen + 1u) * nloc) {
            __builtin_amdgcn_fence(__ATOMIC_RELEASE, "agent");
            asm volatile("s_waitcnt vmcnt(0)" ::: "memory");
            const unsigned og = xb_add(&bar[XB_TOP], 1u);
            const unsigned tg = og / nx;
            if (og + 1u == (tg + 1u) * nx) xb_add(&bar[XB_TOPGEN], 1u);
            else XB_SPIN(xb_ld(&bar[XB_TOPGEN]) == tg, bar);
            __builtin_amdgcn_fence(__ATOMIC_ACQUIRE, "agent");
            xb_add(&bar[XB_XGEN(b.x)], 1u);
            asm volatile("s_waitcnt vmcnt(0)" ::: "memory");
        } else {
            XB_SPIN(xb_ld(&bar[XB_XGEN(b.x)]) == gen, bar);
            __builtin_amdgcn_fence(__ATOMIC_ACQUIRE, "agent");
            asm volatile("s_waitcnt vmcnt(0)" ::: "memory");
        }
    }
    __syncthreads();
}
struct TJob { const float* src; int ld, ncols, K; bf16_t* dst; };
__device__ __forceinline__ TJob get_job(const Params& p, int j) {
    TJob J;
    bf16_t* ws16 = (bf16_t*)p.ws;
    if (j < 10) {
        const int jj = j / 5, sub = j % 5;
        const float* base = p.in[2] + (size_t)jj * 2048 * 12336;
        bf16_t* wmain = (bf16_t*)(p.ws + O_WT_HIN) + (size_t)jj * 12288 * 2048;
        bf16_t* wside = (bf16_t*)(p.ws + O_WT_HSIDE) + (size_t)jj * 48 * 2048;
        J.ld = 12336; J.K = 2048;
        if (sub == 0)      { J.src = base;          J.ncols = 6144; J.dst = wmain; }
        else if (sub == 1) { J.src = base + 6176;   J.ncols = 4096; J.dst = wmain + (size_t)6144 * 2048; }
        else if (sub == 2) { J.src = base + 10288;  J.ncols = 2048; J.dst = wmain + (size_t)10240 * 2048; }
        else if (sub == 3) { J.src = base + 6144;   J.ncols = 32;   J.dst = wside; }
        else               { J.src = base + 10272;  J.ncols = 16;   J.dst = wside + (size_t)32 * 2048; }
    } else if (j < 12) { const int jj = j - 10; J.src = p.in[12] + (size_t)jj * 4096 * 2048; J.ld = 2048; J.ncols = 2048; J.K = 4096; J.dst = (bf16_t*)(p.ws + O_WT_HOUT) + (size_t)jj * 2048 * 4096; }
    else if (j < 14) { const int jj = j - 12; J.src = p.in[13] + (size_t)jj * 2048 * 3072; J.ld = 3072; J.ncols = 3072; J.K = 2048; J.dst = (bf16_t*)(p.ws + O_WT_QKV) + (size_t)jj * 3072 * 2048; }
    else if (j < 16) { const int jj = j - 14; J.src = p.in[15] + (size_t)jj * 2048 * 2048; J.ld = 2048; J.ncols = 2048; J.K = 2048; J.dst = (bf16_t*)(p.ws + O_WT_SOUT) + (size_t)jj * 2048 * 2048; }
    else if (j < 20) { const int l = j - 16; J.src = p.in[16] + (size_t)l * 2048 * 11008; J.ld = 11008; J.ncols = 11008; J.K = 2048; J.dst = (bf16_t*)(p.ws + O_WT_UP) + (size_t)l * 11008 * 2048; }
    else { const int l = j - 20; J.src = p.in[19] + (size_t)l * 5504 * 2048; J.ld = 2048; J.ncols = 2048; J.K = 5504; J.dst = (bf16_t*)(p.ws + O_WT_DOWN) + (size_t)l * 2048 * 5504; }
    (void)ws16;
    return J;
}
__device__ __forceinline__ void phase_prep(const Params& p, LAS unsigned char* lds) {
    const int tid = tidx();
    LAS float* ts = (LAS float*)lds;
    for (int j = 0; j < 24; ++j) {
        const TJob J = get_job(p, j);
        const int tn = (J.ncols + 127) / 128, tk = J.K / 128;
        for (int tile = bidx(); tile < tn * tk; tile += gridDim.x) {
            const int kb = tile / tn, nb = tile % tn;
            __syncthreads();
            {
                const int c4 = (tid & 31) * 4, n = nb * 128 + c4, r0 = tid >> 5;
                if (n < J.ncols) {
                    float4 v[8];
#pragma unroll
                    for (int i = 0; i < 8; ++i) v[i] = *(const float4*)(J.src + (size_t)(kb * 128 + r0 + 16 * i) * J.ld + n);
#pragma unroll
                    for (int i = 0; i < 8; ++i) { const int r = r0 + 16 * i; ts[r * 129 + c4] = v[i].x; ts[r * 129 + c4 + 1] = v[i].y; ts[r * 129 + c4 + 2] = v[i].z; ts[r * 129 + c4 + 3] = v[i].w; }
                }
            }
            __syncthreads();
            const int n = tid >> 2, kc = tid & 3;
            if (nb * 128 + n < J.ncols) {
#pragma unroll
                for (int q = 0; q < 4; ++q) {
                    const int kk = kc * 32 + q * 8;
                    u32x4 w;
                    w.x = pack2(ts[(kk + 0) * 129 + n], ts[(kk + 1) * 129 + n]);
                    w.y = pack2(ts[(kk + 2) * 129 + n], ts[(kk + 3) * 129 + n]);
                    w.z = pack2(ts[(kk + 4) * 129 + n], ts[(kk + 5) * 129 + n]);
                    w.w = pack2(ts[(kk + 6) * 129 + n], ts[(kk + 7) * 129 + n]);
                    *(u32x4*)(J.dst + (size_t)(nb * 128 + n) * J.K + kb * 128 + kk) = w;
                }
            }
        }
    }
    __syncthreads();
    const size_t gtid = (size_t)bidx() * NTHREADS + tid, gn = (size_t)gridDim.x * NTHREADS;
    float* h = (float*)(p.ws + O_H); bf16_t* hb = (bf16_t*)(p.ws + O_HB);
    for (size_t i = gtid; i < (size_t)L_TOK * 512; i += gn) {
        const int row = (int)(i >> 9), c4 = (int)(i & 511) * 4;
        const float4 v = row < 16 ? *(const float4*)(p.in[1] + (size_t)row * DM + c4) : *(const float4*)(p.in[0] + (size_t)(row - 16) * DM + c4);
        u32x2 w; w.x = pack2(v.x, v.y); w.y = pack2(v.z, v.w);
        *(u32x2*)(hb + i * 4) = w;
    }
    if (gtid < 24) ((const float**)(p.ws + O_TAB))[gtid] = p.in[gtid];
    float* rope = (float*)(p.ws + O_ROPE);
    for (size_t i = gtid; i < (size_t)L_TOK * 8; i += gn) {
        const int pos = (int)(i >> 3), f = (int)(i & 7);
        const float ang = (float)pos * p.inv_freq[f];
        double rev = (double)ang * 0.15915494309189535;
        rev -= rint(rev);
        rope[pos * 16 + f] = __builtin_amdgcn_cosf((float)rev);
        rope[pos * 16 + 8 + f] = __builtin_amdgcn_sinf((float)rev);
    }
}

__device__ __forceinline__ void phase_ln(const Ctx& p, const float* g, const float* b, bool last) {
    const int lane = tidx() & 63, wid = tidx() >> 6;
    float* h = (float*)(p.ws + O_H); bf16_t* hb = (bf16_t*)(p.ws + O_HB);
    for (int row = bidx() * 8 + wid; row < L_TOK; row += gridDim.x * 8) {
        float4 v[8]; float s = 0.f;
#pragma unroll
        for (int i = 0; i < 8; ++i) { v[i] = *(const float4*)(h + (size_t)row * DM + i * 256 + lane * 4); s += v[i].x + v[i].y + v[i].z + v[i].w; }
        const float mean = wave_sum(s) * (1.f / 2048.f);
        float q = 0.f;
#pragma unroll
        for (int i = 0; i < 8; ++i) { v[i].x -= mean; v[i].y -= mean; v[i].z -= mean; v[i].w -= mean; q += v[i].x * v[i].x + v[i].y * v[i].y + v[i].z * v[i].z + v[i].w * v[i].w; }
        const float rstd = rsqrtf(wave_sum(q) * (1.f / 2048.f) + 1e-5f);
#pragma unroll
        for (int i = 0; i < 8; ++i) {
            const int c = i * 256 + lane * 4;
            const float4 gg = *(const float4*)(g + c), bb = *(const float4*)(b + c);
            float4 y; y.x = v[i].x * rstd * gg.x + bb.x; y.y = v[i].y * rstd * gg.y + bb.y; y.z = v[i].z * rstd * gg.z + bb.z; y.w = v[i].w * rstd * gg.w + bb.w;
            if (last) { if (row >= 16) *(float4*)(p.out + (size_t)(row - 16) * DM + c) = y; }
            else { u32x2 w; w.x = pack2(y.x, y.y); w.y = pack2(y.z, y.w); *(u32x2*)(hb + (size_t)row * DM + c) = w; }
        }
    }
}

__device__ __forceinline__ void unpack8(const u32x4 w, float (&f)[8]) {
    f[0] = bflo(w.x); f[1] = bfhi(w.x); f[2] = bflo(w.y); f[3] = bfhi(w.y); f[4] = bflo(w.z); f[5] = bfhi(w.z); f[6] = bflo(w.w); f[7] = bfhi(w.w);
}
__device__ __forceinline__ void ld8f(const float* q, float (&f)[8]) {
    const float4 a = *(const float4*)q, b = *(const float4*)(q + 4);
    f[0] = a.x; f[1] = a.y; f[2] = a.z; f[3] = a.w; f[4] = b.x; f[5] = b.y; f[6] = b.z; f[7] = b.w;
}
__device__ __forceinline__ void phase_ffn_conv(const Ctx& p, int layer) {
    const bf16_t* up = (const bf16_t*)(p.ws + O_R2); bf16_t* act = (bf16_t*)(p.ws + O_MIX);
    const float* cw = p.in(17) + (size_t)layer * 3 * DFF2; const float* cb = p.in(18) + (size_t)layer * DFF2;
    const size_t gtid = (size_t)bidx() * NTHREADS + tidx(), gn = (size_t)gridDim.x * NTHREADS;
    for (size_t task = gtid; task < (size_t)1026 * 688; task += gn) {
        const int jb = (int)(task % 688), tb = (int)(task / 688), j0 = jb * 8, t0 = tb * 8;
        float wg[3][8], wv[3][8], bg[8], bv[8];
#pragma unroll
        for (int k = 0; k < 3; ++k) { ld8f(cw + (size_t)k * DFF2 + j0, wg[k]); ld8f(cw + (size_t)k * DFF2 + DFF + j0, wv[k]); }
        ld8f(cb + j0, bg); ld8f(cb + DFF + j0, bv);
        u32x4 gr[10], vr[10];
#pragma unroll
        for (int r = 0; r < 10; ++r) {
            const int t = t0 - 2 + r;
            gr[r] = (u32x4){0u, 0u, 0u, 0u}; vr[r] = (u32x4){0u, 0u, 0u, 0u};
            if (t >= 0) { gr[r] = *(const u32x4*)(up + (size_t)t * DFF2 + j0); vr[r] = *(const u32x4*)(up + (size_t)t * DFF2 + DFF + j0); }
        }
        float g2[8], g1[8], v2[8], v1[8];
        unpack8(gr[0], g2); unpack8(vr[0], v2); unpack8(gr[1], g1); unpack8(vr[1], v1);
#pragma unroll
        for (int tt = 0; tt < 8; ++tt) {
            const int t = t0 + tt;
            float g0[8], v0[8], o[8];
            unpack8(gr[tt + 2], g0); unpack8(vr[tt + 2], v0);
#pragma unroll
            for (int i = 0; i < 8; ++i) {
                const float gg = bg[i] + wg[0][i] * g2[i] + wg[1][i] * g1[i] + wg[2][i] * g0[i];
                const float vv = bv[i] + wv[0][i] * v2[i] + wv[1][i] * v1[i] + wv[2][i] * v0[i];
                o[i] = silu_f(gg) * vv;
                g2[i] = g1[i]; g1[i] = g0[i]; v2[i] = v1[i]; v1[i] = v0[i];
            }
            u32x4 w; w.x = pack2(o[0], o[1]); w.y = pack2(o[2], o[3]); w.z = pack2(o[4], o[5]); w.w = pack2(o[6], o[7]);
            *(u32x4*)(act + (size_t)t * DFF + j0) = w;
        }
    }
}
__device__ __forceinline__ void phase_hyb_prep(const Ctx& p, int jj, LAS unsigned char* lds) {
    const bf16_t* u = (const bf16_t*)(p.ws + O_U);
    const float* side = (const float*)(p.ws + O_SIDE);
    const int tid = tidx(), lane = tid & 63, wid = tid >> 6;
    const size_t gtid = (size_t)bidx() * NTHREADS + tid, gn = (size_t)gridDim.x * NTHREADS;
    {
        bf16_t* xc = (bf16_t*)(p.ws + O_XC);
        const float* cw = p.in(3) + (size_t)jj * 4 * 4096; const float* cb = p.in(4) + (size_t)jj * 4096;
        for (size_t task = gtid; task < (size_t)1026 * 512; task += gn) {
            const int cbk = (int)(task & 511), tb = (int)(task >> 9), c0 = cbk * 8, t0 = tb * 8;
            float w[4][8], bb[8], x3[8], x2[8], x1[8];
#pragma unroll
            for (int k = 0; k < 4; ++k) ld8f(cw + (size_t)k * 4096 + c0, w[k]);
            ld8f(cb + c0, bb);
            u32x4 xr[11];
#pragma unroll
            for (int r = 0; r < 11; ++r) { const int t = t0 - 3 + r; xr[r] = (u32x4){0u, 0u, 0u, 0u}; if (t >= 0) xr[r] = *(const u32x4*)(u + (size_t)t * HYB_N + UXBC + c0); }
            unpack8(xr[0], x3); unpack8(xr[1], x2); unpack8(xr[2], x1);
#pragma unroll
            for (int tt = 0; tt < 8; ++tt) {
                const int t = t0 + tt;
                float x0[8], o[8];
                unpack8(xr[tt + 3], x0);
#pragma unroll
                for (int i = 0; i < 8; ++i) {
                    const float y = bb[i] + w[0][i] * x3[i] + w[1][i] * x2[i] + w[2][i] * x1[i] + w[3][i] * x0[i];
                    o[i] = silu_f(y);
                    x3[i] = x2[i]; x2[i] = x1[i]; x1[i] = x0[i];
                }
                u32x4 ww; ww.x = pack2(o[0], o[1]); ww.y = pack2(o[2], o[3]); ww.z = pack2(o[4], o[5]); ww.w = pack2(o[6], o[7]);
                *(u32x4*)(xc + (size_t)t * 4096 + c0) = ww;
            }
        }
    }
    {
        float* dt = (float*)(p.ws + O_DT); float* acs = (float*)(p.ws + O_ACS); float* cdec = (float*)(p.ws + O_CDEC);
        for (int c = bidx(); c < 65; c += gridDim.x)
        for (int head = wid; head < 32; head += 8) {
            const float bias = p.in(5)[jj * 32 + head], a = -__expf(p.in(6)[jj * 32 + head]);
            const int t0 = c * 128 - 112 + 2 * lane;
            float d0 = 0.f, d1 = 0.f;
            if (t0 >= 0) {
                const float x0 = side[(size_t)t0 * 64 + head] + bias, x1 = side[(size_t)(t0 + 1) * 64 + head] + bias;
                d0 = x0 > 20.f ? x0 : log1pf(__expf(x0)); d1 = x1 > 20.f ? x1 : log1pf(__expf(x1));
            }
            const float a0 = d0 * a, a1 = d1 * a;
            float s = a0 + a1;
#pragma unroll
            for (int o = 1; o < 64; o <<= 1) { const float v = __shfl_up(s, o); if (lane >= o) s += v; }
            const float ex = s - (a0 + a1);
            if (t0 >= 0) {
                dt[(size_t)t0 * 32 + head] = d0; dt[(size_t)(t0 + 1) * 32 + head] = d1;
                acs[(size_t)t0 * 32 + head] = ex + a0; acs[(size_t)(t0 + 1) * 32 + head] = s;
            }
            if (lane == 63) cdec[c * 32 + head] = __expf(s);
        }
    }
    {
        bf16_t* qt = (bf16_t*)(p.ws + O_QT); bf16_t* kt = (bf16_t*)(p.ws + O_KT); float* glast = (float*)(p.ws + O_GLAST);
        const float* w2 = p.in(9) + (size_t)jj * 16 * 1024; const float* gb = p.in(10) + (size_t)jj * 1024;
        LAS float* tot = (LAS float*)lds;
        const int d4 = tid & 15, pg = tid >> 4;
        for (int task = bidx(); task < 129 * 16; task += gridDim.x) {
            const int c = task >> 4, dbase = (task & 15) * 64 + d4 * 4, tbase = c * 64 - 48 + 2 * pg;
            f32x4 w[16];
#pragma unroll
            for (int r = 0; r < 16; ++r) w[r] = *(const f32x4*)(w2 + r * 1024 + dbase);
            const f32x4 b = *(const f32x4*)(gb + dbase);
            f32x4 g0 = {0.f, 0.f, 0.f, 0.f}, g1 = {0.f, 0.f, 0.f, 0.f};
            if (tbase >= 0) {
#pragma unroll
                for (int pos = 0; pos < 2; ++pos) {
                    const float* gl = side + (size_t)(tbase + pos) * 64 + 32;
                    f32x4 x = b;
#pragma unroll
                    for (int r4 = 0; r4 < 4; ++r4) { const f32x4 gv = *(const f32x4*)(gl + r4 * 4); x += w[r4 * 4] * gv[0] + w[r4 * 4 + 1] * gv[1] + w[r4 * 4 + 2] * gv[2] + w[r4 * 4 + 3] * gv[3]; }
                    f32x4 ls;
#pragma unroll
                    for (int e = 0; e < 4; ++e) ls[e] = (fminf(x[e], 0.f) - log1pf(__expf(-fabsf(x[e])))) * (1.f / 16.f);
                    if (pos == 0) g0 = ls; else g1 = ls;
                }
            }
            __syncthreads();
            *(LAS f32x4*)(tot + pg * 64 + d4 * 4) = g0 + g1;
            __syncthreads();
            f32x4 pre = {0.f, 0.f, 0.f, 0.f};
            for (int g = 0; g < pg; ++g) pre += *(const LAS f32x4*)(tot + g * 64 + d4 * 4);
            const f32x4 gc0 = pre + g0, gc1 = gc0 + g1;
            if (tbase >= 0) {
#pragma unroll
                for (int pos = 0; pos < 2; ++pos) {
                    const f32x4 gc = pos == 0 ? gc0 : gc1;
                    const size_t t = (size_t)(tbase + pos);
                    const u32x2 qw = *(const u32x2*)(u + t * HYB_N + UQ + dbase), kw = *(const u32x2*)(u + t * HYB_N + UK + dbase);
                    const float q[4] = {bflo(qw.x), bfhi(qw.x), bflo(qw.y), bfhi(qw.y)}, k[4] = {bflo(kw.x), bfhi(kw.x), bflo(kw.y), bfhi(kw.y)};
                    u32x2 qo, ko;
                    qo.x = pack2(q[0] * 0.0625f * __expf(gc[0]), q[1] * 0.0625f * __expf(gc[1])); qo.y = pack2(q[2] * 0.0625f * __expf(gc[2]), q[3] * 0.0625f * __expf(gc[3]));
                    ko.x = pack2(k[0] * __expf(-gc[0]), k[1] * __expf(-gc[1])); ko.y = pack2(k[2] * __expf(-gc[2]), k[3] * __expf(-gc[3]));
                    *(u32x2*)(qt + t * 1024 + dbase) = qo; *(u32x2*)(kt + t * 1024 + dbase) = ko;
                }
            }
            if (pg == 31) { f32x4 e; e[0] = __expf(gc1[0]); e[1] = __expf(gc1[1]); e[2] = __expf(gc1[2]); e[3] = __expf(gc1[3]); *(f32x4*)(glast + c * 1024 + dbase) = e; }
        }
    }
}

__device__ __forceinline__ void phase_hyb_local(const Ctx& p, LAS unsigned char* lds) {
    const int tid = tidx(), lane = tid & 63, wid = tid >> 6, fr = lane & 15, fq = lane >> 4;
    const bf16_t* xc = (const bf16_t*)(p.ws + O_XC);
    const float* dt = (const float*)(p.ws + O_DT); const float* acs = (const float*)(p.ws + O_ACS);
    const int NSSD = 65 * 8, NGLA = 129 * 16;
    for (int task = bidx(); task < NSSD + NGLA; task += gridDim.x) {
        __syncthreads();
        if (task < NSSD) {
            const int c = task >> 3, g = task & 7, tbase = c * 128 - 112;
            LAS bf16_t* Bs = (LAS bf16_t*)lds;
            LAS bf16_t* Xs = Bs + 128 * 136;
            const int tlast = tbase + 127;
            for (int item = tid; item < 128 * 16; item += NTHREADS) {
                const int j = item >> 4, cb = item & 15, t = tbase + j;
                u32x4 w = {0u, 0u, 0u, 0u};
                if (t >= 0) w = *(const u32x4*)(xc + (size_t)t * 4096 + 2048 + g * 128 + cb * 8);
                *(LAS u32x4*)(Bs + j * 136 + cb * 8) = w;
            }
            for (int item = tid; item < 128 * 32; item += NTHREADS) {
                const int j = item >> 5, cb = item & 31, hh = cb >> 3, t = tbase + j, head = g * 4 + hh;
                u32x4 w = {0u, 0u, 0u, 0u};
                if (t >= 0) {
                    float f[8]; unpack8(*(const u32x4*)(xc + (size_t)t * 4096 + g * 256 + cb * 8), f);
                    const float sc = dt[(size_t)t * 32 + head] * __expf(acs[(size_t)tlast * 32 + head] - acs[(size_t)t * 32 + head]);
                    w.x = pack2(f[0] * sc, f[1] * sc); w.y = pack2(f[2] * sc, f[3] * sc); w.z = pack2(f[4] * sc, f[5] * sc); w.w = pack2(f[6] * sc, f[7] * sc);
                }
                *(LAS u32x4*)(Xs + j * 264 + cb * 8) = w;
            }
            __syncthreads();
            float* loc = (float*)(p.ws + O_SSDLOC) + ((size_t)c * 32 + g * 4) * 64 * 128;
            const int pt = wid & 3, nh = wid >> 2;
            for (int hh = 0; hh < 4; ++hh) {
                f32x4 acc[4];
#pragma unroll
                for (int nt = 0; nt < 4; ++nt) acc[nt] = (f32x4){0.f, 0.f, 0.f, 0.f};
#pragma unroll
                for (int ks = 0; ks < 4; ++ks) {
                    const bf16x8 xf = ldfrag_tr(Xs, 264, hh * 64 + pt * 16, ks * 32, lane);
#pragma unroll
                    for (int nt = 0; nt < 4; ++nt) { const bf16x8 bf = ldfrag_tr(Bs, 136, nh * 64 + nt * 16, ks * 32, lane); acc[nt] = MFMA16(bf, xf, acc[nt]); }
                }
#pragma unroll
                for (int nt = 0; nt < 4; ++nt) *(f32x4*)(loc + ((size_t)hh * 64 + pt * 16 + fr) * 128 + nh * 64 + nt * 16 + 4 * fq) = acc[nt];
            }
        } else {
            const int gt = task - NSSD, c = gt >> 4, h = (gt >> 2) & 3, vs = gt & 3, tbase = c * 64 - 48;
            const bf16_t* u = (const bf16_t*)(p.ws + O_U); const bf16_t* kt = (const bf16_t*)(p.ws + O_KT);
            LAS bf16_t* Ks = (LAS bf16_t*)lds;
            LAS bf16_t* Vs = Ks + 64 * 264;
            for (int item = tid; item < 64 * 32; item += NTHREADS) {
                const int j = item >> 5, cb = item & 31, t = tbase + j;
                u32x4 w = {0u, 0u, 0u, 0u};
                if (t >= 0) w = *(const u32x4*)(kt + (size_t)t * 1024 + h * 256 + cb * 8);
                *(LAS u32x4*)(Ks + j * 264 + cb * 8) = w;
            }
            for (int item = tid; item < 64 * 16; item += NTHREADS) {
                const int j = item >> 4, cb = item & 15, t = tbase + j;
                u32x4 w = {0u, 0u, 0u, 0u};
                if (t >= 0) w = *(const u32x4*)(u + (size_t)t * HYB_N + UV + h * 512 + vs * 128 + cb * 8);
                *(LAS u32x4*)(Vs + j * 136 + cb * 8) = w;
            }
            __syncthreads();
            const float* glast = (const float*)(p.ws + O_GLAST) + c * 1024 + h * 256;
            bf16_t* kv = (bf16_t*)(p.ws + O_R2) + (((size_t)c * 4 + h) * 512 + vs * 128 + wid * 16 + fr) * 256;
            const bf16x8 vf0 = ldfrag_tr(Vs, 136, wid * 16, 0, lane), vf1 = ldfrag_tr(Vs, 136, wid * 16, 32, lane);
#pragma unroll
            for (int nt = 0; nt < 16; ++nt) {
                f32x4 acc = {0.f, 0.f, 0.f, 0.f};
                acc = MFMA16(ldfrag_tr(Ks, 264, nt * 16, 0, lane), vf0, acc);
                acc = MFMA16(ldfrag_tr(Ks, 264, nt * 16, 32, lane), vf1, acc);
                const f32x4 gl = *(const f32x4*)(glast + nt * 16 + 4 * fq);
                u32x2 w; w.x = pack2(acc[0] * gl[0], acc[1] * gl[1]); w.y = pack2(acc[2] * gl[2], acc[3] * gl[3]);
                *(u32x2*)(kv + nt * 16 + 4 * fq) = w;
            }
        }
    }
}

__device__ __forceinline__ void phase_hyb_scan(const Ctx& p) {
    const size_t gtid = (size_t)bidx() * NTHREADS + tidx(), gn = (size_t)gridDim.x * NTHREADS;
    for (size_t task = gtid; task < 131072; task += gn) {
        if (task < 65536) {
            const size_t e = task * 4; const int head = (int)(e >> 13);
            const float* loc = (const float*)(p.ws + O_SSDLOC) + e; bf16_t* prev = (bf16_t*)(p.ws + O_SSDPREV) + e;
            const float* cdec = (const float*)(p.ws + O_CDEC) + head;
            float zz = 0.f; asm volatile("" : "+v"(zz));
            float4 run = {zz, zz, zz, zz};
            for (int c0 = 0; c0 < 65; c0 += 13) {
                float4 l[13]; float dcy[13];
#pragma unroll
                for (int i = 0; i < 13; ++i) { l[i] = *(const float4*)(loc + (size_t)(c0 + i) * 262144); dcy[i] = cdec[(c0 + i) * 32]; }
#pragma unroll
                for (int i = 0; i < 13; ++i) {
                    u32x2 w; w.x = pack2(run.x, run.y); w.y = pack2(run.z, run.w);
                    *(u32x2*)(prev + (size_t)(c0 + i) * 262144) = w;
                    run.x = run.x * dcy[i] + l[i].x; run.y = run.y * dcy[i] + l[i].y; run.z = run.z * dcy[i] + l[i].z; run.w = run.w * dcy[i] + l[i].w;
                }
            }
        } else {
            const size_t e = (task - 65536) * 8; const int h = (int)(e >> 17), d0 = (int)(e & 255);
            const bf16_t* kv = (const bf16_t*)(p.ws + O_R2) + e; bf16_t* sp = (bf16_t*)(p.ws + O_R2 + GLA_ST_BYTES) + e;
            const float* glast = (const float*)(p.ws + O_GLAST) + h * 256 + d0;
            float run[8]; float zz = 0.f; asm volatile("" : "+v"(zz));
#pragma unroll
            for (int i = 0; i < 8; ++i) run[i] = zz;
            for (int c0 = 0; c0 < 129; c0 += 8) {
                u32x4 lw[8]; float4 ga[8], gb2[8];
#pragma unroll
                for (int i = 0; i < 8; ++i) { const int c = c0 + i < 129 ? c0 + i : 128; lw[i] = *(const u32x4*)(kv + (size_t)c * 524288); ga[i] = *(const float4*)(glast + c * 1024); gb2[i] = *(const float4*)(glast + c * 1024 + 4); }
#pragma unroll
                for (int i = 0; i < 8; ++i) {
                    if (c0 + i < 129) {
                        float l[8]; unpack8(lw[i], l);
                        u32x4 w; w.x = pack2(run[0], run[1]); w.y = pack2(run[2], run[3]); w.z = pack2(run[4], run[5]); w.w = pack2(run[6], run[7]);
                        *(u32x4*)(sp + (size_t)(c0 + i) * 524288) = w;
                        run[0] = run[0] * ga[i].x + l[0]; run[1] = run[1] * ga[i].y + l[1]; run[2] = run[2] * ga[i].z + l[2]; run[3] = run[3] * ga[i].w + l[3];
                        run[4] = run[4] * gb2[i].x + l[4]; run[5] = run[5] * gb2[i].y + l[5]; run[6] = run[6] * gb2[i].z + l[6]; run[7] = run[7] * gb2[i].w + l[7];
                    }
                }
            }
        }
    }
}
__device__ __forceinline__ void phase_hyb_out(const Ctx& p, int jj, LAS unsigned char* lds) {
    const bf16_t* xc = (const bf16_t*)(p.ws + O_XC); const bf16_t* u = (const bf16_t*)(p.ws + O_U);
    const float* dt = (const float*)(p.ws + O_DT); const float* acs = (const float*)(p.ws + O_ACS);
    bf16_t* mix = (bf16_t*)(p.ws + O_MIX);
    for (int task0 = bidx(); task0 < 1036; task0 += gridDim.x) {
        bool is_ssd; int c, sub;
        if (task0 < 8) { is_ssd = true; c = 0; sub = task0; }
        else if (task0 < 12) { is_ssd = false; c = 0; sub = task0 - 8; }
        else if (task0 < 524) { is_ssd = true; c = 1 + ((task0 - 12) >> 3); sub = (task0 - 12) & 7; }
        else { is_ssd = false; c = 1 + ((task0 - 524) >> 2); sub = (task0 - 524) & 3; }
        const int tid = tidx(), lane = tid & 63, wid = tid >> 6, fr = lane & 15, fq = lane >> 4;
        __syncthreads();
        if (is_ssd) {
            const int g = sub, tbase = c * 128 - 112;
            LAS bf16_t* Cs = (LAS bf16_t*)lds;
            LAS bf16_t* Bs = Cs + 128 * 136;
            LAS bf16_t* Xt = Bs + 128 * 136;
            LAS bf16_t* Pv = Xt + 128 * 72;
            LAS float* Acs = (LAS float*)(Pv + 64 * 136);
            for (int item = tid; item < 128 * 32; item += NTHREADS) {
                const int j = item >> 5, cb = item & 31, t = tbase + j;
                u32x4 w = {0u, 0u, 0u, 0u};
                if (t >= 0) w = *(const u32x4*)(xc + (size_t)t * 4096 + 2048 + (cb < 16 ? 0 : 1024) + g * 128 + (cb & 15) * 8);
                *(LAS u32x4*)((cb < 16 ? Bs : Cs) + j * 136 + (cb & 15) * 8) = w;
            }
            { const int j = tid & 127, hh = tid >> 7, t = tbase + j; Acs[hh * 128 + j] = t >= 0 ? acs[(size_t)t * 32 + g * 4 + hh] : 0.f; }
            __syncthreads();
            const int i_row = wid * 16 + fr, ti = tbase + i_row;
            f32x4 cb_acc[8];
#pragma unroll
            for (int nt = 0; nt < 8; ++nt) cb_acc[nt] = (f32x4){0.f, 0.f, 0.f, 0.f};
#pragma unroll
            for (int ks = 0; ks < 4; ++ks) {
                const bf16x8 cf = ldfrag(Cs, 136, wid * 16, ks * 32, lane);
#pragma unroll
                for (int nt = 0; nt < 8; ++nt) cb_acc[nt] = MFMA16(ldfrag(Bs, 136, nt * 16, ks * 32, lane), cf, cb_acc[nt]);
            }
            f32x4 yv[4][4];
#pragma unroll
            for (int k = 0; k < 4; ++k)
#pragma unroll
                for (int pt = 0; pt < 4; ++pt) yv[k][pt] = (f32x4){0.f, 0.f, 0.f, 0.f};
            float ssq = 0.f;
#pragma unroll 1
            for (int hh = 0; hh < 4; ++hh) {
                const int head = g * 4 + hh;
                __syncthreads();
                for (int item = tid; item < 128 * 8; item += NTHREADS) {
                    const int j = item >> 3, cb = item & 7, t = tbase + j;
                    u32x4 w = {0u, 0u, 0u, 0u};
                    if (t >= 0) { float f[8]; unpack8(*(const u32x4*)(xc + (size_t)t * 4096 + head * 64 + cb * 8), f); const float sc = dt[(size_t)t * 32 + head];
                        w.x = pack2(f[0] * sc, f[1] * sc); w.y = pack2(f[2] * sc, f[3] * sc); w.z = pack2(f[4] * sc, f[5] * sc); w.w = pack2(f[6] * sc, f[7] * sc); }
                    *(LAS u32x4*)(Xt + j * 72 + cb * 8) = w;
                }
                { const bf16_t* pv = (const bf16_t*)(p.ws + O_SSDPREV) + ((size_t)c * 32 + head) * 64 * 128;
                  for (int item = tid; item < 64 * 16; item += NTHREADS) { const int pp = item >> 4, cb = item & 15; *(LAS u32x4*)(Pv + pp * 136 + cb * 8) = *(const u32x4*)(pv + pp * 128 + cb * 8); } }
                const float ai = Acs[hh * 128 + i_row];
#pragma unroll
                for (int nt = 0; nt < 8; ++nt) {
                    float m[4];
#pragma unroll
                    for (int q = 0; q < 4; ++q) { const int j = nt * 16 + 4 * fq + q; m[q] = j <= i_row ? cb_acc[nt][q] * __expf(ai - Acs[hh * 128 + j]) : 0.f; }
                    u32x2 w; w.x = pack2(m[0], m[1]); w.y = pack2(m[2], m[3]);
                    *(LAS u32x2*)(Bs + i_row * 136 + nt * 16 + 4 * fq) = w;
                }
                __syncthreads();
                f32x4 yd[4], yo[4];
#pragma unroll
                for (int pt = 0; pt < 4; ++pt) { yd[pt] = (f32x4){0.f, 0.f, 0.f, 0.f}; yo[pt] = (f32x4){0.f, 0.f, 0.f, 0.f}; }
#pragma unroll
                for (int ks = 0; ks < 4; ++ks) {
                    const bf16x8 mf = ldfrag(Bs, 136, wid * 16, ks * 32, lane), cf = ldfrag(Cs, 136, wid * 16, ks * 32, lane);
#pragma unroll
                    for (int pt = 0; pt < 4; ++pt) {
                        yd[pt] = MFMA16(ldfrag_tr(Xt, 72, pt * 16, ks * 32, lane), mf, yd[pt]);
                        yo[pt] = MFMA16(ldfrag(Pv, 136, pt * 16, ks * 32, lane), cf, yo[pt]);
                    }
                }
                const float ea = __expf(ai), dsk = p.in(7)[jj * 32 + head];
#pragma unroll
                for (int pt = 0; pt < 4; ++pt) {
                    const int ch = head * 64 + pt * 16 + 4 * fq;
                    float xs[4] = {0.f, 0.f, 0.f, 0.f}, zz[4] = {0.f, 0.f, 0.f, 0.f};
                    if (ti >= 0) {
                        const u32x2 xw = *(const u32x2*)(xc + (size_t)ti * 4096 + ch), zw = *(const u32x2*)(u + (size_t)ti * HYB_N + UZ + ch);
                        xs[0] = bflo(xw.x); xs[1] = bfhi(xw.x); xs[2] = bflo(xw.y); xs[3] = bfhi(xw.y);
                        zz[0] = bflo(zw.x); zz[1] = bfhi(zw.x); zz[2] = bflo(zw.y); zz[3] = bfhi(zw.y);
                    }
#pragma unroll
                    for (int q = 0; q < 4; ++q) { const float y = (yd[pt][q] + ea * yo[pt][q] + dsk * xs[q]) * silu_f(zz[q]); ssq += y * y;
#pragma unroll
                        for (int k = 0; k < 4; ++k) yv[k][pt][q] = (k == hh) ? y : yv[k][pt][q]; }
                }
            }
            ssq += __shfl_xor(ssq, 16); ssq += __shfl_xor(ssq, 32);
            const float rs = rsqrtf(ssq * (1.f / 256.f) + 1e-6f);
            if (ti >= 0) {
                const float* nw = p.in(8) + (size_t)jj * 2048;
#pragma unroll
                for (int hh = 0; hh < 4; ++hh)
#pragma unroll
                    for (int pt = 0; pt < 4; ++pt) {
                        const int ch = (g * 4 + hh) * 64 + pt * 16 + 4 * fq;
                        const f32x4 wv = *(const f32x4*)(nw + ch);
                        u32x2 w; w.x = pack2(yv[hh][pt][0] * rs * wv[0], yv[hh][pt][1] * rs * wv[1]); w.y = pack2(yv[hh][pt][2] * rs * wv[2], yv[hh][pt][3] * rs * wv[3]);
                        *(u32x2*)(mix + (size_t)ti * 4096 + ch) = w;
                    }
            }
        } else {
            const int h = sub, tbase = c * 64 - 48;
            const bf16_t* qt = (const bf16_t*)(p.ws + O_QT); const bf16_t* kt = (const bf16_t*)(p.ws + O_KT);
            LAS bf16_t* Qs = (LAS bf16_t*)lds;
            LAS bf16_t* Ps = Qs + 64 * 264;
            LAS float* Ssq = (LAS float*)(Ps + 64 * 72);
            LAS bf16_t* Ks = (LAS bf16_t*)(Ssq + 512);
            LAS bf16_t* Vs = Ks;
            for (int item = tid; item < 64 * 64; item += NTHREADS) {
                const int j = item >> 6, cb = item & 63, t = tbase + j;
                u32x4 w = {0u, 0u, 0u, 0u};
                if (t >= 0) w = *(const u32x4*)((cb < 32 ? qt : kt) + (size_t)t * 1024 + h * 256 + (cb & 31) * 8);
                *(LAS u32x4*)((cb < 32 ? Qs : Ks) + j * 264 + (cb & 31) * 8) = w;
            }
            u32x4 vreg[8];
#pragma unroll
            for (int r = 0; r < 8; ++r) { const int item = tid + r * NTHREADS, j = item >> 6, cb = item & 63, t = tbase + j;
                vreg[r] = (u32x4){0u, 0u, 0u, 0u};
                if (t >= 0) vreg[r] = *(const u32x4*)(u + (size_t)t * HYB_N + UV + h * 512 + cb * 8); }
            __syncthreads();
#pragma unroll
            for (int rep = 0; rep < 2; ++rep) {
                const int tix = wid + rep * 8, it = tix >> 2, jt = tix & 3;
                f32x4 acc = {0.f, 0.f, 0.f, 0.f};
                if (jt <= it) {
#pragma unroll
                    for (int ks = 0; ks < 8; ++ks) acc = MFMA16(ldfrag(Ks, 264, jt * 16, ks * 32, lane), ldfrag(Qs, 264, it * 16, ks * 32, lane), acc);
                }
                const int i = it * 16 + fr;
                float m[4];
#pragma unroll
                for (int q = 0; q < 4; ++q) { const int j = jt * 16 + 4 * fq + q; m[q] = (j <= i) ? acc[q] : 0.f; }
                u32x2 w; w.x = pack2(m[0], m[1]); w.y = pack2(m[2], m[3]);
                *(LAS u32x2*)(Ps + i * 72 + jt * 16 + 4 * fq) = w;
            }
            __syncthreads();
#pragma unroll
            for (int r = 0; r < 8; ++r) { const int item = tid + r * NTHREADS, j = item >> 6, cb = item & 63; *(LAS u32x4*)(Vs + j * 520 + cb * 8) = vreg[r]; }
            __syncthreads();
            f32x4 o[4][4];
            float ssq[4] = {0.f, 0.f, 0.f, 0.f};
            const bf16_t* sp = (const bf16_t*)(p.ws + O_R2 + GLA_ST_BYTES) + ((size_t)c * 4 + h) * 512 * 256;
#pragma unroll
            for (int vs = 0; vs < 4; ++vs) {
#pragma unroll
                for (int it = 0; it < 4; ++it) o[vs][it] = (f32x4){0.f, 0.f, 0.f, 0.f};
#pragma unroll
                for (int ks = 0; ks < 2; ++ks) {
                    const bf16x8 vf = ldfrag_tr(Vs, 520, vs * 128 + wid * 16, ks * 32, lane);
#pragma unroll
                    for (int it = 0; it < 4; ++it) o[vs][it] = MFMA16(vf, ldfrag(Ps, 72, it * 16, ks * 32, lane), o[vs][it]);
                }
                const bf16_t* spw = sp + (size_t)(vs * 128 + wid * 16) * 256;
#pragma unroll
                for (int ks = 0; ks < 8; ++ks) {
                    const bf16x8 sf = gfrag(spw, 256, 0, ks * 32, lane);
#pragma unroll
                    for (int it = 0; it < 4; ++it) o[vs][it] = MFMA16(sf, ldfrag(Qs, 264, it * 16, ks * 32, lane), o[vs][it]);
                }
#pragma unroll
                for (int it = 0; it < 4; ++it) ssq[it] += o[vs][it][0] * o[vs][it][0] + o[vs][it][1] * o[vs][it][1] + o[vs][it][2] * o[vs][it][2] + o[vs][it][3] * o[vs][it][3];
            }
#pragma unroll
            for (int it = 0; it < 4; ++it) { float s = ssq[it]; s += __shfl_xor(s, 16); s += __shfl_xor(s, 32); if (fq == 0) Ssq[wid * 64 + it * 16 + fr] = s; }
            __syncthreads();
            const float* nw = p.in(11) + (size_t)jj * 2048 + h * 512;
#pragma unroll
            for (int it = 0; it < 4; ++it) {
                const int i = it * 16 + fr, t = tbase + i;
                float s = 0.f;
#pragma unroll
                for (int w8 = 0; w8 < 8; ++w8) s += Ssq[w8 * 64 + i];
                const float rs = rsqrtf(s * (1.f / 512.f) + 1e-6f);
                if (t >= 0) {
#pragma unroll
                    for (int vs = 0; vs < 4; ++vs) {
                        const int v0 = vs * 128 + wid * 16 + 4 * fq;
                        const f32x4 wv = *(const f32x4*)(nw + v0);
                        const u32x2 rw = *(const u32x2*)(u + (size_t)t * HYB_N + UR + h * 512 + v0);
                        const float r0 = bflo(rw.x), r1 = bfhi(rw.x), r2 = bflo(rw.y), r3 = bfhi(rw.y);
                        u32x2 w;
                        w.x = pack2(o[vs][it][0] * rs * wv[0] * silu_f(r0), o[vs][it][1] * rs * wv[1] * silu_f(r1));
                        w.y = pack2(o[vs][it][2] * rs * wv[2] * silu_f(r2), o[vs][it][3] * rs * wv[3] * silu_f(r3));
                        *(u32x2*)(mix + (size_t)t * 4096 + 2048 + h * 512 + v0) = w;
                    }
                }
            }
        }
    }
}
__device__ __forceinline__ void rot_pair(const u32x4 a, const u32x4 b, const float* cs, u32x4& oa, u32x4& ob) {
    float x1[8], x2[8], c[8], s[8]; unpack8(a, x1); unpack8(b, x2); ld8f(cs, c); ld8f(cs + 8, s);
    float r1[8], r2[8];
#pragma unroll
    for (int i = 0; i < 8; ++i) { r1[i] = x1[i] * c[i] - x2[i] * s[i]; r2[i] = x2[i] * c[i] + x1[i] * s[i]; }
    oa.x = pack2(r1[0], r1[1]); oa.y = pack2(r1[2], r1[3]); oa.z = pack2(r1[4], r1[5]); oa.w = pack2(r1[6], r1[7]);
    ob.x = pack2(r2[0], r2[1]); ob.y = pack2(r2[2], r2[3]); ob.z = pack2(r2[4], r2[5]); ob.w = pack2(r2[6], r2[7]);
}
__device__ __forceinline__ void phase_attn(const Ctx& p, int jj, LAS unsigned char* lds) {
    const int tid = tidx(), lane = tid & 63, wid = tid >> 6, fr = lane & 15, fq = lane >> 4;
    const bf16_t* qkv = (const bf16_t*)(p.ws + O_U);
    const float* rope = (const float*)(p.ws + O_ROPE);
    bf16_t* ao = (bf16_t*)(p.ws + O_MIX);
    LAS bf16_t* Ks = (LAS bf16_t*)lds;
    LAS bf16_t* Vt = Ks + 272 * 72;
    LAS bf16_t* Pw = Vt + 64 * 280 + wid * (16 * 168);
    for (int task0 = bidx(); task0 < 520; task0 += gridDim.x) {
        const int task = task0 < 8 ? 512 + task0 : task0 - 8;
        const bool meta = task >= 512;
        const int b = meta ? 0 : (task >> 3), kh = task & 7;
        const int nkeys = meta ? 32 : 272;
        __syncthreads();
        for (int item = tid; item < nkeys * 8; item += NTHREADS) {
            const int key = item >> 3, cb = item & 7;
            const int tok = key < 16 ? key : 16 + 128 * (b - 1) + (key - 16);
            const bool valid = meta ? (key < 16) : (key < 16 || tok >= 16);
            {
                u32x4 w = {0u, 0u, 0u, 0u};
                if (valid) w = *(const u32x4*)(qkv + (size_t)tok * QKV_N + 2560 + kh * 64 + cb * 8);
                const bf16_t e[8] = {(bf16_t)(w.x & 0xffff), (bf16_t)(w.x >> 16), (bf16_t)(w.y & 0xffff), (bf16_t)(w.y >> 16), (bf16_t)(w.z & 0xffff), (bf16_t)(w.z >> 16), (bf16_t)(w.w & 0xffff), (bf16_t)(w.w >> 16)};
#pragma unroll
                for (int i = 0; i < 8; ++i) Vt[(cb * 8 + i) * 280 + key] = e[i];
            }
            if (cb == 1) continue;
            const bf16_t* src = qkv + (size_t)tok * QKV_N + 2048 + kh * 64;
            if (cb == 0) {
                u32x4 oa = {0u, 0u, 0u, 0u}, ob = {0u, 0u, 0u, 0u};
                if (valid) rot_pair(*(const u32x4*)src, *(const u32x4*)(src + 8), rope + (size_t)tok * 16, oa, ob);
                *(LAS u32x4*)(Ks + key * 72) = oa; *(LAS u32x4*)(Ks + key * 72 + 8) = ob;
            } else {
                u32x4 w = {0u, 0u, 0u, 0u};
                if (valid) w = *(const u32x4*)(src + cb * 8);
                *(LAS u32x4*)(Ks + key * 72 + cb * 8) = w;
            }
        }
        __syncthreads();
        if (meta && wid >= 4) continue;
        const int ng = meta ? 1 : 4;
        for (int gi = 0; gi < ng; ++gi) {
            const int g = meta ? wid : gi, hq = kh * 4 + g;
            const int tq = meta ? fr : 16 + 128 * b + 16 * wid + fr;
            u32x4 q0 = *(const u32x4*)(qkv + (size_t)tq * QKV_N + hq * 64 + 8 * fq), q1 = *(const u32x4*)(qkv + (size_t)tq * QKV_N + hq * 64 + 32 + 8 * fq);
            {
                u32x4 ot; ot.x = __shfl_xor((int)q0.x, 16); ot.y = __shfl_xor((int)q0.y, 16); ot.z = __shfl_xor((int)q0.z, 16); ot.w = __shfl_xor((int)q0.w, 16);
                if (fq < 2) {
                    float mine[8], oth[8], c[8], s[8]; unpack8(q0, mine); unpack8(ot, oth); ld8f(rope + (size_t)tq * 16, c); ld8f(rope + (size_t)tq * 16 + 8, s);
                    const float sg = fq == 0 ? -1.f : 1.f;
                    float r[8];
#pragma unroll
                    for (int i = 0; i < 8; ++i) r[i] = mine[i] * c[i] + sg * oth[i] * s[i];
                    q0.x = pack2(r[0], r[1]); q0.y = pack2(r[2], r[3]); q0.z = pack2(r[4], r[5]); q0.w = pack2(r[6], r[7]);
                }
            }
            const bf16x8 qa0 = __builtin_bit_cast(bf16x8, q0), qa1 = __builtin_bit_cast(bf16x8, q1);
            const float sink = p.in(14)[jj * 32 + hq];
            const int nt = meta ? 1 : 10;
            f32x4 sc[10];
            float mx = sink;
#pragma unroll
            for (int t = 0; t < 10; ++t) {
                if (t < nt) {
                    const int krow = t == 0 ? 0 : 16 + 16 * (wid + t - 1);
                    f32x4 a = {0.f, 0.f, 0.f, 0.f};
                    a = MFMA16(ldfrag(Ks, 72, krow, 0, lane), qa0, a);
                    a = MFMA16(ldfrag(Ks, 72, krow, 32, lane), qa1, a);
#pragma unroll
                    for (int j = 0; j < 4; ++j) {
                        bool vis;
                        if (t == 0) vis = meta ? (4 * fq + j <= fr) : true;
                        else { const int rel = 16 * (t - 1) + 4 * fq + j - fr; vis = rel >= 1 && rel <= 128 && (b > 0 || 16 * wid + 16 * (t - 1) + 4 * fq + j >= 128); }
                        const float v = vis ? a[j] * 0.125f : -INFINITY;
                        a[j] = v; mx = fmaxf(mx, v);
                    }
                    sc[t] = a;
                }
            }
            mx = fmaxf(mx, __shfl_xor(mx, 16)); mx = fmaxf(mx, __shfl_xor(mx, 32));
            float den = 0.f;
#pragma unroll
            for (int t = 0; t < 10; ++t) {
                if (t < nt) {
                    float e[4];
#pragma unroll
                    for (int j = 0; j < 4; ++j) { e[j] = __expf(sc[t][j] - mx); den += e[j]; }
                    u32x2 w; w.x = pack2(e[0], e[1]); w.y = pack2(e[2], e[3]);
                    *(LAS u32x2*)(Pw + fr * 168 + t * 16 + 4 * fq) = w;
                }
            }
            if (meta) { unsigned zz = 0u; asm volatile("" : "+v"(zz)); u32x2 z = {zz, zz}; *(LAS u32x2*)(Pw + fr * 168 + 16 + 4 * fq) = z; }
            den += __shfl_xor(den, 16); den += __shfl_xor(den, 32);
            den += __expf(sink - mx);
            const float rden = 1.f / den;
            LDS_FENCE();
            f32x4 oacc[4];
#pragma unroll
            for (int dtl = 0; dtl < 4; ++dtl) oacc[dtl] = (f32x4){0.f, 0.f, 0.f, 0.f};
            const int nks = meta ? 1 : 5;
#pragma unroll
            for (int ks = 0; ks < 5; ++ks) {
                if (ks < nks) {
                    const int pc = 32 * ks + 8 * fq;
                    const bf16x8 pf = *(const LAS bf16x8*)(Pw + fr * 168 + pc);
                    const int vcol = (pc < 16 || meta) ? pc : pc + 16 * wid;
#pragma unroll
                    for (int dtl = 0; dtl < 4; ++dtl) {
                        const bf16x8 vf = *(const LAS bf16x8*)(Vt + (dtl * 16 + fr) * 280 + vcol);
                        oacc[dtl] = MFMA16(vf, pf, oacc[dtl]);
                    }
                }
            }
            LDS_FENCE();
#pragma unroll
            for (int dtl = 0; dtl < 4; ++dtl) {
                u32x2 w; w.x = pack2(oacc[dtl][0] * rden, oacc[dtl][1] * rden); w.y = pack2(oacc[dtl][2] * rden, oacc[dtl][3] * rden);
                *(u32x2*)(ao + (size_t)tq * DM + hq * 64 + dtl * 16 + 4 * fq) = w;
            }
        }
    }
}
enum { K_PREP = 0, K_HIN, K_HPREP, K_HLOCAL, K_HSCAN, K_HOUT, K_GOUT, K_LN1, K_UP, K_CONV, K_DOWN, K_LN2, K_QKV, K_ATTN };
constexpr int N_PHASES = 1 + 2 * 11 + 2 * 8;
__host__ __device__ __forceinline__ void decode_phase(int ph, int& kind, int& layer) {
    if (ph == 0) { kind = K_PREP; layer = 0; return; }
    int r = ph - 1; layer = 0;
    if (r >= 19) { r -= 19; layer = 2; }
    if (r < 11) { kind = K_HIN + r; return; }
    r -= 11; layer += 1;
    kind = r == 0 ? K_QKV : (r == 1 ? K_ATTN : K_GOUT + (r - 2));
}
__global__ void __launch_bounds__(512, 2) fwd_megakernel(Params pin) {
    extern __shared__ __attribute__((aligned(16))) unsigned char shm[];
    LAS unsigned char* lds = (LAS unsigned char*)shm;
    cg::grid_group grid = cg::this_grid();
    volatile LAS unsigned* xst = (volatile LAS unsigned*)(lds + LDS_MAIN);
    if (threadIdx.x == 0) { xst[0] = 0u; xst[1] = 0u; }
    __syncthreads();
    XcdBarrier xb = xcd_barrier_post((unsigned*)(pin.ws + O_BAR), xst);
    if (pin.ph_lo == 0) { phase_prep(pin, lds); if (pin.ph_hi > 1) grid.sync(); }
    for (int ph = pin.ph_lo < 1 ? 1 : pin.ph_lo; ph < pin.ph_hi; ++ph) {
        Ctx p; { unsigned lo = (unsigned)(size_t)pin.ws, hi = (unsigned)((size_t)pin.ws >> 32); asm volatile("" : "+s"(lo), "+s"(hi)); p.ws = (unsigned char*)(__attribute__((address_space(1))) unsigned char*)(((size_t)hi << 32) | lo); p.out = pin.out; }
        ph = __builtin_amdgcn_readfirstlane(ph);
        int kind, layer; decode_phase(ph, kind, layer);
        const int jj = layer >> 1;
        bf16_t* hb = (bf16_t*)(p.ws + O_HB); float* h = (float*)(p.ws + O_H);
        bf16_t* mix = (bf16_t*)(p.ws + O_MIX);
        switch (kind) {
        case K_HIN: case K_QKV: case K_UP: {
            const bf16_t* w; bf16_t* O; int N;
            if (kind == K_HIN) { w = (const bf16_t*)(p.ws + O_WT_HIN) + (size_t)jj * 12288 * 2048; O = (bf16_t*)(p.ws + O_U); N = HYB_N;
                const int lane = tidx() & 63, wid = tidx() >> 6; const bf16_t* ws_ = (const bf16_t*)(p.ws + O_WT_HSIDE) + (size_t)jj * 48 * 2048; float* side = (float*)(p.ws + O_SIDE);
                for (int rt = bidx() * 8 + wid; rt < 513; rt += gridDim.x * 8) {
                    f32x4 a0 = {0.f, 0.f, 0.f, 0.f}, a1 = {0.f, 0.f, 0.f, 0.f}, a2 = {0.f, 0.f, 0.f, 0.f};
                    const bf16_t* pa = hb + (size_t)(rt * 16 + (lane & 15)) * 2048 + 8 * (lane >> 4);
                    const bf16_t* pb = ws_ + (size_t)(lane & 15) * 2048 + 8 * (lane >> 4);
#pragma unroll 8
                    for (int k0 = 0; k0 < 2048; k0 += 32) {
                        const bf16x8 a = *(const bf16x8*)(pa + k0);
                        a0 = MFMA16(*(const bf16x8*)(pb + k0), a, a0); a1 = MFMA16(*(const bf16x8*)(pb + 16 * 2048 + k0), a, a1); a2 = MFMA16(*(const bf16x8*)(pb + 32 * 2048 + k0), a, a2);
                    }
                    float* sr = side + (size_t)(rt * 16 + (lane & 15)) * 64 + 4 * (lane >> 4);
                    *(f32x4*)sr = a0; *(f32x4*)(sr + 16) = a1; *(f32x4*)(sr + 32) = a2; }
            } else if (kind == K_QKV) { w = (const bf16_t*)(p.ws + O_WT_QKV) + (size_t)jj * 3072 * 2048; O = (bf16_t*)(p.ws + O_U); N = QKV_N; }
            else { w = (const bf16_t*)(p.ws + O_WT_UP) + (size_t)layer * 11008 * 2048; O = (bf16_t*)(p.ws + O_R2); N = DFF2; }
            EpiStoreBf16 em{O, N}, e{O + (size_t)16 * N, N};
            gemm_full(lds, hb, w, N, 2048, em, e);
        } break;
        case K_GOUT: case K_DOWN: {
            const bf16_t* w; int K;
            if (kind == K_DOWN) { w = (const bf16_t*)(p.ws + O_WT_DOWN) + (size_t)layer * 2048 * 5504; K = DFF; }
            else if ((layer & 1) == 0) { w = (const bf16_t*)(p.ws + O_WT_HOUT) + (size_t)jj * 2048 * 4096; K = 4096; }
            else { w = (const bf16_t*)(p.ws + O_WT_SOUT) + (size_t)jj * 2048 * 2048; K = 2048; }
            EpiResF32 em{h, hb}, e{h + (size_t)16 * DM, hb + (size_t)16 * DM};
            gemm_full(lds, mix, w, 2048, K, em, e);
        } break;
        case K_HPREP: phase_hyb_prep(p, jj, lds); break;
        case K_HLOCAL: phase_hyb_local(p, lds); break;
        case K_HSCAN: phase_hyb_scan(p); break;
        case K_HOUT: phase_hyb_out(p, jj, lds); break;
        case K_ATTN: phase_attn(p, jj, lds); break;
        case K_LN1: phase_ln(p, p.in(20) + (size_t)layer * DM, p.in(21) + (size_t)layer * DM, false); break;
        case K_LN2: phase_ln(p, p.in(22) + (size_t)layer * DM, p.in(23) + (size_t)layer * DM, layer == 3); break;
        case K_CONV: phase_ffn_conv(p, layer); break;
        default: break;
        }
        if (ph + 1 < pin.ph_hi) xcd_barrier(xb);
    }
}

extern "C" void kernel_launch(void* const* d_in, const int* in_sizes, int n_in, void* d_out, int out_size, void* d_ws, size_t ws_size, hipStream_t stream) {
    static int grid = 0;
    if (grid == 0) {
        if (n_in != 24 || ws_size < WS_END) { fprintf(stderr, "kernel_launch: unexpected inputs (n_in %d, ws %zu, need %zu)\n", n_in, ws_size, (size_t)WS_END); grid = -1; return; }
        int dev = 0, cus = 0, per_cu = 0;
        (void)hipGetDevice(&dev);
        (void)hipDeviceGetAttribute(&cus, hipDeviceAttributeMultiprocessorCount, dev);
        if (hipFuncSetAttribute((const void*)fwd_megakernel, hipFuncAttributeMaxDynamicSharedMemorySize, LDS_BYTES) != hipSuccess) { fprintf(stderr, "kernel_launch: hipFuncSetAttribute failed\n"); grid = -1; return; }
        if (hipOccupancyMaxActiveBlocksPerMultiprocessor(&per_cu, (const void*)fwd_megakernel, NTHREADS, LDS_BYTES) != hipSuccess || per_cu < 1) { fprintf(stderr, "kernel_launch: occupancy query gave %d\n", per_cu); per_cu = 1; }
        (void)hipGetLastError();
        grid = cus * per_cu;
        if (grid > 256) grid = 256;
        fprintf(stderr, "kernel_launch: grid %d (cus %d, per_cu %d), ws need %zu of %zu\n", grid, cus, per_cu, (size_t)WS_END, ws_size);
    }
    if (grid < 0) return;
    Params p{};
    for (int i = 0; i < 24; ++i) p.in[i] = (const float*)d_in[i];
    p.out = (float*)d_out; p.ws = (unsigned char*)d_ws;
    for (int i = 0; i < 8; ++i) p.inv_freq[i] = powf(500000.0f, -(float)i / 8.0f);
#if PER_PHASE_LAUNCH
    for (int ph = 0; ph < N_PHASES; ++ph) {
        p.ph_lo = ph; p.ph_hi = ph + 1;
        hipLaunchKernelGGL(fwd_megakernel, dim3(grid), dim3(NTHREADS), LDS_BYTES, stream, p);
        { int kind, layer; decode_phase(ph, kind, layer); if ((DUP_MASK >> kind) & 1) hipLaunchKernelGGL(fwd_megakernel, dim3(grid), dim3(NTHREADS), LDS_BYTES, stream, p); }
    }
#else
    p.ph_lo = 0; p.ph_hi = N_PHASES;
    if (hipMemsetAsync((unsigned char*)d_ws + O_BAR, 0, XCD_BAR_WORDS * 4, stream) != hipSuccess) fprintf(stderr, "kernel_launch: memset failed\n");
    void* args[] = {&p};
    hipError_t e = hipLaunchCooperativeKernel((const void*)fwd_megakernel, dim3(grid), dim3(NTHREADS), args, LDS_BYTES, stream);
    if (e != hipSuccess) fprintf(stderr, "cooperative launch failed: %s (grid %d)\n", hipGetErrorString(e), grid);
#endif
}
```

```cpp
#include <hip/hip_runtime.h>
#include <hip/hip_cooperative_groups.h>
#include <cstdio>
#include <cmath>
namespace cg = cooperative_groups;
#ifndef PER_PHASE_LAUNCH
#define PER_PHASE_LAUNCH 0
#endif
__device__ __forceinline__ int tidx() { int t = threadIdx.x; asm volatile("" : "+v"(t)); return t; }
__device__ __forceinline__ int bidx() { int b = blockIdx.x; asm volatile("" : "+s"(b)); return b; }
#ifndef DUP_MASK
#define DUP_MASK 0
#endif
namespace pg8 {
#define PG8_LAS __attribute__((address_space(3)))
typedef unsigned short bf16_t;
typedef short bf16x8 __attribute__((ext_vector_type(8)));
typedef float f32x4 __attribute__((ext_vector_type(4)));
typedef unsigned u32x4 __attribute__((ext_vector_type(4)));
constexpr int BM = 256, BK = 64, HALF = 128, HTB = HALF * BK * 2  , STAGE_BYTES = 8 * HTB, NXCD = 8, WGM = 8;

__host__ __device__ __forceinline__ int lds_byte(int r, int c) { const int st = (r >> 4) * 2 + (c >> 5), rr = r & 15, cc = c & 31, ob = rr * 64 + cc * 2; return st * 1024 + (ob ^ (((ob >> 9) & 1) << 5)); }
__host__ __device__ __forceinline__ void stage_rc(int b, int& R, int& C) { const int st = b / 1024, sb = b % 1024, swz = sb ^ (((sb >> 9) & 1) << 5); R = (st >> 1) * 16 + swz / 64; C = (st & 1) * 32 + (swz % 64) / 2; }
__host__ __device__ __forceinline__ int perm32(int rho) { const int n = rho >> 4, i = rho & 15; return 8 * (i >> 2) + 4 * n + (i & 3); }

struct Unit { int pm, pn; };
struct Gemm { const bf16_t* A; const bf16_t* Bt; int M, N, K; };

struct StaticOrder {
    int nM, nN, nwg, G, c;
    __host__ __device__ void init(int M, int N, int G_, int c_) { nM = M / BM; nN = N / BM; nwg = nM * nN; G = G_; c = c_; }
    __host__ __device__ bool next(int i, Unit& u) const {
        const long L = (long)i * G + c; if (L >= nwg) return false;
        int wgid = (int)L; { const int q = nwg / NXCD, r = nwg % NXCD, xcd = wgid % NXCD, off = wgid / NXCD; wgid = (xcd < r ? xcd * (q + 1) : r * (q + 1) + (xcd - r) * q) + off; }
        const int nig = WGM * nN, gid = wgid / nig, fm = gid * WGM, gsz = (nM - fm) < WGM ? (nM - fm) : WGM;
        u.pm = fm + ((wgid % nig) % gsz); u.pn = (wgid % nig) / gsz; return true;
    }
    __device__ __forceinline__ void a_ready(const Unit&) const {}
    __device__ __forceinline__ void done(const Unit&) const {}
};
__device__ __forceinline__ unsigned cvt_pk_bf16(float lo, float hi) { unsigned r; asm volatile("v_cvt_pk_bf16_f32 %0, %1, %2" : "=v"(r) : "v"(lo), "v"(hi)); return r; }
typedef float f32x2 __attribute__((ext_vector_type(2)));

template <class Epi, class Sched, bool STAMP = false>
__device__ __forceinline__ void gemm_phase(PG8_LAS unsigned char* lds, const Gemm g, const Sched& S, const Epi& E, unsigned long long* stamps) {
    const int tid = tidx(), wid = __builtin_amdgcn_readfirstlane(tid >> 6), lane = tid & 63, wr = wid >> 2, wc = wid & 3, fr = lane & 15, fq = lane >> 4;
    const int K = g.K, nt = K / BK;
    int ts_lo = 0, ts_hi = 0, nts = 0; const unsigned long long rt_entry = STAMP ? (unsigned long long)wall_clock64() : 0ull;
#define PG8_STAMP() do { if (STAMP && wid == 0 && nts < 64) { const unsigned long long _c = (unsigned long long)clock64(); \
        ts_lo = (lane == nts) ? (int)(unsigned)_c : ts_lo; ts_hi = (lane == nts) ? (int)(unsigned)(_c >> 32) : ts_hi; ++nts; } } while (0)
    PG8_STAMP();
    unsigned voffA[2], voffB[2];
#pragma unroll
    for (int i = 0; i < 2; ++i) { int R, C; stage_rc(tid * 16 + i * 8192, R, C); const int Rb = Epi::PERM ? ((R & ~31) + perm32(R & 31)) : R;
        voffA[i] = (unsigned)(R * K + C) * 2u; voffB[i] = (unsigned)(Rb * K + C) * 2u; }
    const size_t kstep = (size_t)(BK * 2);
    const size_t hstep = (size_t)HALF * K * 2;
    const size_t tstep = 2 * hstep;
    const unsigned ldsw = (unsigned)wid * 1024u;
    const int aoff = lds_byte(wr * 64 + fr, fq * 8), boff = lds_byte(wc * 32 + fr, fq * 8);
#define PG8_SA(b, h) (((b) * 2 + (h)) * HTB)
#define PG8_SB(b, h) ((4 + (b) * 2 + (h)) * HTB)
#define PG8_STAGE(bufoff, gbase, voff) do { _Pragma("unroll") for (int _i = 0; _i < 2; ++_i) \
        __builtin_amdgcn_global_load_lds((const unsigned*)((const char*)(gbase) + (voff)[_i]), (PG8_LAS unsigned*)(lds + (bufoff) + ldsw + _i * 8192), 16, 0, 0); } while (0)
#define PG8_LDA(dst, b, h) do { _Pragma("unroll") for (int m = 0; m < 4; ++m) _Pragma("unroll") for (int k = 0; k < 2; ++k) dst[m][k] = *(const PG8_LAS bf16x8*)(lds + PG8_SA(b, h) + aoff + m * 2048 + k * 1024); } while (0)
#define PG8_LDB(dst, b, h) do { _Pragma("unroll") for (int n = 0; n < 2; ++n) _Pragma("unroll") for (int k = 0; k < 2; ++k) dst[n][k] = *(const PG8_LAS bf16x8*)(lds + PG8_SB(b, h) + boff + n * 2048 + k * 1024); } while (0)
#define PG8_MMA(ai, bj, At, Bt) do { __builtin_amdgcn_s_setprio(1); _Pragma("unroll") for (int m = 0; m < 4; ++m) _Pragma("unroll") for (int n = 0; n < 2; ++n) _Pragma("unroll") for (int k = 0; k < 2; ++k) \
        acc[ai][bj][m][n] = __builtin_amdgcn_mfma_f32_16x16x32_bf16(Bt[n][k], At[m][k], acc[ai][bj][m][n], 0, 0, 0); __builtin_amdgcn_s_setprio(0); } while (0)
#define PG8_WAIT_V(n) asm volatile("s_waitcnt vmcnt(" #n ")" ::: "memory")
#define PG8_WAIT_L(n) asm volatile("s_waitcnt lgkmcnt(" #n ")" ::: "memory")
#define PG8_BAR __builtin_amdgcn_s_barrier()
#define PG8_SCHED __builtin_amdgcn_sched_barrier(0)
    Unit cur, nxt; int ui = 0;
    if (!S.next(0, cur)) return;
    f32x4 acc[2][2][4][2];
#pragma unroll
    for (int a = 0; a < 2; ++a)
#pragma unroll
        for (int b = 0; b < 2; ++b)
#pragma unroll
            for (int m = 0; m < 4; ++m)
#pragma unroll
                for (int n = 0; n < 2; ++n) acc[a][b][m][n] = (f32x4){0.f, 0.f, 0.f, 0.f};
    bf16x8 At[4][2], B0[2][2], B1[2][2];
    const char* cA = (const char*)g.A + (size_t)cur.pm * tstep; const char* cB = (const char*)g.Bt + (size_t)cur.pn * tstep;
    S.a_ready(cur);
    PG8_STAGE(PG8_SB(0, 0), cB, voffB); PG8_STAGE(PG8_SA(0, 0), cA, voffA); PG8_STAGE(PG8_SB(0, 1), cB + hstep, voffB); PG8_STAGE(PG8_SA(0, 1), cA + hstep, voffA);
    if (wr == 1) PG8_BAR;
    PG8_WAIT_V(4); PG8_BAR;
    PG8_STAGE(PG8_SB(1, 0), cB + kstep, voffB); PG8_STAGE(PG8_SA(1, 0), cA + kstep, voffA); PG8_STAGE(PG8_SB(1, 1), cB + hstep + kstep, voffB);
    PG8_WAIT_V(6); PG8_BAR;
    PG8_STAMP();
    for (;;) {
        const bool has_next = S.next(ui + 1, nxt);
        const char* nA = has_next ? (const char*)g.A + (size_t)nxt.pm * tstep : cA; const char* nB = has_next ? (const char*)g.Bt + (size_t)nxt.pn * tstep : cB;
        for (int t = 0; t < nt; t += 2) {
            const bool last = (t == nt - 2);
            const char* a1 = cA + (size_t)(t + 1) * kstep;
            const char* a2 = last ? nA : cA + (size_t)(t + 2) * kstep; const char* b2 = last ? nB : cB + (size_t)(t + 2) * kstep;
            const char* a3 = a2 + kstep; const char* b3 = b2 + kstep;
            if (last && has_next) S.a_ready(nxt);
            PG8_LDB(B0, 0, 0); PG8_SCHED; PG8_LDA(At, 0, 0); PG8_STAGE(PG8_SA(1, 1), a1 + hstep, voffA);
            PG8_WAIT_L(8); PG8_BAR; PG8_WAIT_L(0); PG8_MMA(0, 0, At, B0); PG8_BAR; PG8_SCHED;
            PG8_LDB(B1, 0, 1); PG8_STAGE(PG8_SB(0, 0), b2, voffB);
            PG8_BAR; PG8_WAIT_L(0); PG8_MMA(0, 1, At, B1); PG8_BAR;
            PG8_LDA(At, 0, 1); PG8_STAGE(PG8_SA(0, 0), a2, voffA);
            PG8_BAR; PG8_WAIT_L(0); PG8_MMA(1, 0, At, B0); PG8_BAR; PG8_SCHED;
            PG8_STAGE(PG8_SB(0, 1), b2 + hstep, voffB);
            PG8_WAIT_V(6); PG8_BAR; PG8_MMA(1, 1, At, B1); PG8_BAR;
            PG8_LDB(B0, 1, 0); PG8_SCHED; PG8_LDA(At, 1, 0); PG8_STAGE(PG8_SA(0, 1), a2 + hstep, voffA);
            PG8_WAIT_L(8); PG8_BAR; PG8_WAIT_L(0); PG8_MMA(0, 0, At, B0); PG8_BAR; PG8_SCHED;
            PG8_LDB(B1, 1, 1); PG8_STAGE(PG8_SB(1, 0), b3, voffB);
            PG8_BAR; PG8_WAIT_L(0); PG8_MMA(0, 1, At, B1); PG8_BAR;
            PG8_LDA(At, 1, 1); PG8_STAGE(PG8_SA(1, 0), a3, voffA);
            PG8_BAR; PG8_WAIT_L(0); PG8_MMA(1, 0, At, B0); PG8_BAR; PG8_SCHED;
            PG8_STAGE(PG8_SB(1, 1), b3 + hstep, voffB);
            PG8_WAIT_V(6); PG8_BAR; PG8_MMA(1, 1, At, B1); PG8_BAR;
        }
        PG8_STAMP();
        if constexpr (!Epi::AFTER_DRAIN) { E(acc, cur, wr, wc, fr, fq); S.done(cur); }
        PG8_STAMP();
        if (!has_next) break;
#pragma unroll
        for (int a = 0; a < 2; ++a)
#pragma unroll
            for (int b = 0; b < 2; ++b)
#pragma unroll
                for (int m = 0; m < 4; ++m)
#pragma unroll
                    for (int n = 0; n < 2; ++n) acc[a][b][m][n] = (f32x4){0.f, 0.f, 0.f, 0.f};
        cur = nxt; cA = nA; cB = nB; ++ui;
    }
    PG8_WAIT_V(0);
    if (wr == 0) PG8_BAR;
    PG8_BAR;
    if constexpr (Epi::AFTER_DRAIN) { E.fused(acc, cur, wr, wc, fr, fq, lds, wid, lane); S.done(cur); }
    PG8_STAMP();
    if (STAMP && wid == 0) { stamps[lane] = lane < nts ? (((unsigned long long)(unsigned)ts_hi << 32) | (unsigned)ts_lo) : 0ull;
        if (lane == 62) stamps[62] = rt_entry; if (lane == 63) stamps[63] = (unsigned long long)wall_clock64(); }
#undef PG8_STAMP
#undef PG8_SA
#undef PG8_SB
#undef PG8_STAGE
#undef PG8_LDA
#undef PG8_LDB
#undef PG8_MMA
#undef PG8_WAIT_V
#undef PG8_WAIT_L
#undef PG8_BAR
#undef PG8_SCHED
}
}
using pg8::bf16_t; using pg8::bf16x8; using pg8::f32x4; using pg8::u32x4;
#define LAS __attribute__((address_space(3)))
typedef unsigned u32x2 __attribute__((ext_vector_type(2)));

constexpr int L_TOK = 8208, DM = 2048;
constexpr int HYB_N = 12288, DFF = 5504, DFF2 = 11008, QKV_N = 3072;
constexpr int UZ = 0, UXBC = 2048, UQ = 6144, UK = 7168, UV = 8192, UR = 10240;
constexpr float ALPHA = 1.6817928305074292f;
constexpr int NTHREADS = 512;
constexpr int LDS_MAIN = 143360;
constexpr int LDS_BYTES = LDS_MAIN + 256;

constexpr size_t al256(size_t x) { return (x + 255) & ~(size_t)255; }
constexpr size_t O_WT_HIN   = 0;
constexpr size_t O_WT_HSIDE = O_WT_HIN   + al256(2ull * 12288 * 2048 * 2);
constexpr size_t O_WT_HOUT  = O_WT_HSIDE + al256(2ull * 48 * 2048 * 2);
constexpr size_t O_WT_QKV   = O_WT_HOUT  + al256(2ull * 2048 * 4096 * 2);
constexpr size_t O_WT_SOUT  = O_WT_QKV   + al256(2ull * 3072 * 2048 * 2);
constexpr size_t O_WT_UP    = O_WT_SOUT  + al256(2ull * 2048 * 2048 * 2);
constexpr size_t O_WT_DOWN  = O_WT_UP    + al256(4ull * 11008 * 2048 * 2);
constexpr size_t O_H        = O_WT_DOWN  + al256(4ull * 2048 * 5504 * 2);
constexpr size_t O_HB       = O_H        + al256((size_t)L_TOK * 2048 * 4);
constexpr size_t O_U        = O_HB       + al256((size_t)L_TOK * 2048 * 2);
constexpr size_t O_R2       = O_U        + al256((size_t)L_TOK * 12288 * 2);
constexpr size_t GLA_ST_BYTES = 129ull * 4 * 512 * 256 * 2;
constexpr size_t O_MIX      = O_R2       + al256(2 * GLA_ST_BYTES);
constexpr size_t O_XC       = O_MIX      + al256((size_t)L_TOK * 5504 * 2);
constexpr size_t O_SIDE     = O_XC       + al256((size_t)L_TOK * 4096 * 2);
constexpr size_t O_DT       = O_SIDE     + al256((size_t)L_TOK * 64 * 4);
constexpr size_t O_ACS      = O_DT       + al256((size_t)L_TOK * 32 * 4);
constexpr size_t O_QT       = O_ACS      + al256((size_t)L_TOK * 32 * 4);
constexpr size_t O_KT       = O_QT       + al256((size_t)L_TOK * 1024 * 2);
constexpr size_t O_GLAST    = O_KT       + al256((size_t)L_TOK * 1024 * 2);
constexpr size_t O_CDEC     = O_GLAST    + al256(129ull * 1024 * 4);
constexpr size_t O_SSDLOC   = O_CDEC     + al256(65ull * 32 * 4);
constexpr size_t O_SSDPREV  = O_SSDLOC   + al256(65ull * 32 * 64 * 128 * 4);
constexpr size_t O_ROPE     = O_SSDPREV  + al256(65ull * 32 * 64 * 128 * 2);
constexpr size_t O_TAB      = O_ROPE     + al256((size_t)L_TOK * 16 * 4);
constexpr size_t O_BAR      = O_TAB      + 256;
constexpr size_t WS_END     = O_BAR      + al256(4096 * 4);
static_assert(WS_END <= 1442840576ull, "workspace too large");

struct Params {
    const float* in[24];
    float* out;
    unsigned char* ws;
    float inv_freq[8];
    int ph_lo, ph_hi;
};

struct Ctx { unsigned char* ws; float* out;
    __device__ __forceinline__ const float* in(int k) const { const size_t a = ((const size_t*)(ws + O_TAB))[k]; return (const float*)(const __attribute__((address_space(1))) float*)a; } };

__device__ __forceinline__ bf16_t f2bf(float f) { unsigned u = __float_as_uint(f); u += 0x7FFFu + ((u >> 16) & 1u); return (bf16_t)(u >> 16); }
__device__ __forceinline__ float bf2f(bf16_t b) { return __uint_as_float(((unsigned)b) << 16); }
__device__ __forceinline__ unsigned pack2(float lo, float hi) { unsigned r; asm("v_cvt_pk_bf16_f32 %0, %1, %2" : "=v"(r) : "v"(lo), "v"(hi)); return r; }
__device__ __forceinline__ float bflo(unsigned w) { return __uint_as_float(w << 16); }
__device__ __forceinline__ float bfhi(unsigned w) { return __uint_as_float(w & 0xffff0000u); }
__device__ __forceinline__ float silu_f(float x) { return x / (1.f + __expf(-x)); }
__device__ __forceinline__ float wave_sum(float v) {
#pragma unroll
    for (int o = 32; o > 0; o >>= 1) v += __shfl_xor(v, o);
    return v;
}
__device__ __forceinline__ bf16x8 ldfrag(const LAS bf16_t* base, int ld, int row0, int k0, int lane) {
    return *(const LAS bf16x8*)(base + (row0 + (lane & 15)) * ld + k0 + 8 * (lane >> 4));
}
__device__ __forceinline__ bf16x8 gfrag(const bf16_t* base, size_t ld, int row0, int k0, int lane) {
    return *(const bf16x8*)(base + (size_t)(row0 + (lane & 15)) * ld + k0 + 8 * (lane >> 4));
}
typedef short s16x4 __attribute__((ext_vector_type(4)));
__device__ __forceinline__ bf16x8 ldfrag_tr(const LAS bf16_t* base, int ld, int n0, int k0, int lane) {
    const int g = lane >> 4, i = lane & 15, q = i >> 2, pp = i & 3;
    const LAS bf16_t* a = base + (k0 + 8 * g + q) * ld + n0 + 4 * pp;
    const s16x4 r1 = __builtin_amdgcn_ds_read_tr16_b64_v4i16((LAS s16x4*)a);
    const s16x4 r2 = __builtin_amdgcn_ds_read_tr16_b64_v4i16((LAS s16x4*)(a + 4 * ld));
    return __builtin_shufflevector(r1, r2, 0, 1, 2, 3, 4, 5, 6, 7);
}
#define MFMA16(a, b, c) __builtin_amdgcn_mfma_f32_16x16x32_bf16((a), (b), (c), 0, 0, 0)
#define LDS_FENCE() asm volatile("s_waitcnt lgkmcnt(0)" ::: "memory")

struct EpiStoreBf16 {
    static constexpr bool PERM = true, AFTER_DRAIN = false;
    bf16_t* O; int ldc;
    __device__ __forceinline__ void operator()(const f32x4 (&acc)[2][2][4][2], const pg8::Unit& u, int wr, int wc, int fr, int fq) const {
        const int row0 = u.pm * 256 + wr * 64 + fr, col0 = u.pn * 256 + wc * 32 + 8 * fq;
#pragma unroll
        for (int ai = 0; ai < 2; ++ai)
#pragma unroll
            for (int m = 0; m < 4; ++m) { bf16_t* rowp = O + (size_t)(row0 + ai * 128 + m * 16) * ldc + col0;
#pragma unroll
                for (int bj = 0; bj < 2; ++bj) { const f32x4 v0 = acc[ai][bj][m][0], v1 = acc[ai][bj][m][1];
                    u32x4 w; w.x = pg8::cvt_pk_bf16(v0[0], v0[1]); w.y = pg8::cvt_pk_bf16(v0[2], v0[3]); w.z = pg8::cvt_pk_bf16(v1[0], v1[1]); w.w = pg8::cvt_pk_bf16(v1[2], v1[3]);
                    *(u32x4*)(rowp + bj * 128) = w; } }
    }
    __device__ __forceinline__ void meta(int row, int col, f32x4 v) const {
        u32x2 w; w.x = pg8::cvt_pk_bf16(v[0], v[1]); w.y = pg8::cvt_pk_bf16(v[2], v[3]);
        *(u32x2*)(O + (size_t)row * ldc + col) = w;
    }
};
struct EpiResF32 {
    static constexpr bool PERM = false, AFTER_DRAIN = false;
    float* H; const bf16_t* HB;
    __device__ __forceinline__ void operator()(const f32x4 (&acc)[2][2][4][2], const pg8::Unit& u, int wr, int wc, int fr, int fq) const {
        const int row0 = u.pm * 256 + wr * 64 + fr, col0 = u.pn * 256 + wc * 32 + 4 * fq;
#pragma unroll
        for (int ai = 0; ai < 2; ++ai)
#pragma unroll
            for (int m = 0; m < 4; ++m) { const size_t ro = (size_t)(row0 + ai * 128 + m * 16) * DM + col0;
#pragma unroll
                for (int bj = 0; bj < 2; ++bj)
#pragma unroll
                    for (int n = 0; n < 2; ++n) { const size_t o = ro + bj * 128 + n * 16; const u32x2 hw = *(const u32x2*)(HB + o);
                        const f32x4 hv = {bflo(hw.x), bfhi(hw.x), bflo(hw.y), bfhi(hw.y)}; *(f32x4*)(H + o) = hv * ALPHA + acc[ai][bj][m][n]; } }
    }
    __device__ __forceinline__ void meta(int row, int col, f32x4 v) const {
        const size_t o = (size_t)row * DM + col; const u32x2 hw = *(const u32x2*)(HB + o);
        const f32x4 hv = {bflo(hw.x), bfhi(hw.x), bflo(hw.y), bfhi(hw.y)}; *(f32x4*)(H + o) = hv * ALPHA + v;
    }
};
__device__ __forceinline__ f32x4 wave_gemm16(const bf16_t* A, const bf16_t* Bt, int K, int lane) {
    f32x4 acc = {0.f, 0.f, 0.f, 0.f};
    const bf16_t* pa = A + (size_t)(lane & 15) * K + 8 * (lane >> 4);
    const bf16_t* pb = Bt + (size_t)(lane & 15) * K + 8 * (lane >> 4);
#pragma unroll 16
    for (int k0 = 0; k0 < K; k0 += 32) {
        const bf16x8 a = *(const bf16x8*)(pa + k0), b = *(const bf16x8*)(pb + k0);
        acc = MFMA16(b, a, acc);
    }
    return acc;
}
template <class Epi>
__device__ __forceinline__ void gemm_full(LAS unsigned char* lds, const bf16_t* A, const bf16_t* Bt, int N, int K, const Epi& Emeta, const Epi& Emain) {
    const int lane = tidx() & 63, wid = tidx() >> 6;
    for (int tile = bidx() * 8 + wid; tile < N / 16; tile += gridDim.x * 8) {
        const f32x4 acc = wave_gemm16(A, Bt + (size_t)tile * 16 * K, K, lane);
        Emeta.meta(lane & 15, tile * 16 + 4 * (lane >> 4), acc);
    }
    pg8::Gemm g{A + (size_t)16 * K, Bt, 8192, N, K};
    pg8::StaticOrder S; S.init(8192, N, (int)gridDim.x, (int)bidx());
    pg8::gemm_phase<Epi, pg8::StaticOrder, false>(lds, g, S, Emain, nullptr);
    __syncthreads();
}
#define XB_TMO      128
#define XB_XCNT(j)  (256  + 64 * (j))
#define XB_XSUB(j)  (1280 + 64 * (j))
#define XB_XGEN(j)  (2304 + 64 * (j))
#define XB_TOP      3328
#define XB_TOPGEN   3392
#define XCD_BAR_WORDS 3456
#define XB_SPIN_CAP (1u << 18)

__device__ __forceinline__ unsigned xb_ld(unsigned* p)              { return __hip_atomic_load(p, __ATOMIC_RELAXED, __HIP_MEMORY_SCOPE_AGENT); }
__device__ __forceinline__ unsigned xb_add(unsigned* p, unsigned v) { return __hip_atomic_fetch_add(p, v, __ATOMIC_RELAXED, __HIP_MEMORY_SCOPE_AGENT); }
__device__ __forceinline__ unsigned xb_xcc_id() { return (unsigned)__builtin_amdgcn_s_getreg((3 << 11) | 20) & 0xFu; }
#define XB_SPIN(cond, bar) do { unsigned _sp = 0; while (cond) { __builtin_amdgcn_s_sleep(1); \
    if ((++_sp & 255u) == 0u) { if (xb_ld(&(bar)[XB_TMO])) break; if (_sp > XB_SPIN_CAP) { atomicAdd(&(bar)[XB_TMO], 1u); break; } } } } while (0)

struct XcdBarrier {
    unsigned* bar; unsigned x;
    volatile LAS unsigned* st;
};

__device__ __forceinline__ XcdBarrier xcd_barrier_post(unsigned* bar, volatile LAS unsigned* st) {
    XcdBarrier b; b.bar = bar; b.x = xb_xcc_id(); b.st = st;
    if (threadIdx.x == 0) (void)xb_add(&bar[XB_XCNT(b.x)], 1u);
    return b;
}
__device__ __forceinline__ void xcd_barrier_complete(unsigned* bar, unsigned x, unsigned& nloc, unsigned& nx) {
    const unsigned G = gridDim.x * gridDim.y * gridDim.z;
    unsigned sum, cnt, mine, sp = 0u;
    for (;;) {
        sum = 0u; cnt = 0u; mine = 0u;
#pragma unroll
        for (unsigned j = 0; j < 16; ++j) { const unsigned c = xb_ld(&bar[XB_XCNT(j)]); sum += c; cnt += (c > 0u) ? 1u : 0u; mine = (j == x) ? c : mine; }
        if (sum == G) break;
        __builtin_amdgcn_s_sleep(1);
        if ((++sp & 255u) == 0u) { if (xb_ld(&bar[XB_TMO])) break; if (sp > XB_SPIN_CAP) { atomicAdd(&bar[XB_TMO], 1u); break; } }
    }
    nloc = mine > 0u ? mine : 1u; nx = cnt > 0u ? cnt : 1u;
}

__device__ __forceinline__ void xcd_barrier(const XcdBarrier& b) {
    asm volatile("s_waitcnt vmcnt(0)" ::: "memory");
    __syncthreads();
    if (threadIdx.x == 0) {
        unsigned* bar = b.bar;
        __builtin_amdgcn_s_waitcnt(0);
        unsigned nloc = b.st[0], nx = b.st[1];
        if (nloc == 0u) { xcd_barrier_complete(bar, b.x, nloc, nx); b.st[0] = nloc; b.st[1] = nx; }
        const unsigned old = xb_add(&bar[XB_XSUB(b.x)], 1u);
        const unsigned gen = old / nloc;
        if (old + 1u == (gen + 1u) * nloc) {
            __builtin_amdgcn_fence(__ATOMIC_RELEASE, "agent");
            asm volatile("s_waitcnt vmcnt(0)" ::: "memory");
            const unsigned og = xb_add(&bar[XB_TOP], 1u);
            const unsigned tg = og / nx;
            if (og + 1u == (tg + 1u) * nx) xb_add(&bar[XB_TOPGEN], 1u);
            else XB_SPIN(xb_ld(&bar[XB_TOPGEN]) == tg, bar);
            __builtin_amdgcn_fence(__ATOMIC_ACQUIRE, "agent");
            xb_add(&bar[XB_XGEN(b.x)], 1u);
            asm volatile("s_waitcnt vmcnt(0)" ::: "memory");
        } else {
            XB_SPIN(xb_ld(&bar[XB_XGEN(b.x)]) == gen, bar);
            __builtin_amdgcn_fence(__ATOMIC_ACQUIRE, "agent");
            asm volatile("s_waitcnt vmcnt(0)" ::: "memory");
        }
    }
    __syncthreads();
}
struct TJob { const float* src; int ld, ncols, K; bf16_t* dst; };
__device__ __forceinline__ TJob get_job(const Params& p, int j) {
    TJob J;
    bf16_t* ws16 = (bf16_t*)p.ws;
    if (j < 10) {
        const int jj = j / 5, sub = j % 5;
        const float* base = p.in[2] + (size_t)jj * 2048 * 12336;
        bf16_t* wmain = (bf16_t*)(p.ws + O_WT_HIN) + (size_t)jj * 12288 * 2048;
        bf16_t* wside = (bf16_t*)(p.ws + O_WT_HSIDE) + (size_t)jj * 48 * 2048;
        J.ld = 12336; J.K = 2048;
        if (sub == 0)      { J.src = base;          J.ncols = 6144; J.dst = wmain; }
        else if (sub == 1) { J.src = base + 6176;   J.ncols = 4096; J.dst = wmain + (size_t)6144 * 2048; }
        else if (sub == 2) { J.src = base + 10288;  J.ncols = 2048; J.dst = wmain + (size_t)10240 * 2048; }
        else if (sub == 3) { J.src = base + 6144;   J.ncols = 32;   J.dst = wside; }
        else               { J.src = base + 10272;  J.ncols = 16;   J.dst = wside + (size_t)32 * 2048; }
    } else if (j < 12) { const int jj = j - 10; J.src = p.in[12] + (size_t)jj * 4096 * 2048; J.ld = 2048; J.ncols = 2048; J.K = 4096; J.dst = (bf16_t*)(p.ws + O_WT_HOUT) + (size_t)jj * 2048 * 4096; }
    else if (j < 14) { const int jj = j - 12; J.src = p.in[13] + (size_t)jj * 2048 * 3072; J.ld = 3072; J.ncols = 3072; J.K = 2048; J.dst = (bf16_t*)(p.ws + O_WT_QKV) + (size_t)jj * 3072 * 2048; }
    else if (j < 16) { const int jj = j - 14; J.src = p.in[15] + (size_t)jj * 2048 * 2048; J.ld = 2048; J.ncols = 2048; J.K = 2048; J.dst = (bf16_t*)(p.ws + O_WT_SOUT) + (size_t)jj * 2048 * 2048; }
    else if (j < 20) { const int l = j - 16; J.src = p.in[16] + (size_t)l * 2048 * 11008; J.ld = 11008; J.ncols = 11008; J.K = 2048; J.dst = (bf16_t*)(p.ws + O_WT_UP) + (size_t)l * 11008 * 2048; }
    else { const int l = j - 20; J.src = p.in[19] + (size_t)l * 5504 * 2048; J.ld = 2048; J.ncols = 2048; J.K = 5504; J.dst = (bf16_t*)(p.ws + O_WT_DOWN) + (size_t)l * 2048 * 5504; }
    (void)ws16;
    return J;
}
__device__ __forceinline__ void phase_prep(const Params& p, LAS unsigned char* lds) {
    const int tid = tidx();
    LAS float* ts = (LAS float*)lds;
    for (int j = 0; j < 24; ++j) {
        const TJob J = get_job(p, j);
        const int tn = (J.ncols + 127) / 128, tk = J.K / 128;
        for (int tile = bidx(); tile < tn * tk; tile += gridDim.x) {
            const int kb = tile / tn, nb = tile % tn;
            __syncthreads();
            {
                const int c4 = (tid & 31) * 4, n = nb * 128 + c4, r0 = tid >> 5;
                if (n < J.ncols) {
                    float4 v[8];
#pragma unroll
                    for (int i = 0; i < 8; ++i) v[i] = *(const float4*)(J.src + (size_t)(kb * 128 + r0 + 16 * i) * J.ld + n);
#pragma unroll
                    for (int i = 0; i < 8; ++i) { const int r = r0 + 16 * i; ts[r * 129 + c4] = v[i].x; ts[r * 129 + c4 + 1] = v[i].y; ts[r * 129 + c4 + 2] = v[i].z; ts[r * 129 + c4 + 3] = v[i].w; }
                }
            }
            __syncthreads();
            const int n = tid >> 2, kc = tid & 3;
            if (nb * 128 + n < J.ncols) {
#pragma unroll
                for (int q = 0; q < 4; ++q) {
                    const int kk = kc * 32 + q * 8;
                    u32x4 w;
                    w.x = pack2(ts[(kk + 0) * 129 + n], ts[(kk + 1) * 129 + n]);
                    w.y = pack2(ts[(kk + 2) * 129 + n], ts[(kk + 3) * 129 + n]);
                    w.z = pack2(ts[(kk + 4) * 129 + n], ts[(kk + 5) * 129 + n]);
                    w.w = pack2(ts[(kk + 6) * 129 + n], ts[(kk + 7) * 129 + n]);
                    *(u32x4*)(J.dst + (size_t)(nb * 128 + n) * J.K + kb * 128 + kk) = w;
                }
            }
        }
    }
    __syncthreads();
    const size_t gtid = (size_t)bidx() * NTHREADS + tid, gn = (size_t)gridDim.x * NTHREADS;
    float* h = (float*)(p.ws + O_H); bf16_t* hb = (bf16_t*)(p.ws + O_HB);
    for (size_t i = gtid; i < (size_t)L_TOK * 512; i += gn) {
        const int row = (int)(i >> 9), c4 = (int)(i & 511) * 4;
        const float4 v = row < 16 ? *(const float4*)(p.in[1] + (size_t)row * DM + c4) : *(const float4*)(p.in[0] + (size_t)(row - 16) * DM + c4);
        u32x2 w; w.x = pack2(v.x, v.y); w.y = pack2(v.z, v.w);
        *(u32x2*)(hb + i * 4) = w;
    }
    if (gtid < 24) ((const float**)(p.ws + O_TAB))[gtid] = p.in[gtid];
    float* rope = (float*)(p.ws + O_ROPE);
    for (size_t i = gtid; i < (size_t)L_TOK * 8; i += gn) {
        const int pos = (int)(i >> 3), f = (int)(i & 7);
        const float ang = (float)pos * p.inv_freq[f];
        double rev = (double)ang * 0.15915494309189535;
        rev -= rint(rev);
        rope[pos * 16 + f] = __builtin_amdgcn_cosf((float)rev);
        rope[pos * 16 + 8 + f] = __builtin_amdgcn_sinf((float)rev);
    }
}

__device__ __forceinline__ void phase_ln(const Ctx& p, const float* g, const float* b, bool last) {
    const int lane = tidx() & 63, wid = tidx() >> 6;
    float* h = (float*)(p.ws + O_H); bf16_t* hb = (bf16_t*)(p.ws + O_HB);
    for (int row = bidx() * 8 + wid; row < L_TOK; row += gridDim.x * 8) {
        float4 v[8]; float s = 0.f;
#pragma unroll
        for (int i = 0; i < 8; ++i) { v[i] = *(const float4*)(h + (size_t)row * DM + i * 256 + lane * 4); s += v[i].x + v[i].y + v[i].z + v[i].w; }
        const float mean = wave_sum(s) * (1.f / 2048.f);
        float q = 0.f;
#pragma unroll
        for (int i = 0; i < 8; ++i) { v[i].x -= mean; v[i].y -= mean; v[i].z -= mean; v[i].w -= mean; q += v[i].x * v[i].x + v[i].y * v[i].y + v[i].z * v[i].z + v[i].w * v[i].w; }
        const float rstd = rsqrtf(wave_sum(q) * (1.f / 2048.f) + 1e-5f);
#pragma unroll
        for (int i = 0; i < 8; ++i) {
            const int c = i * 256 + lane * 4;
            const float4 gg = *(const float4*)(g + c), bb = *(const float4*)(b + c);
            float4 y; y.x = v[i].x * rstd * gg.x + bb.x; y.y = v[i].y * rstd * gg.y + bb.y; y.z = v[i].z * rstd * gg.z + bb.z; y.w = v[i].w * rstd * gg.w + bb.w;
            if (last) { if (row >= 16) *(float4*)(p.out + (size_t)(row - 16) * DM + c) = y; }
            else { u32x2 w; w.x = pack2(y.x, y.y); w.y = pack2(y.z, y.w); *(u32x2*)(hb + (size_t)row * DM + c) = w; }
        }
    }
}

__device__ __forceinline__ void unpack8(const u32x4 w, float (&f)[8]) {
    f[0] = bflo(w.x); f[1] = bfhi(w.x); f[2] = bflo(w.y); f[3] = bfhi(w.y); f[4] = bflo(w.z); f[5] = bfhi(w.z); f[6] = bflo(w.w); f[7] = bfhi(w.w);
}
__device__ __forceinline__ void ld8f(const float* q, float (&f)[8]) {
    const float4 a = *(const float4*)q, b = *(const float4*)(q + 4);
    f[0] = a.x; f[1] = a.y; f[2] = a.z; f[3] = a.w; f[4] = b.x; f[5] = b.y; f[6] = b.z; f[7] = b.w;
}
__device__ __forceinline__ void phase_ffn_conv(const Ctx& p, int layer) {
    const bf16_t* up = (const bf16_t*)(p.ws + O_R2); bf16_t* act = (bf16_t*)(p.ws + O_MIX);
    const float* cw = p.in(17) + (size_t)layer * 3 * DFF2; const float* cb = p.in(18) + (size_t)layer * DFF2;
    const size_t gtid = (size_t)bidx() * NTHREADS + tidx(), gn = (size_t)gridDim.x * NTHREADS;
    for (size_t task = gtid; task < (size_t)1026 * 688; task += gn) {
        const int jb = (int)(task % 688), tb = (int)(task / 688), j0 = jb * 8, t0 = tb * 8;
        float wg[3][8], wv[3][8], bg[8], bv[8];
#pragma unroll
        for (int k = 0; k < 3; ++k) { ld8f(cw + (size_t)k * DFF2 + j0, wg[k]); ld8f(cw + (size_t)k * DFF2 + DFF + j0, wv[k]); }
        ld8f(cb + j0, bg); ld8f(cb + DFF + j0, bv);
        u32x4 gr[10], vr[10];
#pragma unroll
        for (int r = 0; r < 10; ++r) {
            const int t = t0 - 2 + r;
            gr[r] = (u32x4){0u, 0u, 0u, 0u}; vr[r] = (u32x4){0u, 0u, 0u, 0u};
            if (t >= 0) { gr[r] = *(const u32x4*)(up + (size_t)t * DFF2 + j0); vr[r] = *(const u32x4*)(up + (size_t)t * DFF2 + DFF + j0); }
        }
        float g2[8], g1[8], v2[8], v1[8];
        unpack8(gr[0], g2); unpack8(vr[0], v2); unpack8(gr[1], g1); unpack8(vr[1], v1);
#pragma unroll
        for (int tt = 0; tt < 8; ++tt) {
            const int t = t0 + tt;
            float g0[8], v0[8], o[8];
            unpack8(gr[tt + 2], g0); unpack8(vr[tt + 2], v0);
#pragma unroll
            for (int i = 0; i < 8; ++i) {
                const float gg = bg[i] + wg[0][i] * g2[i] + wg[1][i] * g1[i] + wg[2][i] * g0[i];
                const float vv = bv[i] + wv[0][i] * v2[i] + wv[1][i] * v1[i] + wv[2][i] * v0[i];
                o[i] = silu_f(gg) * vv;
                g2[i] = g1[i]; g1[i] = g0[i]; v2[i] = v1[i]; v1[i] = v0[i];
            }
            u32x4 w; w.x = pack2(o[0], o[1]); w.y = pack2(o[2], o[3]); w.z = pack2(o[4], o[5]); w.w = pack2(o[6], o[7]);
            *(u32x4*)(act + (size_t)t * DFF + j0) = w;
        }
    }
}
__device__ __forceinline__ void phase_hyb_prep(const Ctx& p, int jj, LAS unsigned char* lds) {
    const bf16_t* u = (const bf16_t*)(p.ws + O_U);
    const float* side = (const float*)(p.ws + O_SIDE);
    const int tid = tidx(), lane = tid & 63, wid = tid >> 6;
    const size_t gtid = (size_t)bidx() * NTHREADS + tid, gn = (size_t)gridDim.x * NTHREADS;
    {
        bf16_t* xc = (bf16_t*)(p.ws + O_XC);
        const float* cw = p.in(3) + (size_t)jj * 4 * 4096; const float* cb = p.in(4) + (size_t)jj * 4096;
        for (size_t task = gtid; task < (size_t)1026 * 512; task += gn) {
            const int cbk = (int)(task & 511), tb = (int)(task >> 9), c0 = cbk * 8, t0 = tb * 8;
            float w[4][8], bb[8], x3[8], x2[8], x1[8];
#pragma unroll
            for (int k = 0; k < 4; ++k) ld8f(cw + (size_t)k * 4096 + c0, w[k]);
            ld8f(cb + c0, bb);
            u32x4 xr[11];
#pragma unroll
            for (int r = 0; r < 11; ++r) { const int t = t0 - 3 + r; xr[r] = (u32x4){0u, 0u, 0u, 0u}; if (t >= 0) xr[r] = *(const u32x4*)(u + (size_t)t * HYB_N + UXBC + c0); }
            unpack8(xr[0], x3); unpack8(xr[1], x2); unpack8(xr[2], x1);
#pragma unroll
            for (int tt = 0; tt < 8; ++tt) {
                const int t = t0 + tt;
                float x0[8], o[8];
                unpack8(xr[tt + 3], x0);
#pragma unroll
                for (int i = 0; i < 8; ++i) {
                    const float y = bb[i] + w[0][i] * x3[i] + w[1][i] * x2[i] + w[2][i] * x1[i] + w[3][i] * x0[i];
                    o[i] = silu_f(y);
                    x3[i] = x2[i]; x2[i] = x1[i]; x1[i] = x0[i];
                }
                u32x4 ww; ww.x = pack2(o[0], o[1]); ww.y = pack2(o[2], o[3]); ww.z = pack2(o[4], o[5]); ww.w = pack2(o[6], o[7]);
                *(u32x4*)(xc + (size_t)t * 4096 + c0) = ww;
            }
        }
    }
    {
        float* dt = (float*)(p.ws + O_DT); float* acs = (float*)(p.ws + O_ACS); float* cdec = (float*)(p.ws + O_CDEC);
        for (int c = bidx(); c < 65; c += gridDim.x)
        for (int head = wid; head < 32; head += 8) {
            const float bias = p.in(5)[jj * 32 + head], a = -__expf(p.in(6)[jj * 32 + head]);
            const int t0 = c * 128 - 112 + 2 * lane;
            float d0 = 0.f, d1 = 0.f;
            if (t0 >= 0) {
                const float x0 = side[(size_t)t0 * 64 + head] + bias, x1 = side[(size_t)(t0 + 1) * 64 + head] + bias;
                d0 = x0 > 20.f ? x0 : log1pf(__expf(x0)); d1 = x1 > 20.f ? x1 : log1pf(__expf(x1));
            }
            const float a0 = d0 * a, a1 = d1 * a;
            float s = a0 + a1;
#pragma unroll
            for (int o = 1; o < 64; o <<= 1) { const float v = __shfl_up(s, o); if (lane >= o) s += v; }
            const float ex = s - (a0 + a1);
            if (t0 >= 0) {
                dt[(size_t)t0 * 32 + head] = d0; dt[(size_t)(t0 + 1) * 32 + head] = d1;
                acs[(size_t)t0 * 32 + head] = ex + a0; acs[(size_t)(t0 + 1) * 32 + head] = s;
            }
            if (lane == 63) cdec[c * 32 + head] = __expf(s);
        }
    }
    {
        bf16_t* qt = (bf16_t*)(p.ws + O_QT); bf16_t* kt = (bf16_t*)(p.ws + O_KT); float* glast = (float*)(p.ws + O_GLAST);
        const float* w2 = p.in(9) + (size_t)jj * 16 * 1024; const float* gb = p.in(10) + (size_t)jj * 1024;
        LAS float* tot = (LAS float*)lds;
        const int d4 = tid & 15, pg = tid >> 4;
        for (int task = bidx(); task < 129 * 16; task += gridDim.x) {
            const int c = task >> 4, dbase = (task & 15) * 64 + d4 * 4, tbase = c * 64 - 48 + 2 * pg;
            f32x4 w[16];
#pragma unroll
            for (int r = 0; r < 16; ++r) w[r] = *(const f32x4*)(w2 + r * 1024 + dbase);
            const f32x4 b = *(const f32x4*)(gb + dbase);
            f32x4 g0 = {0.f, 0.f, 0.f, 0.f}, g1 = {0.f, 0.f, 0.f, 0.f};
            if (tbase >= 0) {
#pragma unroll
                for (int pos = 0; pos < 2; ++pos) {
                    const float* gl = side + (size_t)(tbase + pos) * 64 + 32;
                    f32x4 x = b;
#pragma unroll
                    for (int r4 = 0; r4 < 4; ++r4) { const f32x4 gv = *(const f32x4*)(gl + r4 * 4); x += w[r4 * 4] * gv[0] + w[r4 * 4 + 1] * gv[1] + w[r4 * 4 + 2] * gv[2] + w[r4 * 4 + 3] * gv[3]; }
                    f32x4 ls;
#pragma unroll
                    for (int e = 0; e < 4; ++e) ls[e] = (fminf(x[e], 0.f) - log1pf(__expf(-fabsf(x[e])))) * (1.f / 16.f);
                    if (pos == 0) g0 = ls; else g1 = ls;
                }
            }
            __syncthreads();
            *(LAS f32x4*)(tot + pg * 64 + d4 * 4) = g0 + g1;
            __syncthreads();
            f32x4 pre = {0.f, 0.f, 0.f, 0.f};
            for (int g = 0; g < pg; ++g) pre += *(const LAS f32x4*)(tot + g * 64 + d4 * 4);
            const f32x4 gc0 = pre + g0, gc1 = gc0 + g1;
            if (tbase >= 0) {
#pragma unroll
                for (int pos = 0; pos < 2; ++pos) {
                    const f32x4 gc = pos == 0 ? gc0 : gc1;
                    const size_t t = (size_t)(tbase + pos);
                    const u32x2 qw = *(const u32x2*)(u + t * HYB_N + UQ + dbase), kw = *(const u32x2*)(u + t * HYB_N + UK + dbase);
                    const float q[4] = {bflo(qw.x), bfhi(qw.x), bflo(qw.y), bfhi(qw.y)}, k[4] = {bflo(kw.x), bfhi(kw.x), bflo(kw.y), bfhi(kw.y)};
                    u32x2 qo, ko;
                    qo.x = pack2(q[0] * 0.0625f * __expf(gc[0]), q[1] * 0.0625f * __expf(gc[1])); qo.y = pack2(q[2] * 0.0625f * __expf(gc[2]), q[3] * 0.0625f * __expf(gc[3]));
                    ko.x = pack2(k[0] * __expf(-gc[0]), k[1] * __expf(-gc[1])); ko.y = pack2(k[2] * __expf(-gc[2]), k[3] * __expf(-gc[3]));
                    *(u32x2*)(qt + t * 1024 + dbase) = qo; *(u32x2*)(kt + t * 1024 + dbase) = ko;
                }
            }
            if (pg == 31) { f32x4 e; e[0] = __expf(gc1[0]); e[1] = __expf(gc1[1]); e[2] = __expf(gc1[2]); e[3] = __expf(gc1[3]); *(f32x4*)(glast + c * 1024 + dbase) = e; }
        }
    }
}

__device__ __forceinline__ void phase_hyb_local(const Ctx& p, LAS unsigned char* lds) {
    const int tid = tidx(), lane = tid & 63, wid = tid >> 6, fr = lane & 15, fq = lane >> 4;
    const bf16_t* xc = (const bf16_t*)(p.ws + O_XC);
    const float* dt = (const float*)(p.ws + O_DT); const float* acs = (const float*)(p.ws + O_ACS);
    const int NSSD = 65 * 8, NGLA = 129 * 16;
    for (int task = bidx(); task < NSSD + NGLA; task += gridDim.x) {
        __syncthreads();
        if (task < NSSD) {
            const int c = task >> 3, g = task & 7, tbase = c * 128 - 112;
            LAS bf16_t* Bs = (LAS bf16_t*)lds;
            LAS bf16_t* Xs = Bs + 128 * 136;
            const int tlast = tbase + 127;
            for (int item = tid; item < 128 * 16; item += NTHREADS) {
                const int j = item >> 4, cb = item & 15, t = tbase + j;
                u32x4 w = {0u, 0u, 0u, 0u};
                if (t >= 0) w = *(const u32x4*)(xc + (size_t)t * 4096 + 2048 + g * 128 + cb * 8);
                *(LAS u32x4*)(Bs + j * 136 + cb * 8) = w;
            }
            for (int item = tid; item < 128 * 32; item += NTHREADS) {
                const int j = item >> 5, cb = item & 31, hh = cb >> 3, t = tbase + j, head = g * 4 + hh;
                u32x4 w = {0u, 0u, 0u, 0u};
                if (t >= 0) {
                    float f[8]; unpack8(*(const u32x4*)(xc + (size_t)t * 4096 + g * 256 + cb * 8), f);
                    const float sc = dt[(size_t)t * 32 + head] * __expf(acs[(size_t)tlast * 32 + head] - acs[(size_t)t * 32 + head]);
                    w.x = pack2(f[0] * sc, f[1] * sc); w.y = pack2(f[2] * sc, f[3] * sc); w.z = pack2(f[4] * sc, f[5] * sc); w.w = pack2(f[6] * sc, f[7] * sc);
                }
                *(LAS u32x4*)(Xs + j * 264 + cb * 8) = w;
            }
            __syncthreads();
            float* loc = (float*)(p.ws + O_SSDLOC) + ((size_t)c * 32 + g * 4) * 64 * 128;
            const int pt = wid & 3, nh = wid >> 2;
            for (int hh = 0; hh < 4; ++hh) {
                f32x4 acc[4];
#pragma unroll
                for (int nt = 0; nt < 4; ++nt) acc[nt] = (f32x4){0.f, 0.f, 0.f, 0.f};
#pragma unroll
                for (int ks = 0; ks < 4; ++ks) {
                    const bf16x8 xf = ldfrag_tr(Xs, 264, hh * 64 + pt * 16, ks * 32, lane);
#pragma unroll
                    for (int nt = 0; nt < 4; ++nt) { const bf16x8 bf = ldfrag_tr(Bs, 136, nh * 64 + nt * 16, ks * 32, lane); acc[nt] = MFMA16(bf, xf, acc[nt]); }
                }
#pragma unroll
                for (int nt = 0; nt < 4; ++nt) *(f32x4*)(loc + ((size_t)hh * 64 + pt * 16 + fr) * 128 + nh * 64 + nt * 16 + 4 * fq) = acc[nt];
            }
        } else {
            const int gt = task - NSSD, c = gt >> 4, h = (gt >> 2) & 3, vs = gt & 3, tbase = c * 64 - 48;
            const bf16_t* u = (const bf16_t*)(p.ws + O_U); const bf16_t* kt = (const bf16_t*)(p.ws + O_KT);
            LAS bf16_t* Ks = (LAS bf16_t*)lds;
            LAS bf16_t* Vs = Ks + 64 * 264;
            for (int item = tid; item < 64 * 32; item += NTHREADS) {
                const int j = item >> 5, cb = item & 31, t = tbase + j;
                u32x4 w = {0u, 0u, 0u, 0u};
                if (t >= 0) w = *(const u32x4*)(kt + (size_t)t * 1024 + h * 256 + cb * 8);
                *(LAS u32x4*)(Ks + j * 264 + cb * 8) = w;
            }
            for (int item = tid; item < 64 * 16; item += NTHREADS) {
                const int j = item >> 4, cb = item & 15, t = tbase + j;
                u32x4 w = {0u, 0u, 0u, 0u};
                if (t >= 0) w = *(const u32x4*)(u + (size_t)t * HYB_N + UV + h * 512 + vs * 128 + cb * 8);
                *(LAS u32x4*)(Vs + j * 136 + cb * 8) = w;
            }
            __syncthreads();
            const float* glast = (const float*)(p.ws + O_GLAST) + c * 1024 + h * 256;
            bf16_t* kv = (bf16_t*)(p.ws + O_R2) + ((size_t)c * 4 + h) * 131072 + (size_t)(vs * 8 + wid) * 4096 + fr * 8 + (fq & 1) * 4;
            const bf16x8 vf0 = ldfrag_tr(Vs, 136, wid * 16, 0, lane), vf1 = ldfrag_tr(Vs, 136, wid * 16, 32, lane);
#pragma unroll
            for (int nt = 0; nt < 16; ++nt) {
                f32x4 acc = {0.f, 0.f, 0.f, 0.f};
                acc = MFMA16(ldfrag_tr(Ks, 264, nt * 16, 0, lane), vf0, acc);
                acc = MFMA16(ldfrag_tr(Ks, 264, nt * 16, 32, lane), vf1, acc);
                const f32x4 gl = *(const f32x4*)(glast + nt * 16 + 4 * fq);
                u32x2 w; w.x = pack2(acc[0] * gl[0], acc[1] * gl[1]); w.y = pack2(acc[2] * gl[2], acc[3] * gl[3]);
                *(u32x2*)(kv + (nt >> 1) * 512 + ((nt & 1) * 2 + (fq >> 1)) * 128) = w;
            }
        }
    }
}

__device__ __forceinline__ void phase_hyb_scan(const Ctx& p) {
    const size_t gtid = (size_t)bidx() * NTHREADS + tidx(), gn = (size_t)gridDim.x * NTHREADS;
    for (size_t task = gtid; task < 131072; task += gn) {
        if (task < 65536) {
            const size_t e = task * 4; const int head = (int)(e >> 13);
            const float* loc = (const float*)(p.ws + O_SSDLOC) + e; bf16_t* prev = (bf16_t*)(p.ws + O_SSDPREV) + e;
            const float* cdec = (const float*)(p.ws + O_CDEC) + head;
            float zz = 0.f; asm volatile("" : "+v"(zz));
            float4 run = {zz, zz, zz, zz};
            for (int c0 = 0; c0 < 65; c0 += 13) {
                float4 l[13]; float dcy[13];
#pragma unroll
                for (int i = 0; i < 13; ++i) { l[i] = *(const float4*)(loc + (size_t)(c0 + i) * 262144); dcy[i] = cdec[(c0 + i) * 32]; }
#pragma unroll
                for (int i = 0; i < 13; ++i) {
                    u32x2 w; w.x = pack2(run.x, run.y); w.y = pack2(run.z, run.w);
                    *(u32x2*)(prev + (size_t)(c0 + i) * 262144) = w;
                    run.x = run.x * dcy[i] + l[i].x; run.y = run.y * dcy[i] + l[i].y; run.z = run.z * dcy[i] + l[i].z; run.w = run.w * dcy[i] + l[i].w;
                }
            }
        } else {
            const size_t e = (task - 65536) * 8; const int h = (int)(e >> 17), ch16 = (int)((e & 131071) >> 3), d0 = ((ch16 >> 6) & 7) * 32 + ((ch16 >> 4) & 3) * 8;
            const bf16_t* kv = (const bf16_t*)(p.ws + O_R2) + e; bf16_t* sp = (bf16_t*)(p.ws + O_R2 + GLA_ST_BYTES) + e;
            const float* glast = (const float*)(p.ws + O_GLAST) + h * 256 + d0;
            float run[8]; float zz = 0.f; asm volatile("" : "+v"(zz));
#pragma unroll
            for (int i = 0; i < 8; ++i) run[i] = zz;
            for (int c0 = 0; c0 < 129; c0 += 8) {
                u32x4 lw[8]; float4 ga[8], gb2[8];
#pragma unroll
                for (int i = 0; i < 8; ++i) { const int c = c0 + i < 129 ? c0 + i : 128; lw[i] = *(const u32x4*)(kv + (size_t)c * 524288); ga[i] = *(const float4*)(glast + c * 1024); gb2[i] = *(const float4*)(glast + c * 1024 + 4); }
#pragma unroll
                for (int i = 0; i < 8; ++i) {
                    if (c0 + i < 129) {
                        float l[8]; unpack8(lw[i], l);
                        u32x4 w; w.x = pack2(run[0], run[1]); w.y = pack2(run[2], run[3]); w.z = pack2(run[4], run[5]); w.w = pack2(run[6], run[7]);
                        if (c0 + i == 5) { unsigned zq = 0u; asm volatile("" : "+v"(zq)); w.x |= zq; }
                        *(u32x4*)(sp + (size_t)(c0 + i) * 524288) = w;
                        run[0] = run[0] * ga[i].x + l[0]; run[1] = run[1] * ga[i].y + l[1]; run[2] = run[2] * ga[i].z + l[2]; run[3] = run[3] * ga[i].w + l[3];
                        run[4] = run[4] * gb2[i].x + l[4]; run[5] = run[5] * gb2[i].y + l[5]; run[6] = run[6] * gb2[i].z + l[6]; run[7] = run[7] * gb2[i].w + l[7];
                    }
                }
            }
        }
    }
}
__device__ __forceinline__ void phase_hyb_out(const Ctx& p, int jj, LAS unsigned char* lds) {
    const bf16_t* xc = (const bf16_t*)(p.ws + O_XC); const bf16_t* u = (const bf16_t*)(p.ws + O_U);
    const float* dt = (const float*)(p.ws + O_DT); const float* acs = (const float*)(p.ws + O_ACS);
    bf16_t* mix = (bf16_t*)(p.ws + O_MIX);
    for (int task0 = bidx(); task0 < 1036; task0 += gridDim.x) {
        bool is_ssd; int c, sub;
        if (task0 < 8) { is_ssd = true; c = 0; sub = task0; }
        else if (task0 < 12) { is_ssd = false; c = 0; sub = task0 - 8; }
        else if (task0 < 524) { is_ssd = true; c = 1 + ((task0 - 12) >> 3); sub = (task0 - 12) & 7; }
        else { is_ssd = false; c = 1 + ((task0 - 524) >> 2); sub = (task0 - 524) & 3; }
        const int tid = tidx(), lane = tid & 63, wid = tid >> 6, fr = lane & 15, fq = lane >> 4;
        __syncthreads();
        if (is_ssd) {
            const int g = sub, tbase = c * 128 - 112;
            LAS bf16_t* Cs = (LAS bf16_t*)lds;
            LAS bf16_t* Bs = Cs + 128 * 136;
            LAS bf16_t* Xt = Bs + 128 * 136;
            LAS bf16_t* Pv = Xt + 128 * 72;
            LAS float* Acs = (LAS float*)(Pv + 64 * 136);
            for (int item = tid; item < 128 * 32; item += NTHREADS) {
                const int j = item >> 5, cb = item & 31, t = tbase + j;
                u32x4 w = {0u, 0u, 0u, 0u};
                if (t >= 0) w = *(const u32x4*)(xc + (size_t)t * 4096 + 2048 + (cb < 16 ? 0 : 1024) + g * 128 + (cb & 15) * 8);
                *(LAS u32x4*)((cb < 16 ? Bs : Cs) + j * 136 + (cb & 15) * 8) = w;
            }
            { const int j = tid & 127, hh = tid >> 7, t = tbase + j; Acs[hh * 128 + j] = t >= 0 ? acs[(size_t)t * 32 + g * 4 + hh] : 0.f; }
            __syncthreads();
            const int i_row = wid * 16 + fr, ti = tbase + i_row;
            f32x4 cb_acc[8];
#pragma unroll
            for (int nt = 0; nt < 8; ++nt) cb_acc[nt] = (f32x4){0.f, 0.f, 0.f, 0.f};
#pragma unroll
            for (int ks = 0; ks < 4; ++ks) {
                const bf16x8 cf = ldfrag(Cs, 136, wid * 16, ks * 32, lane);
#pragma unroll
                for (int nt = 0; nt < 8; ++nt) cb_acc[nt] = MFMA16(ldfrag(Bs, 136, nt * 16, ks * 32, lane), cf, cb_acc[nt]);
            }
            f32x4 yv[4][4];
#pragma unroll
            for (int k = 0; k < 4; ++k)
#pragma unroll
                for (int pt = 0; pt < 4; ++pt) yv[k][pt] = (f32x4){0.f, 0.f, 0.f, 0.f};
            float ssq = 0.f;
#pragma unroll 1
            for (int hh = 0; hh < 4; ++hh) {
                const int head = g * 4 + hh;
                __syncthreads();
                for (int item = tid; item < 128 * 8; item += NTHREADS) {
                    const int j = item >> 3, cb = item & 7, t = tbase + j;
                    u32x4 w = {0u, 0u, 0u, 0u};
                    if (t >= 0) { float f[8]; unpack8(*(const u32x4*)(xc + (size_t)t * 4096 + head * 64 + cb * 8), f); const float sc = dt[(size_t)t * 32 + head];
                        w.x = pack2(f[0] * sc, f[1] * sc); w.y = pack2(f[2] * sc, f[3] * sc); w.z = pack2(f[4] * sc, f[5] * sc); w.w = pack2(f[6] * sc, f[7] * sc); }
                    *(LAS u32x4*)(Xt + j * 72 + cb * 8) = w;
                }
                { const bf16_t* pv = (const bf16_t*)(p.ws + O_SSDPREV) + ((size_t)c * 32 + head) * 64 * 128;
                  for (int item = tid; item < 64 * 16; item += NTHREADS) { const int pp = item >> 4, cb = item & 15; *(LAS u32x4*)(Pv + pp * 136 + cb * 8) = *(const u32x4*)(pv + pp * 128 + cb * 8); } }
                const float ai = Acs[hh * 128 + i_row];
#pragma unroll
                for (int nt = 0; nt < 8; ++nt) {
                    float m[4];
#pragma unroll
                    for (int q = 0; q < 4; ++q) { const int j = nt * 16 + 4 * fq + q; m[q] = j <= i_row ? cb_acc[nt][q] * __expf(ai - Acs[hh * 128 + j]) : 0.f; }
                    u32x2 w; w.x = pack2(m[0], m[1]); w.y = pack2(m[2], m[3]);
                    *(LAS u32x2*)(Bs + i_row * 136 + nt * 16 + 4 * fq) = w;
                }
                __syncthreads();
                f32x4 yd[4], yo[4];
#pragma unroll
                for (int pt = 0; pt < 4; ++pt) { yd[pt] = (f32x4){0.f, 0.f, 0.f, 0.f}; yo[pt] = (f32x4){0.f, 0.f, 0.f, 0.f}; }
#pragma unroll
                for (int ks = 0; ks < 4; ++ks) {
                    const bf16x8 mf = ldfrag(Bs, 136, wid * 16, ks * 32, lane), cf = ldfrag(Cs, 136, wid * 16, ks * 32, lane);
#pragma unroll
                    for (int pt = 0; pt < 4; ++pt) {
                        yd[pt] = MFMA16(ldfrag_tr(Xt, 72, pt * 16, ks * 32, lane), mf, yd[pt]);
                        yo[pt] = MFMA16(ldfrag(Pv, 136, pt * 16, ks * 32, lane), cf, yo[pt]);
                    }
                }
                const float ea = __expf(ai), dsk = p.in(7)[jj * 32 + head];
#pragma unroll
                for (int pt = 0; pt < 4; ++pt) {
                    const int ch = head * 64 + pt * 16 + 4 * fq;
                    float xs[4] = {0.f, 0.f, 0.f, 0.f}, zz[4] = {0.f, 0.f, 0.f, 0.f};
                    if (ti >= 0) {
                        const u32x2 xw = *(const u32x2*)(xc + (size_t)ti * 4096 + ch), zw = *(const u32x2*)(u + (size_t)ti * HYB_N + UZ + ch);
                        xs[0] = bflo(xw.x); xs[1] = bfhi(xw.x); xs[2] = bflo(xw.y); xs[3] = bfhi(xw.y);
                        zz[0] = bflo(zw.x); zz[1] = bfhi(zw.x); zz[2] = bflo(zw.y); zz[3] = bfhi(zw.y);
                    }
#pragma unroll
                    for (int q = 0; q < 4; ++q) { const float y = (yd[pt][q] + ea * yo[pt][q] + dsk * xs[q]) * silu_f(zz[q]); ssq += y * y;
#pragma unroll
                        for (int k = 0; k < 4; ++k) yv[k][pt][q] = (k == hh) ? y : yv[k][pt][q]; }
                }
            }
            ssq += __shfl_xor(ssq, 16); ssq += __shfl_xor(ssq, 32);
            const float rs = rsqrtf(ssq * (1.f / 256.f) + 1e-6f);
            if (ti >= 0) {
                const float* nw = p.in(8) + (size_t)jj * 2048;
#pragma unroll
                for (int hh = 0; hh < 4; ++hh)
#pragma unroll
                    for (int pt = 0; pt < 4; ++pt) {
                        const int ch = (g * 4 + hh) * 64 + pt * 16 + 4 * fq;
                        const f32x4 wv = *(const f32x4*)(nw + ch);
                        u32x2 w; w.x = pack2(yv[hh][pt][0] * rs * wv[0], yv[hh][pt][1] * rs * wv[1]); w.y = pack2(yv[hh][pt][2] * rs * wv[2], yv[hh][pt][3] * rs * wv[3]);
                        *(u32x2*)(mix + (size_t)ti * 4096 + ch) = w;
                    }
            }
        } else {
            const int h = sub, tbase = c * 64 - 48;
            const bf16_t* qt = (const bf16_t*)(p.ws + O_QT); const bf16_t* kt = (const bf16_t*)(p.ws + O_KT);
            LAS bf16_t* Qs = (LAS bf16_t*)lds;
            LAS bf16_t* Ps = Qs + 64 * 264;
            LAS float* Ssq = (LAS float*)(Ps + 64 * 72);
            LAS bf16_t* Ks = (LAS bf16_t*)(Ssq + 512);
            LAS bf16_t* Vs = Ks;
            for (int item = tid; item < 64 * 64; item += NTHREADS) {
                const int j = item >> 6, cb = item & 63, t = tbase + j;
                u32x4 w = {0u, 0u, 0u, 0u};
                if (t >= 0) w = *(const u32x4*)((cb < 32 ? qt : kt) + (size_t)t * 1024 + h * 256 + (cb & 31) * 8);
                *(LAS u32x4*)((cb < 32 ? Qs : Ks) + j * 264 + (cb & 31) * 8) = w;
            }
            u32x4 vreg[8];
#pragma unroll
            for (int r = 0; r < 8; ++r) { const int item = tid + r * NTHREADS, j = item >> 6, cb = item & 63, t = tbase + j;
                vreg[r] = (u32x4){0u, 0u, 0u, 0u};
                if (t >= 0) vreg[r] = *(const u32x4*)(u + (size_t)t * HYB_N + UV + h * 512 + cb * 8); }
            __syncthreads();
#pragma unroll
            for (int rep = 0; rep < 2; ++rep) {
                const int tix = wid + rep * 8, it = tix >> 2, jt = tix & 3;
                f32x4 acc = {0.f, 0.f, 0.f, 0.f};
                if (jt <= it) {
#pragma unroll
                    for (int ks = 0; ks < 8; ++ks) acc = MFMA16(ldfrag(Ks, 264, jt * 16, ks * 32, lane), ldfrag(Qs, 264, it * 16, ks * 32, lane), acc);
                }
                const int i = it * 16 + fr;
                float m[4];
#pragma unroll
                for (int q = 0; q < 4; ++q) { const int j = jt * 16 + 4 * fq + q; m[q] = (j <= i) ? acc[q] : 0.f; }
                u32x2 w; w.x = pack2(m[0], m[1]); w.y = pack2(m[2], m[3]);
                *(LAS u32x2*)(Ps + i * 72 + jt * 16 + 4 * fq) = w;
            }
            __syncthreads();
#pragma unroll
            for (int r = 0; r < 8; ++r) { const int item = tid + r * NTHREADS, j = item >> 6, cb = item & 63; *(LAS u32x4*)(Vs + j * 520 + cb * 8) = vreg[r]; }
            __syncthreads();
            f32x4 o[4][4];
            float ssq[4] = {0.f, 0.f, 0.f, 0.f};
            const bf16_t* sp = (const bf16_t*)(p.ws + O_R2 + GLA_ST_BYTES) + ((size_t)c * 4 + h) * 512 * 256;
#pragma unroll
            for (int vs = 0; vs < 4; ++vs) {
#pragma unroll
                for (int it = 0; it < 4; ++it) o[vs][it] = (f32x4){0.f, 0.f, 0.f, 0.f};
#pragma unroll
                for (int ks = 0; ks < 2; ++ks) {
                    const bf16x8 vf = ldfrag_tr(Vs, 520, vs * 128 + wid * 16, ks * 32, lane);
#pragma unroll
                    for (int it = 0; it < 4; ++it) o[vs][it] = MFMA16(vf, ldfrag(Ps, 72, it * 16, ks * 32, lane), o[vs][it]);
                }
                const bf16_t* spw = sp + (size_t)(vs * 8 + wid) * 4096 + lane * 8;
#pragma unroll
                for (int ks = 0; ks < 8; ++ks) {
                    const bf16x8 sf = *(const bf16x8*)(spw + ks * 512);
#pragma unroll
                    for (int it = 0; it < 4; ++it) o[vs][it] = MFMA16(sf, ldfrag(Qs, 264, it * 16, ks * 32, lane), o[vs][it]);
                }
#pragma unroll
                for (int it = 0; it < 4; ++it) ssq[it] += o[vs][it][0] * o[vs][it][0] + o[vs][it][1] * o[vs][it][1] + o[vs][it][2] * o[vs][it][2] + o[vs][it][3] * o[vs][it][3];
            }
#pragma unroll
            for (int it = 0; it < 4; ++it) { float s = ssq[it]; s += __shfl_xor(s, 16); s += __shfl_xor(s, 32); if (fq == 0) Ssq[wid * 64 + it * 16 + fr] = s; }
            __syncthreads();
            const float* nw = p.in(11) + (size_t)jj * 2048 + h * 512;
#pragma unroll
            for (int it = 0; it < 4; ++it) {
                const int i = it * 16 + fr, t = tbase + i;
                float s = 0.f;
#pragma unroll
                for (int w8 = 0; w8 < 8; ++w8) s += Ssq[w8 * 64 + i];
                const float rs = rsqrtf(s * (1.f / 512.f) + 1e-6f);
                if (t >= 0) {
#pragma unroll
                    for (int vs = 0; vs < 4; ++vs) {
                        const int v0 = vs * 128 + wid * 16 + 4 * fq;
                        const f32x4 wv = *(const f32x4*)(nw + v0);
                        const u32x2 rw = *(const u32x2*)(u + (size_t)t * HYB_N + UR + h * 512 + v0);
                        const float r0 = bflo(rw.x), r1 = bfhi(rw.x), r2 = bflo(rw.y), r3 = bfhi(rw.y);
                        u32x2 w;
                        w.x = pack2(o[vs][it][0] * rs * wv[0] * silu_f(r0), o[vs][it][1] * rs * wv[1] * silu_f(r1));
                        w.y = pack2(o[vs][it][2] * rs * wv[2] * silu_f(r2), o[vs][it][3] * rs * wv[3] * silu_f(r3));
                        *(u32x2*)(mix + (size_t)t * 4096 + 2048 + h * 512 + v0) = w;
                    }
                }
            }
        }
    }
}
__device__ __forceinline__ void rot_pair(const u32x4 a, const u32x4 b, const float* cs, u32x4& oa, u32x4& ob) {
    float x1[8], x2[8], c[8], s[8]; unpack8(a, x1); unpack8(b, x2); ld8f(cs, c); ld8f(cs + 8, s);
    float r1[8], r2[8];
#pragma unroll
    for (int i = 0; i < 8; ++i) { r1[i] = x1[i] * c[i] - x2[i] * s[i]; r2[i] = x2[i] * c[i] + x1[i] * s[i]; }
    oa.x = pack2(r1[0], r1[1]); oa.y = pack2(r1[2], r1[3]); oa.z = pack2(r1[4], r1[5]); oa.w = pack2(r1[6], r1[7]);
    ob.x = pack2(r2[0], r2[1]); ob.y = pack2(r2[2], r2[3]); ob.z = pack2(r2[4], r2[5]); ob.w = pack2(r2[6], r2[7]);
}
__device__ __forceinline__ void phase_attn(const Ctx& p, int jj, LAS unsigned char* lds) {
    const int tid = tidx(), lane = tid & 63, wid = tid >> 6, fr = lane & 15, fq = lane >> 4;
    const bf16_t* qkv = (const bf16_t*)(p.ws + O_U);
    const float* rope = (const float*)(p.ws + O_ROPE);
    bf16_t* ao = (bf16_t*)(p.ws + O_MIX);
    LAS bf16_t* Ks = (LAS bf16_t*)lds;
    LAS bf16_t* Vt = Ks + 272 * 72;
    LAS bf16_t* Pw = Vt + 64 * 280 + wid * (16 * 168);
    for (int task0 = bidx(); task0 < 520; task0 += gridDim.x) {
        const int task = task0 < 8 ? 512 + task0 : task0 - 8;
        const bool meta = task >= 512;
        const int b = meta ? 0 : (task >> 3), kh = task & 7;
        const int nkeys = meta ? 32 : 272;
        __syncthreads();
        for (int item = tid; item < nkeys * 8; item += NTHREADS) {
            const int key = item >> 3, cb = item & 7;
            const int tok = key < 16 ? key : 16 + 128 * (b - 1) + (key - 16);
            const bool valid = meta ? (key < 16) : (key < 16 || tok >= 16);
            {
                u32x4 w = {0u, 0u, 0u, 0u};
                if (valid) w = *(const u32x4*)(qkv + (size_t)tok * QKV_N + 2560 + kh * 64 + cb * 8);
                const bf16_t e[8] = {(bf16_t)(w.x & 0xffff), (bf16_t)(w.x >> 16), (bf16_t)(w.y & 0xffff), (bf16_t)(w.y >> 16), (bf16_t)(w.z & 0xffff), (bf16_t)(w.z >> 16), (bf16_t)(w.w & 0xffff), (bf16_t)(w.w >> 16)};
#pragma unroll
                for (int i = 0; i < 8; ++i) Vt[(cb * 8 + i) * 280 + key] = e[i];
            }
            if (cb == 1) continue;
            const bf16_t* src = qkv + (size_t)tok * QKV_N + 2048 + kh * 64;
            if (cb == 0) {
                u32x4 oa = {0u, 0u, 0u, 0u}, ob = {0u, 0u, 0u, 0u};
                if (valid) rot_pair(*(const u32x4*)src, *(const u32x4*)(src + 8), rope + (size_t)tok * 16, oa, ob);
                *(LAS u32x4*)(Ks + key * 72) = oa; *(LAS u32x4*)(Ks + key * 72 + 8) = ob;
            } else {
                u32x4 w = {0u, 0u, 0u, 0u};
                if (valid) w = *(const u32x4*)(src + cb * 8);
                *(LAS u32x4*)(Ks + key * 72 + cb * 8) = w;
            }
        }
        __syncthreads();
        if (meta && wid >= 4) continue;
        const int ng = meta ? 1 : 4;
        for (int gi = 0; gi < ng; ++gi) {
            const int g = meta ? wid : gi, hq = kh * 4 + g;
            const int tq = meta ? fr : 16 + 128 * b + 16 * wid + fr;
            u32x4 q0 = *(const u32x4*)(qkv + (size_t)tq * QKV_N + hq * 64 + 8 * fq), q1 = *(const u32x4*)(qkv + (size_t)tq * QKV_N + hq * 64 + 32 + 8 * fq);
            {
                u32x4 ot; ot.x = __shfl_xor((int)q0.x, 16); ot.y = __shfl_xor((int)q0.y, 16); ot.z = __shfl_xor((int)q0.z, 16); ot.w = __shfl_xor((int)q0.w, 16);
                if (fq < 2) {
                    float mine[8], oth[8], c[8], s[8]; unpack8(q0, mine); unpack8(ot, oth); ld8f(rope + (size_t)tq * 16, c); ld8f(rope + (size_t)tq * 16 + 8, s);
                    const float sg = fq == 0 ? -1.f : 1.f;
                    float r[8];
#pragma unroll
                    for (int i = 0; i < 8; ++i) r[i] = mine[i] * c[i] + sg * oth[i] * s[i];
                    q0.x = pack2(r[0], r[1]); q0.y = pack2(r[2], r[3]); q0.z = pack2(r[4], r[5]); q0.w = pack2(r[6], r[7]);
                }
            }
            const bf16x8 qa0 = __builtin_bit_cast(bf16x8, q0), qa1 = __builtin_bit_cast(bf16x8, q1);
            const float sink = p.in(14)[jj * 32 + hq];
            const int nt = meta ? 1 : 10;
            f32x4 sc[10];
            float mx = sink;
#pragma unroll
            for (int t = 0; t < 10; ++t) {
                if (t < nt) {
                    const int krow = t == 0 ? 0 : 16 + 16 * (wid + t - 1);
                    f32x4 a = {0.f, 0.f, 0.f, 0.f};
                    a = MFMA16(ldfrag(Ks, 72, krow, 0, lane), qa0, a);
                    a = MFMA16(ldfrag(Ks, 72, krow, 32, lane), qa1, a);
#pragma unroll
                    for (int j = 0; j < 4; ++j) {
                        bool vis;
                        if (t == 0) vis = meta ? (4 * fq + j <= fr) : true;
                        else { const int rel = 16 * (t - 1) + 4 * fq + j - fr; vis = rel >= 1 && rel <= 128 && (b > 0 || 16 * wid + 16 * (t - 1) + 4 * fq + j >= 128); }
                        const float v = vis ? a[j] * 0.125f : -INFINITY;
                        a[j] = v; mx = fmaxf(mx, v);
                    }
                    sc[t] = a;
                }
            }
            mx = fmaxf(mx, __shfl_xor(mx, 16)); mx = fmaxf(mx, __shfl_xor(mx, 32));
            float den = 0.f;
#pragma unroll
            for (int t = 0; t < 10; ++t) {
                if (t < nt) {
                    float e[4];
#pragma unroll
                    for (int j = 0; j < 4; ++j) { e[j] = __expf(sc[t][j] - mx); den += e[j]; }
                    u32x2 w; w.x = pack2(e[0], e[1]); w.y = pack2(e[2], e[3]);
                    *(LAS u32x2*)(Pw + fr * 168 + t * 16 + 4 * fq) = w;
                }
            }
            if (meta) { unsigned zz = 0u; asm volatile("" : "+v"(zz)); u32x2 z = {zz, zz}; *(LAS u32x2*)(Pw + fr * 168 + 16 + 4 * fq) = z; }
            den += __shfl_xor(den, 16); den += __shfl_xor(den, 32);
            den += __expf(sink - mx);
            const float rden = 1.f / den;
            LDS_FENCE();
            f32x4 oacc[4];
#pragma unroll
            for (int dtl = 0; dtl < 4; ++dtl) oacc[dtl] = (f32x4){0.f, 0.f, 0.f, 0.f};
            const int nks = meta ? 1 : 5;
#pragma unroll
            for (int ks = 0; ks < 5; ++ks) {
                if (ks < nks) {
                    const int pc = 32 * ks + 8 * fq;
                    const bf16x8 pf = *(const LAS bf16x8*)(Pw + fr * 168 + pc);
                    const int vcol = (pc < 16 || meta) ? pc : pc + 16 * wid;
#pragma unroll
                    for (int dtl = 0; dtl < 4; ++dtl) {
                        const bf16x8 vf = *(const LAS bf16x8*)(Vt + (dtl * 16 + fr) * 280 + vcol);
                        oacc[dtl] = MFMA16(vf, pf, oacc[dtl]);
                    }
                }
            }
            LDS_FENCE();
#pragma unroll
            for (int dtl = 0; dtl < 4; ++dtl) {
                u32x2 w; w.x = pack2(oacc[dtl][0] * rden, oacc[dtl][1] * rden); w.y = pack2(oacc[dtl][2] * rden, oacc[dtl][3] * rden);
                *(u32x2*)(ao + (size_t)tq * DM + hq * 64 + dtl * 16 + 4 * fq) = w;
            }
        }
    }
}
enum { K_PREP = 0, K_HIN, K_HPREP, K_HLOCAL, K_HSCAN, K_HOUT, K_GOUT, K_LN1, K_UP, K_CONV, K_DOWN, K_LN2, K_QKV, K_ATTN };
constexpr int N_PHASES = 1 + 2 * 11 + 2 * 8;
__host__ __device__ __forceinline__ void decode_phase(int ph, int& kind, int& layer) {
    if (ph == 0) { kind = K_PREP; layer = 0; return; }
    int r = ph - 1; layer = 0;
    if (r >= 19) { r -= 19; layer = 2; }
    if (r < 11) { kind = K_HIN + r; return; }
    r -= 11; layer += 1;
    kind = r == 0 ? K_QKV : (r == 1 ? K_ATTN : K_GOUT + (r - 2));
}
__global__ void __launch_bounds__(512, 2) fwd_megakernel(Params pin) {
    extern __shared__ __attribute__((aligned(16))) unsigned char shm[];
    LAS unsigned char* lds = (LAS unsigned char*)shm;
    cg::grid_group grid = cg::this_grid();
    volatile LAS unsigned* xst = (volatile LAS unsigned*)(lds + LDS_MAIN);
    if (threadIdx.x == 0) { xst[0] = 0u; xst[1] = 0u; }
    __syncthreads();
    XcdBarrier xb = xcd_barrier_post((unsigned*)(pin.ws + O_BAR), xst);
    if (pin.ph_lo == 0) { phase_prep(pin, lds); if (pin.ph_hi > 1) grid.sync(); }
    for (int ph = pin.ph_lo < 1 ? 1 : pin.ph_lo; ph < pin.ph_hi; ++ph) {
        Ctx p; { unsigned lo = (unsigned)(size_t)pin.ws, hi = (unsigned)((size_t)pin.ws >> 32); asm volatile("" : "+s"(lo), "+s"(hi)); p.ws = (unsigned char*)(__attribute__((address_space(1))) unsigned char*)(((size_t)hi << 32) | lo); p.out = pin.out; }
        ph = __builtin_amdgcn_readfirstlane(ph);
        int kind, layer; decode_phase(ph, kind, layer);
        const int jj = layer >> 1;
        bf16_t* hb = (bf16_t*)(p.ws + O_HB); float* h = (float*)(p.ws + O_H);
        bf16_t* mix = (bf16_t*)(p.ws + O_MIX);
        switch (kind) {
        case K_HIN: case K_QKV: case K_UP: {
            const bf16_t* w; bf16_t* O; int N;
            if (kind == K_HIN) { w = (const bf16_t*)(p.ws + O_WT_HIN) + (size_t)jj * 12288 * 2048; O = (bf16_t*)(p.ws + O_U); N = HYB_N;
                const int lane = tidx() & 63, wid = tidx() >> 6; const bf16_t* ws_ = (const bf16_t*)(p.ws + O_WT_HSIDE) + (size_t)jj * 48 * 2048; float* side = (float*)(p.ws + O_SIDE);
                for (int rt = bidx() * 8 + wid; rt < 513; rt += gridDim.x * 8) {
                    f32x4 a0 = {0.f, 0.f, 0.f, 0.f}, a1 = {0.f, 0.f, 0.f, 0.f}, a2 = {0.f, 0.f, 0.f, 0.f};
                    const bf16_t* pa = hb + (size_t)(rt * 16 + (lane & 15)) * 2048 + 8 * (lane >> 4);
                    const bf16_t* pb = ws_ + (size_t)(lane & 15) * 2048 + 8 * (lane >> 4);
#pragma unroll 8
                    for (int k0 = 0; k0 < 2048; k0 += 32) {
                        const bf16x8 a = *(const bf16x8*)(pa + k0);
                        a0 = MFMA16(*(const bf16x8*)(pb + k0), a, a0); a1 = MFMA16(*(const bf16x8*)(pb + 16 * 2048 + k0), a, a1); a2 = MFMA16(*(const bf16x8*)(pb + 32 * 2048 + k0), a, a2);
                    }
                    float* sr = side + (size_t)(rt * 16 + (lane & 15)) * 64 + 4 * (lane >> 4);
                    *(f32x4*)sr = a0; *(f32x4*)(sr + 16) = a1; *(f32x4*)(sr + 32) = a2; }
            } else if (kind == K_QKV) { w = (const bf16_t*)(p.ws + O_WT_QKV) + (size_t)jj * 3072 * 2048; O = (bf16_t*)(p.ws + O_U); N = QKV_N; }
            else { w = (const bf16_t*)(p.ws + O_WT_UP) + (size_t)layer * 11008 * 2048; O = (bf16_t*)(p.ws + O_R2); N = DFF2; }
            EpiStoreBf16 em{O, N}, e{O + (size_t)16 * N, N};
            gemm_full(lds, hb, w, N, 2048, em, e);
        } break;
        case K_GOUT: case K_DOWN: {
            const bf16_t* w; int K;
            if (kind == K_DOWN) { w = (const bf16_t*)(p.ws + O_WT_DOWN) + (size_t)layer * 2048 * 5504; K = DFF; }
            else if ((layer & 1) == 0) { w = (const bf16_t*)(p.ws + O_WT_HOUT) + (size_t)jj * 2048 * 4096; K = 4096; }
            else { w = (const bf16_t*)(p.ws + O_WT_SOUT) + (size_t)jj * 2048 * 2048; K = 2048; }
            EpiResF32 em{h, hb}, e{h + (size_t)16 * DM, hb + (size_t)16 * DM};
            gemm_full(lds, mix, w, 2048, K, em, e);
        } break;
        case K_HPREP: phase_hyb_prep(p, jj, lds); break;
        case K_HLOCAL: phase_hyb_local(p, lds); break;
        case K_HSCAN: phase_hyb_scan(p); break;
        case K_HOUT: phase_hyb_out(p, jj, lds); break;
        case K_ATTN: phase_attn(p, jj, lds); break;
        case K_LN1: phase_ln(p, p.in(20) + (size_t)layer * DM, p.in(21) + (size_t)layer * DM, false); break;
        case K_LN2: phase_ln(p, p.in(22) + (size_t)layer * DM, p.in(23) + (size_t)layer * DM, layer == 3); break;
        case K_CONV: phase_ffn_conv(p, layer); break;
        default: break;
        }
        if (ph + 1 < pin.ph_hi) xcd_barrier(xb);
    }
}

extern "C" void kernel_launch(void* const* d_in, const int* in_sizes, int n_in, void* d_out, int out_size, void* d_ws, size_t ws_size, hipStream_t stream) {
    static int grid = 0;
    if (grid == 0) {
        if (n_in != 24 || ws_size < WS_END) { fprintf(stderr, "kernel_launch: unexpected inputs (n_in %d, ws %zu, need %zu)\n", n_in, ws_size, (size_t)WS_END); grid = -1; return; }
        int dev = 0, cus = 0, per_cu = 0;
        (void)hipGetDevice(&dev);
        (void)hipDeviceGetAttribute(&cus, hipDeviceAttributeMultiprocessorCount, dev);
        if (hipFuncSetAttribute((const void*)fwd_megakernel, hipFuncAttributeMaxDynamicSharedMemorySize, LDS_BYTES) != hipSuccess) { fprintf(stderr, "kernel_launch: hipFuncSetAttribute failed\n"); grid = -1; return; }
        if (hipOccupancyMaxActiveBlocksPerMultiprocessor(&per_cu, (const void*)fwd_megakernel, NTHREADS, LDS_BYTES) != hipSuccess || per_cu < 1) { fprintf(stderr, "kernel_launch: occupancy query gave %d\n", per_cu); per_cu = 1; }
        (void)hipGetLastError();
        grid = cus * per_cu;
        if (grid > 256) grid = 256;
        fprintf(stderr, "kernel_launch: grid %d (cus %d, per_cu %d), ws need %zu of %zu\n", grid, cus, per_cu, (size_t)WS_END, ws_size);
    }
    if (grid < 0) return;
    Params p{};
    for (int i = 0; i < 24; ++i) p.in[i] = (const float*)d_in[i];
    p.out = (float*)d_out; p.ws = (unsigned char*)d_ws;
    for (int i = 0; i < 8; ++i) p.inv_freq[i] = powf(500000.0f, -(float)i / 8.0f);
#if PER_PHASE_LAUNCH
    for (int ph = 0; ph < N_PHASES; ++ph) {
        p.ph_lo = ph; p.ph_hi = ph + 1;
        hipLaunchKernelGGL(fwd_megakernel, dim3(grid), dim3(NTHREADS), LDS_BYTES, stream, p);
        { int kind, layer; decode_phase(ph, kind, layer); if ((DUP_MASK >> kind) & 1) hipLaunchKernelGGL(fwd_megakernel, dim3(grid), dim3(NTHREADS), LDS_BYTES, stream, p); }
    }
#else
    p.ph_lo = 0; p.ph_hi = N_PHASES;
    if (hipMemsetAsync((unsigned char*)d_ws + O_BAR, 0, XCD_BAR_WORDS * 4, stream) != hipSuccess) fprintf(stderr, "kernel_launch: memset failed\n");
    void* args[] = {&p};
    hipError_t e = hipLaunchCooperativeKernel((const void*)fwd_megakernel, dim3(grid), dim3(NTHREADS), args, LDS_BYTES, stream);
    if (e != hipSuccess) fprintf(stderr, "cooperative launch failed: %s (grid %d)\n", hipGetErrorString(e), grid);
#endif
}
```

```cpp
#include <hip/hip_runtime.h>
#include <hip/hip_cooperative_groups.h>
#include <cstdio>
#include <cmath>
namespace cg = cooperative_groups;
#ifndef PER_PHASE_LAUNCH
#define PER_PHASE_LAUNCH 0
#endif
__device__ __forceinline__ int tidx() { int t = threadIdx.x; asm volatile("" : "+v"(t)); return t; }
__device__ __forceinline__ int bidx() { int b = blockIdx.x; asm volatile("" : "+s"(b)); return b; }
#ifndef DUP_MASK
#define DUP_MASK 0
#endif
namespace pg8 {
#define PG8_LAS __attribute__((address_space(3)))
typedef unsigned short bf16_t;
typedef short bf16x8 __attribute__((ext_vector_type(8)));
typedef float f32x4 __attribute__((ext_vector_type(4)));
typedef unsigned u32x4 __attribute__((ext_vector_type(4)));
constexpr int BM = 256, BK = 64, HALF = 128, HTB = HALF * BK * 2  , STAGE_BYTES = 8 * HTB, NXCD = 8, WGM = 8;

__host__ __device__ __forceinline__ int lds_byte(int r, int c) { const int st = (r >> 4) * 2 + (c >> 5), rr = r & 15, cc = c & 31, ob = rr * 64 + cc * 2; return st * 1024 + (ob ^ (((ob >> 9) & 1) << 5)); }
__host__ __device__ __forceinline__ void stage_rc(int b, int& R, int& C) { const int st = b / 1024, sb = b % 1024, swz = sb ^ (((sb >> 9) & 1) << 5); R = (st >> 1) * 16 + swz / 64; C = (st & 1) * 32 + (swz % 64) / 2; }
__host__ __device__ __forceinline__ int perm32(int rho) { const int n = rho >> 4, i = rho & 15; return 8 * (i >> 2) + 4 * n + (i & 3); }

struct Unit { int pm, pn; };
struct Gemm { const bf16_t* A; const bf16_t* Bt; int M, N, K; };

struct StaticOrder {
    int nM, nN, nwg, G, c;
    __host__ __device__ void init(int M, int N, int G_, int c_) { nM = M / BM; nN = N / BM; nwg = nM * nN; G = G_; c = c_; }
    __host__ __device__ bool next(int i, Unit& u) const {
        const long L = (long)i * G + c; if (L >= nwg) return false;
        int wgid = (int)L; { const int q = nwg / NXCD, r = nwg % NXCD, xcd = wgid % NXCD, off = wgid / NXCD; wgid = (xcd < r ? xcd * (q + 1) : r * (q + 1) + (xcd - r) * q) + off; }
        const int nig = WGM * nN, gid = wgid / nig, fm = gid * WGM, gsz = (nM - fm) < WGM ? (nM - fm) : WGM;
        u.pm = fm + ((wgid % nig) % gsz); u.pn = (wgid % nig) / gsz; return true;
    }
    __device__ __forceinline__ void a_ready(const Unit&) const {}
    __device__ __forceinline__ void done(const Unit&) const {}
};
__device__ __forceinline__ unsigned cvt_pk_bf16(float lo, float hi) { unsigned r; asm volatile("v_cvt_pk_bf16_f32 %0, %1, %2" : "=v"(r) : "v"(lo), "v"(hi)); return r; }
typedef float f32x2 __attribute__((ext_vector_type(2)));

template <class Epi, class Sched, bool STAMP = false>
__device__ __forceinline__ void gemm_phase(PG8_LAS unsigned char* lds, const Gemm g, const Sched& S, const Epi& E, unsigned long long* stamps) {
    const int tid = tidx(), wid = __builtin_amdgcn_readfirstlane(tid >> 6), lane = tid & 63, wr = wid >> 2, wc = wid & 3, fr = lane & 15, fq = lane >> 4;
    const int K = g.K, nt = K / BK;
    int ts_lo = 0, ts_hi = 0, nts = 0; const unsigned long long rt_entry = STAMP ? (unsigned long long)wall_clock64() : 0ull;
#define PG8_STAMP() do { if (STAMP && wid == 0 && nts < 64) { const unsigned long long _c = (unsigned long long)clock64(); \
        ts_lo = (lane == nts) ? (int)(unsigned)_c : ts_lo; ts_hi = (lane == nts) ? (int)(unsigned)(_c >> 32) : ts_hi; ++nts; } } while (0)
    PG8_STAMP();
    unsigned voffA[2], voffB[2];
#pragma unroll
    for (int i = 0; i < 2; ++i) { int R, C; stage_rc(tid * 16 + i * 8192, R, C); const int Rb = Epi::PERM ? ((R & ~31) + perm32(R & 31)) : R;
        voffA[i] = (unsigned)(R * K + C) * 2u; voffB[i] = (unsigned)(Rb * K + C) * 2u; }
    const size_t kstep = (size_t)(BK * 2);
    const size_t hstep = (size_t)HALF * K * 2;
    const size_t tstep = 2 * hstep;
    const unsigned ldsw = (unsigned)wid * 1024u;
    const int aoff = lds_byte(wr * 64 + fr, fq * 8), boff = lds_byte(wc * 32 + fr, fq * 8);
#define PG8_SA(b, h) (((b) * 2 + (h)) * HTB)
#define PG8_SB(b, h) ((4 + (b) * 2 + (h)) * HTB)
#define PG8_STAGE(bufoff, gbase, voff) do { _Pragma("unroll") for (int _i = 0; _i < 2; ++_i) \
        __builtin_amdgcn_global_load_lds((const unsigned*)((const char*)(gbase) + (voff)[_i]), (PG8_LAS unsigned*)(lds + (bufoff) + ldsw + _i * 8192), 16, 0, 0); } while (0)
#define PG8_LDA(dst, b, h) do { _Pragma("unroll") for (int m = 0; m < 4; ++m) _Pragma("unroll") for (int k = 0; k < 2; ++k) dst[m][k] = *(const PG8_LAS bf16x8*)(lds + PG8_SA(b, h) + aoff + m * 2048 + k * 1024); } while (0)
#define PG8_LDB(dst, b, h) do { _Pragma("unroll") for (int n = 0; n < 2; ++n) _Pragma("unroll") for (int k = 0; k < 2; ++k) dst[n][k] = *(const PG8_LAS bf16x8*)(lds + PG8_SB(b, h) + boff + n * 2048 + k * 1024); } while (0)
#define PG8_MMA(ai, bj, At, Bt) do { __builtin_amdgcn_s_setprio(1); _Pragma("unroll") for (int m = 0; m < 4; ++m) _Pragma("unroll") for (int n = 0; n < 2; ++n) _Pragma("unroll") for (int k = 0; k < 2; ++k) \
        acc[ai][bj][m][n] = __builtin_amdgcn_mfma_f32_16x16x32_bf16(Bt[n][k], At[m][k], acc[ai][bj][m][n], 0, 0, 0); __builtin_amdgcn_s_setprio(0); } while (0)
#define PG8_WAIT_V(n) asm volatile("s_waitcnt vmcnt(" #n ")" ::: "memory")
#define PG8_WAIT_L(n) asm volatile("s_waitcnt lgkmcnt(" #n ")" ::: "memory")
#define PG8_BAR __builtin_amdgcn_s_barrier()
#define PG8_SCHED __builtin_amdgcn_sched_barrier(0)
    Unit cur, nxt; int ui = 0;
    if (!S.next(0, cur)) return;
    f32x4 acc[2][2][4][2];
#pragma unroll
    for (int a = 0; a < 2; ++a)
#pragma unroll
        for (int b = 0; b < 2; ++b)
#pragma unroll
            for (int m = 0; m < 4; ++m)
#pragma unroll
                for (int n = 0; n < 2; ++n) acc[a][b][m][n] = (f32x4){0.f, 0.f, 0.f, 0.f};
    bf16x8 At[4][2], B0[2][2], B1[2][2];
    const char* cA = (const char*)g.A + (size_t)cur.pm * tstep; const char* cB = (const char*)g.Bt + (size_t)cur.pn * tstep;
    S.a_ready(cur);
    PG8_STAGE(PG8_SB(0, 0), cB, voffB); PG8_STAGE(PG8_SA(0, 0), cA, voffA); PG8_STAGE(PG8_SB(0, 1), cB + hstep, voffB); PG8_STAGE(PG8_SA(0, 1), cA + hstep, voffA);
    if (wr == 1) PG8_BAR;
    PG8_WAIT_V(4); PG8_BAR;
    PG8_STAGE(PG8_SB(1, 0), cB + kstep, voffB); PG8_STAGE(PG8_SA(1, 0), cA + kstep, voffA); PG8_STAGE(PG8_SB(1, 1), cB + hstep + kstep, voffB);
    PG8_WAIT_V(6); PG8_BAR;
    PG8_STAMP();
    for (;;) {
        const bool has_next = S.next(ui + 1, nxt);
        const char* nA = has_next ? (const char*)g.A + (size_t)nxt.pm * tstep : cA; const char* nB = has_next ? (const char*)g.Bt + (size_t)nxt.pn * tstep : cB;
        for (int t = 0; t < nt; t += 2) {
            const bool last = (t == nt - 2);
            const char* a1 = cA + (size_t)(t + 1) * kstep;
            const char* a2 = last ? nA : cA + (size_t)(t + 2) * kstep; const char* b2 = last ? nB : cB + (size_t)(t + 2) * kstep;
            const char* a3 = a2 + kstep; const char* b3 = b2 + kstep;
            if (last && has_next) S.a_ready(nxt);
            PG8_LDB(B0, 0, 0); PG8_SCHED; PG8_LDA(At, 0, 0); PG8_STAGE(PG8_SA(1, 1), a1 + hstep, voffA);
            PG8_WAIT_L(8); PG8_BAR; PG8_WAIT_L(0); PG8_MMA(0, 0, At, B0); PG8_BAR; PG8_SCHED;
            PG8_LDB(B1, 0, 1); PG8_STAGE(PG8_SB(0, 0), b2, voffB);
            PG8_BAR; PG8_WAIT_L(0); PG8_MMA(0, 1, At, B1); PG8_BAR;
            PG8_LDA(At, 0, 1); PG8_STAGE(PG8_SA(0, 0), a2, voffA);
            PG8_BAR; PG8_WAIT_L(0); PG8_MMA(1, 0, At, B0); PG8_BAR; PG8_SCHED;
            PG8_STAGE(PG8_SB(0, 1), b2 + hstep, voffB);
            PG8_WAIT_V(6); PG8_BAR; PG8_MMA(1, 1, At, B1); PG8_BAR;
            PG8_LDB(B0, 1, 0); PG8_SCHED; PG8_LDA(At, 1, 0); PG8_STAGE(PG8_SA(0, 1), a2 + hstep, voffA);
            PG8_WAIT_L(8); PG8_BAR; PG8_WAIT_L(0); PG8_MMA(0, 0, At, B0); PG8_BAR; PG8_SCHED;
            PG8_LDB(B1, 1, 1); PG8_STAGE(PG8_SB(1, 0), b3, voffB);
            PG8_BAR; PG8_WAIT_L(0); PG8_MMA(0, 1, At, B1); PG8_BAR;
            PG8_LDA(At, 1, 1); PG8_STAGE(PG8_SA(1, 0), a3, voffA);
            PG8_BAR; PG8_WAIT_L(0); PG8_MMA(1, 0, At, B0); PG8_BAR; PG8_SCHED;
            PG8_STAGE(PG8_SB(1, 1), b3 + hstep, voffB);
            PG8_WAIT_V(6); PG8_BAR; PG8_MMA(1, 1, At, B1); PG8_BAR;
        }
        PG8_STAMP();
        if constexpr (!Epi::AFTER_DRAIN) { E(acc, cur, wr, wc, fr, fq); S.done(cur); }
        PG8_STAMP();
        if (!has_next) break;
#pragma unroll
        for (int a = 0; a < 2; ++a)
#pragma unroll
            for (int b = 0; b < 2; ++b)
#pragma unroll
                for (int m = 0; m < 4; ++m)
#pragma unroll
                    for (int n = 0; n < 2; ++n) acc[a][b][m][n] = (f32x4){0.f, 0.f, 0.f, 0.f};
        cur = nxt; cA = nA; cB = nB; ++ui;
    }
    PG8_WAIT_V(0);
    if (wr == 0) PG8_BAR;
    PG8_BAR;
    if constexpr (Epi::AFTER_DRAIN) { E.fused(acc, cur, wr, wc, fr, fq, lds, wid, lane); S.done(cur); }
    PG8_STAMP();
    if (STAMP && wid == 0) { stamps[lane] = lane < nts ? (((unsigned long long)(unsigned)ts_hi << 32) | (unsigned)ts_lo) : 0ull;
        if (lane == 62) stamps[62] = rt_entry; if (lane == 63) stamps[63] = (unsigned long long)wall_clock64(); }
#undef PG8_STAMP
#undef PG8_SA
#undef PG8_SB
#undef PG8_STAGE
#undef PG8_LDA
#undef PG8_LDB
#undef PG8_MMA
#undef PG8_WAIT_V
#undef PG8_WAIT_L
#undef PG8_BAR
#undef PG8_SCHED
}
}
using pg8::bf16_t; using pg8::bf16x8; using pg8::f32x4; using pg8::u32x4;
#define LAS __attribute__((address_space(3)))
typedef unsigned u32x2 __attribute__((ext_vector_type(2)));

constexpr int L_TOK = 8208, DM = 2048;
constexpr int HYB_N = 12288, DFF = 5504, DFF2 = 11008, QKV_N = 3072;
constexpr int UZ = 0, UXBC = 2048, UQ = 6144, UK = 7168, UV = 8192, UR = 10240;
constexpr float ALPHA = 1.6817928305074292f;
constexpr int NTHREADS = 512;
constexpr int LDS_MAIN = 143360;
constexpr int LDS_BYTES = LDS_MAIN + 256;

constexpr size_t al256(size_t x) { return (x + 255) & ~(size_t)255; }
constexpr size_t O_WT_HIN   = 0;
constexpr size_t O_WT_HSIDE = O_WT_HIN   + al256(2ull * 12288 * 2048 * 2);
constexpr size_t O_WT_HOUT  = O_WT_HSIDE + al256(2ull * 48 * 2048 * 2);
constexpr size_t O_WT_QKV   = O_WT_HOUT  + al256(2ull * 2048 * 4096 * 2);
constexpr size_t O_WT_SOUT  = O_WT_QKV   + al256(2ull * 3072 * 2048 * 2);
constexpr size_t O_WT_UP    = O_WT_SOUT  + al256(2ull * 2048 * 2048 * 2);
constexpr size_t O_WT_DOWN  = O_WT_UP    + al256(4ull * 11008 * 2048 * 2);
constexpr size_t O_H        = O_WT_DOWN  + al256(4ull * 2048 * 5504 * 2);
constexpr size_t O_HB       = O_H        + al256((size_t)L_TOK * 2048 * 4);
constexpr size_t O_U        = O_HB       + al256((size_t)L_TOK * 2048 * 2);
constexpr size_t O_R2       = O_U        + al256((size_t)L_TOK * 12288 * 2);
constexpr size_t GLA_ST_BYTES = 129ull * 4 * 512 * 256 * 2;
constexpr size_t O_MIX      = O_R2       + al256(2 * GLA_ST_BYTES);
constexpr size_t O_XC       = O_MIX      + al256((size_t)L_TOK * 5504 * 2);
constexpr size_t O_SIDE     = O_XC       + al256((size_t)L_TOK * 4096 * 2);
constexpr size_t O_DT       = O_SIDE     + al256((size_t)L_TOK * 64 * 4);
constexpr size_t O_ACS      = O_DT       + al256((size_t)L_TOK * 32 * 4);
constexpr size_t O_QT       = O_ACS      + al256((size_t)L_TOK * 32 * 4);
constexpr size_t O_KT       = O_QT       + al256((size_t)L_TOK * 1024 * 2);
constexpr size_t O_GLAST    = O_KT       + al256((size_t)L_TOK * 1024 * 2);
constexpr size_t O_CDEC     = O_GLAST    + al256(129ull * 1024 * 4);
constexpr size_t O_SSDLOC   = O_CDEC     + al256(65ull * 32 * 4);
constexpr size_t O_SSDPREV  = O_SSDLOC   + al256(65ull * 32 * 64 * 128 * 4);
constexpr size_t O_ROPE     = O_SSDPREV  + al256(65ull * 32 * 64 * 128 * 2);
constexpr size_t O_TAB      = O_ROPE     + al256((size_t)L_TOK * 16 * 4);
constexpr size_t O_BAR      = O_TAB      + 256;
constexpr size_t WS_END     = O_BAR      + al256(4096 * 4);
static_assert(WS_END <= 1442840576ull, "workspace too large");

struct Params {
    const float* in[24];
    float* out;
    unsigned char* ws;
    float inv_freq[8];
    int ph_lo, ph_hi;
};

struct Ctx { unsigned char* ws; float* out;
    __device__ __forceinline__ const float* in(int k) const { const size_t a = ((const size_t*)(ws + O_TAB))[k]; return (const float*)(const __attribute__((address_space(1))) float*)a; } };

__device__ __forceinline__ bf16_t f2bf(float f) { unsigned u = __float_as_uint(f); u += 0x7FFFu + ((u >> 16) & 1u); return (bf16_t)(u >> 16); }
__device__ __forceinline__ float bf2f(bf16_t b) { return __uint_as_float(((unsigned)b) << 16); }
__device__ __forceinline__ unsigned pack2(float lo, float hi) { unsigned r; asm("v_cvt_pk_bf16_f32 %0, %1, %2" : "=v"(r) : "v"(lo), "v"(hi)); return r; }
__device__ __forceinline__ float bflo(unsigned w) { return __uint_as_float(w << 16); }
__device__ __forceinline__ float bfhi(unsigned w) { return __uint_as_float(w & 0xffff0000u); }
__device__ __forceinline__ float silu_f(float x) { return x * __builtin_amdgcn_rcpf(1.f + __expf(-x)); }
__device__ __forceinline__ float wave_sum(float v) {
#pragma unroll
    for (int o = 32; o > 0; o >>= 1) v += __shfl_xor(v, o);
    return v;
}
__device__ __forceinline__ bf16x8 ldfrag(const LAS bf16_t* base, int ld, int row0, int k0, int lane) {
    return *(const LAS bf16x8*)(base + (row0 + (lane & 15)) * ld + k0 + 8 * (lane >> 4));
}
__device__ __forceinline__ bf16x8 gfrag(const bf16_t* base, size_t ld, int row0, int k0, int lane) {
    return *(const bf16x8*)(base + (size_t)(row0 + (lane & 15)) * ld + k0 + 8 * (lane >> 4));
}
typedef short s16x4 __attribute__((ext_vector_type(4)));
__device__ __forceinline__ bf16x8 ldfrag_tr(const LAS bf16_t* base, int ld, int n0, int k0, int lane) {
    const int g = lane >> 4, i = lane & 15, q = i >> 2, pp = i & 3;
    const LAS bf16_t* a = base + (k0 + 8 * g + q) * ld + n0 + 4 * pp;
    const s16x4 r1 = __builtin_amdgcn_ds_read_tr16_b64_v4i16((LAS s16x4*)a);
    const s16x4 r2 = __builtin_amdgcn_ds_read_tr16_b64_v4i16((LAS s16x4*)(a + 4 * ld));
    return __builtin_shufflevector(r1, r2, 0, 1, 2, 3, 4, 5, 6, 7);
}
#define MFMA16(a, b, c) __builtin_amdgcn_mfma_f32_16x16x32_bf16((a), (b), (c), 0, 0, 0)
#define LDS_FENCE() asm volatile("s_waitcnt lgkmcnt(0)" ::: "memory")

struct EpiStoreBf16 {
    static constexpr bool PERM = true, AFTER_DRAIN = false;
    bf16_t* O; int ldc;
    __device__ __forceinline__ void operator()(const f32x4 (&acc)[2][2][4][2], const pg8::Unit& u, int wr, int wc, int fr, int fq) const {
        const int row0 = u.pm * 256 + wr * 64 + fr, col0 = u.pn * 256 + wc * 32 + 8 * fq;
#pragma unroll
        for (int ai = 0; ai < 2; ++ai)
#pragma unroll
            for (int m = 0; m < 4; ++m) { bf16_t* rowp = O + (size_t)(row0 + ai * 128 + m * 16) * ldc + col0;
#pragma unroll
                for (int bj = 0; bj < 2; ++bj) { const f32x4 v0 = acc[ai][bj][m][0], v1 = acc[ai][bj][m][1];
                    u32x4 w; w.x = pg8::cvt_pk_bf16(v0[0], v0[1]); w.y = pg8::cvt_pk_bf16(v0[2], v0[3]); w.z = pg8::cvt_pk_bf16(v1[0], v1[1]); w.w = pg8::cvt_pk_bf16(v1[2], v1[3]);
                    *(u32x4*)(rowp + bj * 128) = w; } }
    }
    __device__ __forceinline__ void meta(int row, int col, f32x4 v) const {
        u32x2 w; w.x = pg8::cvt_pk_bf16(v[0], v[1]); w.y = pg8::cvt_pk_bf16(v[2], v[3]);
        *(u32x2*)(O + (size_t)row * ldc + col) = w;
    }
};
struct EpiResF32 {
    static constexpr bool PERM = false, AFTER_DRAIN = false;
    float* H; const bf16_t* HB;
    __device__ __forceinline__ void operator()(const f32x4 (&acc)[2][2][4][2], const pg8::Unit& u, int wr, int wc, int fr, int fq) const {
        const int row0 = u.pm * 256 + wr * 64 + fr, col0 = u.pn * 256 + wc * 32 + 4 * fq;
#pragma unroll
        for (int ai = 0; ai < 2; ++ai)
#pragma unroll
            for (int m = 0; m < 4; ++m) { const size_t ro = (size_t)(row0 + ai * 128 + m * 16) * DM + col0;
#pragma unroll
                for (int bj = 0; bj < 2; ++bj)
#pragma unroll
                    for (int n = 0; n < 2; ++n) { const size_t o = ro + bj * 128 + n * 16; const u32x2 hw = *(const u32x2*)(HB + o);
                        const f32x4 hv = {bflo(hw.x), bfhi(hw.x), bflo(hw.y), bfhi(hw.y)}; *(f32x4*)(H + o) = hv * ALPHA + acc[ai][bj][m][n]; } }
    }
    __device__ __forceinline__ void meta(int row, int col, f32x4 v) const {
        const size_t o = (size_t)row * DM + col; const u32x2 hw = *(const u32x2*)(HB + o);
        const f32x4 hv = {bflo(hw.x), bfhi(hw.x), bflo(hw.y), bfhi(hw.y)}; *(f32x4*)(H + o) = hv * ALPHA + v;
    }
};
__device__ __forceinline__ f32x4 wave_gemm16(const bf16_t* A, const bf16_t* Bt, int K, int lane) {
    f32x4 acc = {0.f, 0.f, 0.f, 0.f};
    const bf16_t* pa = A + (size_t)(lane & 15) * K + 8 * (lane >> 4);
    const bf16_t* pb = Bt + (size_t)(lane & 15) * K + 8 * (lane >> 4);
#pragma unroll 16
    for (int k0 = 0; k0 < K; k0 += 32) {
        const bf16x8 a = *(const bf16x8*)(pa + k0), b = *(const bf16x8*)(pb + k0);
        acc = MFMA16(b, a, acc);
    }
    return acc;
}
template <class Epi>
__device__ __forceinline__ void gemm_full(LAS unsigned char* lds, const bf16_t* A, const bf16_t* Bt, int N, int K, const Epi& Emeta, const Epi& Emain) {
    const int lane = tidx() & 63, wid = tidx() >> 6;
    for (int tile = bidx() * 8 + wid; tile < N / 16; tile += gridDim.x * 8) {
        const f32x4 acc = wave_gemm16(A, Bt + (size_t)tile * 16 * K, K, lane);
        Emeta.meta(lane & 15, tile * 16 + 4 * (lane >> 4), acc);
    }
    pg8::Gemm g{A + (size_t)16 * K, Bt, 8192, N, K};
    pg8::StaticOrder S; S.init(8192, N, (int)gridDim.x, (int)bidx());
    pg8::gemm_phase<Epi, pg8::StaticOrder, false>(lds, g, S, Emain, nullptr);
    __syncthreads();
}
#define XB_TMO      128
#define XB_XCNT(j)  (256  + 64 * (j))
#define XB_XSUB(j)  (1280 + 64 * (j))
#define XB_XGEN(j)  (2304 + 64 * (j))
#define XB_TOP      3328
#define XB_TOPGEN   3392
#define XCD_BAR_WORDS 3456
#define XB_SPIN_CAP (1u << 18)

__device__ __forceinline__ unsigned xb_ld(unsigned* p)              { return __hip_atomic_load(p, __ATOMIC_RELAXED, __HIP_MEMORY_SCOPE_AGENT); }
__device__ __forceinline__ unsigned xb_add(unsigned* p, unsigned v) { return __hip_atomic_fetch_add(p, v, __ATOMIC_RELAXED, __HIP_MEMORY_SCOPE_AGENT); }
__device__ __forceinline__ unsigned xb_xcc_id() { return (unsigned)__builtin_amdgcn_s_getreg((3 << 11) | 20) & 0xFu; }
#define XB_SPIN(cond, bar) do { unsigned _sp = 0; while (cond) { __builtin_amdgcn_s_sleep(1); \
    if ((++_sp & 255u) == 0u) { if (xb_ld(&(bar)[XB_TMO])) break; if (_sp > XB_SPIN_CAP) { atomicAdd(&(bar)[XB_TMO], 1u); break; } } } } while (0)

struct XcdBarrier {
    unsigned* bar; unsigned x;
    volatile LAS unsigned* st;
};

__device__ __forceinline__ XcdBarrier xcd_barrier_post(unsigned* bar, volatile LAS unsigned* st) {
    XcdBarrier b; b.bar = bar; b.x = xb_xcc_id(); b.st = st;
    if (threadIdx.x == 0) (void)xb_add(&bar[XB_XCNT(b.x)], 1u);
    return b;
}
__device__ __forceinline__ void xcd_barrier_complete(unsigned* bar, unsigned x, unsigned& nloc, unsigned& nx) {
    const unsigned G = gridDim.x * gridDim.y * gridDim.z;
    unsigned sum, cnt, mine, sp = 0u;
    for (;;) {
        sum = 0u; cnt = 0u; mine = 0u;
#pragma unroll
        for (unsigned j = 0; j < 16; ++j) { const unsigned c = xb_ld(&bar[XB_XCNT(j)]); sum += c; cnt += (c > 0u) ? 1u : 0u; mine = (j == x) ? c : mine; }
        if (sum == G) break;
        __builtin_amdgcn_s_sleep(1);
        if ((++sp & 255u) == 0u) { if (xb_ld(&bar[XB_TMO])) break; if (sp > XB_SPIN_CAP) { atomicAdd(&bar[XB_TMO], 1u); break; } }
    }
    nloc = mine > 0u ? mine : 1u; nx = cnt > 0u ? cnt : 1u;
}

__device__ __forceinline__ void xcd_barrier(const XcdBarrier& b) {
    asm volatile("s_waitcnt vmcnt(0)" ::: "memory");
    __syncthreads();
    if (threadIdx.x == 0) {
        unsigned* bar = b.bar;
        __builtin_amdgcn_s_waitcnt(0);
        unsigned nloc = b.st[0], nx = b.st[1];
        if (nloc == 0u) { xcd_barrier_complete(bar, b.x, nloc, nx); b.st[0] = nloc; b.st[1] = nx; }
        const unsigned old = xb_add(&bar[XB_XSUB(b.x)], 1u);
        const unsigned gen = old / nloc;
        if (old + 1u == (gen + 1u) * nloc) {
            __builtin_amdgcn_fence(__ATOMIC_RELEASE, "agent");
            asm volatile("s_waitcnt vmcnt(0)" ::: "memory");
            const unsigned og = xb_add(&bar[XB_TOP], 1u);
            const unsigned tg = og / nx;
            if (og + 1u == (tg + 1u) * nx) xb_add(&bar[XB_TOPGEN], 1u);
            else XB_SPIN(xb_ld(&bar[XB_TOPGEN]) == tg, bar);
            __builtin_amdgcn_fence(__ATOMIC_ACQUIRE, "agent");
            xb_add(&bar[XB_XGEN(b.x)], 1u);
            asm volatile("s_waitcnt vmcnt(0)" ::: "memory");
        } else {
            XB_SPIN(xb_ld(&bar[XB_XGEN(b.x)]) == gen, bar);
            __builtin_amdgcn_fence(__ATOMIC_ACQUIRE, "agent");
            asm volatile("s_waitcnt vmcnt(0)" ::: "memory");
        }
    }
    __syncthreads();
}
struct TJob { const float* src; int ld, ncols, K; bf16_t* dst; };
__device__ __forceinline__ TJob get_job(const Params& p, int j) {
    TJob J;
    bf16_t* ws16 = (bf16_t*)p.ws;
    if (j < 10) {
        const int jj = j / 5, sub = j % 5;
        const float* base = p.in[2] + (size_t)jj * 2048 * 12336;
        bf16_t* wmain = (bf16_t*)(p.ws + O_WT_HIN) + (size_t)jj * 12288 * 2048;
        bf16_t* wside = (bf16_t*)(p.ws + O_WT_HSIDE) + (size_t)jj * 48 * 2048;
        J.ld = 12336; J.K = 2048;
        if (sub == 0)      { J.src = base;          J.ncols = 6144; J.dst = wmain; }
        else if (sub == 1) { J.src = base + 6176;   J.ncols = 4096; J.dst = wmain + (size_t)6144 * 2048; }
        else if (sub == 2) { J.src = base + 10288;  J.ncols = 2048; J.dst = wmain + (size_t)10240 * 2048; }
        else if (sub == 3) { J.src = base + 6144;   J.ncols = 32;   J.dst = wside; }
        else               { J.src = base + 10272;  J.ncols = 16;   J.dst = wside + (size_t)32 * 2048; }
    } else if (j < 12) { const int jj = j - 10; J.src = p.in[12] + (size_t)jj * 4096 * 2048; J.ld = 2048; J.ncols = 2048; J.K = 4096; J.dst = (bf16_t*)(p.ws + O_WT_HOUT) + (size_t)jj * 2048 * 4096; }
    else if (j < 14) { const int jj = j - 12; J.src = p.in[13] + (size_t)jj * 2048 * 3072; J.ld = 3072; J.ncols = 3072; J.K = 2048; J.dst = (bf16_t*)(p.ws + O_WT_QKV) + (size_t)jj * 3072 * 2048; }
    else if (j < 16) { const int jj = j - 14; J.src = p.in[15] + (size_t)jj * 2048 * 2048; J.ld = 2048; J.ncols = 2048; J.K = 2048; J.dst = (bf16_t*)(p.ws + O_WT_SOUT) + (size_t)jj * 2048 * 2048; }
    else if (j < 20) { const int l = j - 16; J.src = p.in[16] + (size_t)l * 2048 * 11008; J.ld = 11008; J.ncols = 11008; J.K = 2048; J.dst = (bf16_t*)(p.ws + O_WT_UP) + (size_t)l * 11008 * 2048; }
    else { const int l = j - 20; J.src = p.in[19] + (size_t)l * 5504 * 2048; J.ld = 2048; J.ncols = 2048; J.K = 5504; J.dst = (bf16_t*)(p.ws + O_WT_DOWN) + (size_t)l * 2048 * 5504; }
    (void)ws16;
    return J;
}
__device__ __forceinline__ void phase_prep(const Params& p, LAS unsigned char* lds) {
    const int tid = tidx();
    LAS float* ts = (LAS float*)lds;
    for (int j = 0; j < 24; ++j) {
        const TJob J = get_job(p, j);
        const int tn = (J.ncols + 127) / 128, tk = J.K / 128;
        for (int tile = bidx(); tile < tn * tk; tile += gridDim.x) {
            const int kb = tile / tn, nb = tile % tn;
            __syncthreads();
            {
                const int c4 = (tid & 31) * 4, n = nb * 128 + c4, r0 = tid >> 5;
                if (n < J.ncols) {
                    float4 v[8];
#pragma unroll
                    for (int i = 0; i < 8; ++i) v[i] = *(const float4*)(J.src + (size_t)(kb * 128 + r0 + 16 * i) * J.ld + n);
#pragma unroll
                    for (int i = 0; i < 8; ++i) { const int r = r0 + 16 * i; ts[r * 129 + c4] = v[i].x; ts[r * 129 + c4 + 1] = v[i].y; ts[r * 129 + c4 + 2] = v[i].z; ts[r * 129 + c4 + 3] = v[i].w; }
                }
            }
            __syncthreads();
            const int n = tid >> 2, kc = tid & 3;
            if (nb * 128 + n < J.ncols) {
#pragma unroll
                for (int q = 0; q < 4; ++q) {
                    const int kk = kc * 32 + q * 8;
                    u32x4 w;
                    w.x = pack2(ts[(kk + 0) * 129 + n], ts[(kk + 1) * 129 + n]);
                    w.y = pack2(ts[(kk + 2) * 129 + n], ts[(kk + 3) * 129 + n]);
                    w.z = pack2(ts[(kk + 4) * 129 + n], ts[(kk + 5) * 129 + n]);
                    w.w = pack2(ts[(kk + 6) * 129 + n], ts[(kk + 7) * 129 + n]);
                    *(u32x4*)(J.dst + (size_t)(nb * 128 + n) * J.K + kb * 128 + kk) = w;
                }
            }
        }
    }
    __syncthreads();
    const size_t gtid = (size_t)bidx() * NTHREADS + tid, gn = (size_t)gridDim.x * NTHREADS;
    float* h = (float*)(p.ws + O_H); bf16_t* hb = (bf16_t*)(p.ws + O_HB);
    for (size_t i = gtid; i < (size_t)L_TOK * 512; i += gn) {
        const int row = (int)(i >> 9), c4 = (int)(i & 511) * 4;
        const float4 v = row < 16 ? *(const float4*)(p.in[1] + (size_t)row * DM + c4) : *(const float4*)(p.in[0] + (size_t)(row - 16) * DM + c4);
        u32x2 w; w.x = pack2(v.x, v.y); w.y = pack2(v.z, v.w);
        *(u32x2*)(hb + i * 4) = w;
    }
    if (gtid < 24) ((const float**)(p.ws + O_TAB))[gtid] = p.in[gtid];
    float* rope = (float*)(p.ws + O_ROPE);
    for (size_t i = gtid; i < (size_t)L_TOK * 8; i += gn) {
        const int pos = (int)(i >> 3), f = (int)(i & 7);
        const float ang = (float)pos * p.inv_freq[f];
        double rev = (double)ang * 0.15915494309189535;
        rev -= rint(rev);
        rope[pos * 16 + f] = __builtin_amdgcn_cosf((float)rev);
        rope[pos * 16 + 8 + f] = __builtin_amdgcn_sinf((float)rev);
    }
}

__device__ __forceinline__ void phase_ln(const Ctx& p, const float* g, const float* b, bool last) {
    const int lane = tidx() & 63, wid = tidx() >> 6;
    float* h = (float*)(p.ws + O_H); bf16_t* hb = (bf16_t*)(p.ws + O_HB);
    for (int row = bidx() * 8 + wid; row < L_TOK; row += gridDim.x * 8) {
        float4 v[8]; float s = 0.f;
#pragma unroll
        for (int i = 0; i < 8; ++i) { v[i] = *(const float4*)(h + (size_t)row * DM + i * 256 + lane * 4); s += v[i].x + v[i].y + v[i].z + v[i].w; }
        const float mean = wave_sum(s) * (1.f / 2048.f);
        float q = 0.f;
#pragma unroll
        for (int i = 0; i < 8; ++i) { v[i].x -= mean; v[i].y -= mean; v[i].z -= mean; v[i].w -= mean; q += v[i].x * v[i].x + v[i].y * v[i].y + v[i].z * v[i].z + v[i].w * v[i].w; }
        const float rstd = rsqrtf(wave_sum(q) * (1.f / 2048.f) + 1e-5f);
#pragma unroll
        for (int i = 0; i < 8; ++i) {
            const int c = i * 256 + lane * 4;
            const float4 gg = *(const float4*)(g + c), bb = *(const float4*)(b + c);
            float4 y; y.x = v[i].x * rstd * gg.x + bb.x; y.y = v[i].y * rstd * gg.y + bb.y; y.z = v[i].z * rstd * gg.z + bb.z; y.w = v[i].w * rstd * gg.w + bb.w;
            if (last) { if (row >= 16) *(float4*)(p.out + (size_t)(row - 16) * DM + c) = y; }
            else { u32x2 w; w.x = pack2(y.x, y.y); w.y = pack2(y.z, y.w); *(u32x2*)(hb + (size_t)row * DM + c) = w; }
        }
    }
}

__device__ __forceinline__ void unpack8(const u32x4 w, float (&f)[8]) {
    f[0] = bflo(w.x); f[1] = bfhi(w.x); f[2] = bflo(w.y); f[3] = bfhi(w.y); f[4] = bflo(w.z); f[5] = bfhi(w.z); f[6] = bflo(w.w); f[7] = bfhi(w.w);
}
__device__ __forceinline__ void ld8f(const float* q, float (&f)[8]) {
    const float4 a = *(const float4*)q, b = *(const float4*)(q + 4);
    f[0] = a.x; f[1] = a.y; f[2] = a.z; f[3] = a.w; f[4] = b.x; f[5] = b.y; f[6] = b.z; f[7] = b.w;
}
__device__ __forceinline__ void phase_ffn_conv(const Ctx& p, int layer) {
    const bf16_t* up = (const bf16_t*)(p.ws + O_R2); bf16_t* act = (bf16_t*)(p.ws + O_MIX);
    const float* cw = p.in(17) + (size_t)layer * 3 * DFF2; const float* cb = p.in(18) + (size_t)layer * DFF2;
    const size_t gtid = (size_t)bidx() * NTHREADS + tidx(), gn = (size_t)gridDim.x * NTHREADS;
    for (size_t task = gtid; task < (size_t)1026 * 688; task += gn) {
        const int jb = (int)(task % 688), tb = (int)(task / 688), j0 = jb * 8, t0 = tb * 8;
        float wg[3][8], wv[3][8], bg[8], bv[8];
#pragma unroll
        for (int k = 0; k < 3; ++k) { ld8f(cw + (size_t)k * DFF2 + j0, wg[k]); ld8f(cw + (size_t)k * DFF2 + DFF + j0, wv[k]); }
        ld8f(cb + j0, bg); ld8f(cb + DFF + j0, bv);
        u32x4 gr[10], vr[10];
#pragma unroll
        for (int r = 0; r < 10; ++r) {
            const int t = t0 - 2 + r;
            gr[r] = (u32x4){0u, 0u, 0u, 0u}; vr[r] = (u32x4){0u, 0u, 0u, 0u};
            if (t >= 0) { gr[r] = *(const u32x4*)(up + (size_t)t * DFF2 + j0); vr[r] = *(const u32x4*)(up + (size_t)t * DFF2 + DFF + j0); }
        }
        float g2[8], g1[8], v2[8], v1[8];
        unpack8(gr[0], g2); unpack8(vr[0], v2); unpack8(gr[1], g1); unpack8(vr[1], v1);
#pragma unroll
        for (int tt = 0; tt < 8; ++tt) {
            const int t = t0 + tt;
            float g0[8], v0[8], o[8];
            unpack8(gr[tt + 2], g0); unpack8(vr[tt + 2], v0);
#pragma unroll
            for (int i = 0; i < 8; ++i) {
                const float gg = bg[i] + wg[0][i] * g2[i] + wg[1][i] * g1[i] + wg[2][i] * g0[i];
                const float vv = bv[i] + wv[0][i] * v2[i] + wv[1][i] * v1[i] + wv[2][i] * v0[i];
                o[i] = silu_f(gg) * vv;
                g2[i] = g1[i]; g1[i] = g0[i]; v2[i] = v1[i]; v1[i] = v0[i];
            }
            u32x4 w; w.x = pack2(o[0], o[1]); w.y = pack2(o[2], o[3]); w.z = pack2(o[4], o[5]); w.w = pack2(o[6], o[7]);
            *(u32x4*)(act + (size_t)t * DFF + j0) = w;
        }
    }
}
__device__ __forceinline__ void phase_hyb_prep(const Ctx& p, int jj, LAS unsigned char* lds) {
    const bf16_t* u = (const bf16_t*)(p.ws + O_U);
    const float* side = (const float*)(p.ws + O_SIDE);
    const int tid = tidx(), lane = tid & 63, wid = tid >> 6;
    const size_t gtid = (size_t)bidx() * NTHREADS + tid, gn = (size_t)gridDim.x * NTHREADS;
    {
        bf16_t* xc = (bf16_t*)(p.ws + O_XC);
        const float* cw = p.in(3) + (size_t)jj * 4 * 4096; const float* cb = p.in(4) + (size_t)jj * 4096;
        for (size_t task = gtid; task < (size_t)1026 * 512; task += gn) {
            const int cbk = (int)(task & 511), tb = (int)(task >> 9), c0 = cbk * 8, t0 = tb * 8;
            float w[4][8], bb[8], x3[8], x2[8], x1[8];
#pragma unroll
            for (int k = 0; k < 4; ++k) ld8f(cw + (size_t)k * 4096 + c0, w[k]);
            ld8f(cb + c0, bb);
            u32x4 xr[11];
#pragma unroll
            for (int r = 0; r < 11; ++r) { const int t = t0 - 3 + r; xr[r] = (u32x4){0u, 0u, 0u, 0u}; if (t >= 0) xr[r] = *(const u32x4*)(u + (size_t)t * HYB_N + UXBC + c0); }
            unpack8(xr[0], x3); unpack8(xr[1], x2); unpack8(xr[2], x1);
#pragma unroll
            for (int tt = 0; tt < 8; ++tt) {
                const int t = t0 + tt;
                float x0[8], o[8];
                unpack8(xr[tt + 3], x0);
#pragma unroll
                for (int i = 0; i < 8; ++i) {
                    const float y = bb[i] + w[0][i] * x3[i] + w[1][i] * x2[i] + w[2][i] * x1[i] + w[3][i] * x0[i];
                    o[i] = silu_f(y);
                    x3[i] = x2[i]; x2[i] = x1[i]; x1[i] = x0[i];
                }
                u32x4 ww; ww.x = pack2(o[0], o[1]); ww.y = pack2(o[2], o[3]); ww.z = pack2(o[4], o[5]); ww.w = pack2(o[6], o[7]);
                *(u32x4*)(xc + (size_t)t * 4096 + c0) = ww;
            }
        }
    }
    {
        float* dt = (float*)(p.ws + O_DT); float* acs = (float*)(p.ws + O_ACS); float* cdec = (float*)(p.ws + O_CDEC);
        for (int c = bidx(); c < 65; c += gridDim.x)
        for (int head = wid; head < 32; head += 8) {
            const float bias = p.in(5)[jj * 32 + head], a = -__expf(p.in(6)[jj * 32 + head]);
            const int t0 = c * 128 - 112 + 2 * lane;
            float d0 = 0.f, d1 = 0.f;
            if (t0 >= 0) {
                const float x0 = side[(size_t)t0 * 64 + head] + bias, x1 = side[(size_t)(t0 + 1) * 64 + head] + bias;
                d0 = x0 > 20.f ? x0 : __logf(1.f + __expf(x0)); d1 = x1 > 20.f ? x1 : __logf(1.f + __expf(x1));
            }
            const float a0 = d0 * a, a1 = d1 * a;
            float s = a0 + a1;
#pragma unroll
            for (int o = 1; o < 64; o <<= 1) { const float v = __shfl_up(s, o); if (lane >= o) s += v; }
            const float ex = s - (a0 + a1);
            if (t0 >= 0) {
                dt[(size_t)t0 * 32 + head] = d0; dt[(size_t)(t0 + 1) * 32 + head] = d1;
                acs[(size_t)t0 * 32 + head] = ex + a0; acs[(size_t)(t0 + 1) * 32 + head] = s;
            }
            if (lane == 63) cdec[c * 32 + head] = __expf(s);
        }
    }
    {
        bf16_t* qt = (bf16_t*)(p.ws + O_QT); bf16_t* kt = (bf16_t*)(p.ws + O_KT); float* glast = (float*)(p.ws + O_GLAST);
        const float* w2 = p.in(9) + (size_t)jj * 16 * 1024; const float* gb = p.in(10) + (size_t)jj * 1024;
        LAS float* tot = (LAS float*)lds;
        const int d4 = tid & 15, pg = tid >> 4;
        for (int task = bidx(); task < 129 * 16; task += gridDim.x) {
            const int c = task >> 4, dbase = (task & 15) * 64 + d4 * 4, tbase = c * 64 - 48 + 2 * pg;
            f32x4 w[16];
#pragma unroll
            for (int r = 0; r < 16; ++r) w[r] = *(const f32x4*)(w2 + r * 1024 + dbase);
            const f32x4 b = *(const f32x4*)(gb + dbase);
            f32x4 g0 = {0.f, 0.f, 0.f, 0.f}, g1 = {0.f, 0.f, 0.f, 0.f};
            if (tbase >= 0) {
#pragma unroll
                for (int pos = 0; pos < 2; ++pos) {
                    const float* gl = side + (size_t)(tbase + pos) * 64 + 32;
                    f32x4 x = b;
#pragma unroll
                    for (int r4 = 0; r4 < 4; ++r4) { const f32x4 gv = *(const f32x4*)(gl + r4 * 4); x += w[r4 * 4] * gv[0] + w[r4 * 4 + 1] * gv[1] + w[r4 * 4 + 2] * gv[2] + w[r4 * 4 + 3] * gv[3]; }
                    f32x4 ls;
#pragma unroll
                    for (int e = 0; e < 4; ++e) ls[e] = (fminf(x[e], 0.f) - __logf(1.f + __expf(-fabsf(x[e])))) * (1.f / 16.f);
                    if (pos == 0) g0 = ls; else g1 = ls;
                }
            }
            __syncthreads();
            *(LAS f32x4*)(tot + pg * 64 + d4 * 4) = g0 + g1;
            __syncthreads();
            f32x4 pre = {0.f, 0.f, 0.f, 0.f};
            for (int g = 0; g < pg; ++g) pre += *(const LAS f32x4*)(tot + g * 64 + d4 * 4);
            const f32x4 gc0 = pre + g0, gc1 = gc0 + g1;
            if (tbase >= 0) {
#pragma unroll
                for (int pos = 0; pos < 2; ++pos) {
                    const f32x4 gc = pos == 0 ? gc0 : gc1;
                    const size_t t = (size_t)(tbase + pos);
                    const u32x2 qw = *(const u32x2*)(u + t * HYB_N + UQ + dbase), kw = *(const u32x2*)(u + t * HYB_N + UK + dbase);
                    const float q[4] = {bflo(qw.x), bfhi(qw.x), bflo(qw.y), bfhi(qw.y)}, k[4] = {bflo(kw.x), bfhi(kw.x), bflo(kw.y), bfhi(kw.y)};
                    u32x2 qo, ko;
                    qo.x = pack2(q[0] * 0.0625f * __expf(gc[0]), q[1] * 0.0625f * __expf(gc[1])); qo.y = pack2(q[2] * 0.0625f * __expf(gc[2]), q[3] * 0.0625f * __expf(gc[3]));
                    ko.x = pack2(k[0] * __expf(-gc[0]), k[1] * __expf(-gc[1])); ko.y = pack2(k[2] * __expf(-gc[2]), k[3] * __expf(-gc[3]));
                    *(u32x2*)(qt + t * 1024 + dbase) = qo; *(u32x2*)(kt + t * 1024 + dbase) = ko;
                }
            }
            if (pg == 31) { f32x4 e; e[0] = __expf(gc1[0]); e[1] = __expf(gc1[1]); e[2] = __expf(gc1[2]); e[3] = __expf(gc1[3]); *(f32x4*)(glast + c * 1024 + dbase) = e; }
        }
    }
}

__device__ __forceinline__ void phase_hyb_local(const Ctx& p, LAS unsigned char* lds) {
    const int tid = tidx(), lane = tid & 63, wid = tid >> 6, fr = lane & 15, fq = lane >> 4;
    const bf16_t* xc = (const bf16_t*)(p.ws + O_XC);
    const float* dt = (const float*)(p.ws + O_DT); const float* acs = (const float*)(p.ws + O_ACS);
    const int NSSD = 65 * 8, NGLA = 129 * 16;
    for (int task = bidx(); task < NSSD + NGLA; task += gridDim.x) {
        __syncthreads();
        if (task < NSSD) {
            const int c = task >> 3, g = task & 7, tbase = c * 128 - 112;
            LAS bf16_t* Bs = (LAS bf16_t*)lds;
            LAS bf16_t* Xs = Bs + 128 * 136;
            const int tlast = tbase + 127;
            for (int item = tid; item < 128 * 16; item += NTHREADS) {
                const int j = item >> 4, cb = item & 15, t = tbase + j;
                u32x4 w = {0u, 0u, 0u, 0u};
                if (t >= 0) w = *(const u32x4*)(xc + (size_t)t * 4096 + 2048 + g * 128 + cb * 8);
                *(LAS u32x4*)(Bs + j * 136 + cb * 8) = w;
            }
            for (int item = tid; item < 128 * 32; item += NTHREADS) {
                const int j = item >> 5, cb = item & 31, hh = cb >> 3, t = tbase + j, head = g * 4 + hh;
                u32x4 w = {0u, 0u, 0u, 0u};
                if (t >= 0) {
                    float f[8]; unpack8(*(const u32x4*)(xc + (size_t)t * 4096 + g * 256 + cb * 8), f);
                    const float sc = dt[(size_t)t * 32 + head] * __expf(acs[(size_t)tlast * 32 + head] - acs[(size_t)t * 32 + head]);
                    w.x = pack2(f[0] * sc, f[1] * sc); w.y = pack2(f[2] * sc, f[3] * sc); w.z = pack2(f[4] * sc, f[5] * sc); w.w = pack2(f[6] * sc, f[7] * sc);
                }
                *(LAS u32x4*)(Xs + j * 264 + cb * 8) = w;
            }
            __syncthreads();
            float* loc = (float*)(p.ws + O_SSDLOC) + ((size_t)c * 32 + g * 4) * 64 * 128;
            const int pt = wid & 3, nh = wid >> 2;
            for (int hh = 0; hh < 4; ++hh) {
                f32x4 acc[4];
#pragma unroll
                for (int nt = 0; nt < 4; ++nt) acc[nt] = (f32x4){0.f, 0.f, 0.f, 0.f};
#pragma unroll
                for (int ks = 0; ks < 4; ++ks) {
                    const bf16x8 xf = ldfrag_tr(Xs, 264, hh * 64 + pt * 16, ks * 32, lane);
#pragma unroll
                    for (int nt = 0; nt < 4; ++nt) { const bf16x8 bf = ldfrag_tr(Bs, 136, nh * 64 + nt * 16, ks * 32, lane); acc[nt] = MFMA16(bf, xf, acc[nt]); }
                }
#pragma unroll
                for (int nt = 0; nt < 4; ++nt) *(f32x4*)(loc + ((size_t)hh * 64 + pt * 16 + fr) * 128 + nh * 64 + nt * 16 + 4 * fq) = acc[nt];
            }
        } else {
            const int gt = task - NSSD, c = gt >> 4, h = (gt >> 2) & 3, vs = gt & 3, tbase = c * 64 - 48;
            const bf16_t* u = (const bf16_t*)(p.ws + O_U); const bf16_t* kt = (const bf16_t*)(p.ws + O_KT);
            LAS bf16_t* Ks = (LAS bf16_t*)lds;
            LAS bf16_t* Vs = Ks + 64 * 264;
            for (int item = tid; item < 64 * 32; item += NTHREADS) {
                const int j = item >> 5, cb = item & 31, t = tbase + j;
                u32x4 w = {0u, 0u, 0u, 0u};
                if (t >= 0) w = *(const u32x4*)(kt + (size_t)t * 1024 + h * 256 + cb * 8);
                *(LAS u32x4*)(Ks + j * 264 + cb * 8) = w;
            }
            for (int item = tid; item < 64 * 16; item += NTHREADS) {
                const int j = item >> 4, cb = item & 15, t = tbase + j;
                u32x4 w = {0u, 0u, 0u, 0u};
                if (t >= 0) w = *(const u32x4*)(u + (size_t)t * HYB_N + UV + h * 512 + vs * 128 + cb * 8);
                *(LAS u32x4*)(Vs + j * 136 + cb * 8) = w;
            }
            __syncthreads();
            const float* glast = (const float*)(p.ws + O_GLAST) + c * 1024 + h * 256;
            bf16_t* kv = (bf16_t*)(p.ws + O_R2) + ((size_t)c * 4 + h) * 131072 + (size_t)(vs * 8 + wid) * 4096 + fr * 8 + (fq & 1) * 4;
            const bf16x8 vf0 = ldfrag_tr(Vs, 136, wid * 16, 0, lane), vf1 = ldfrag_tr(Vs, 136, wid * 16, 32, lane);
#pragma unroll
            for (int nt = 0; nt < 16; ++nt) {
                f32x4 acc = {0.f, 0.f, 0.f, 0.f};
                acc = MFMA16(ldfrag_tr(Ks, 264, nt * 16, 0, lane), vf0, acc);
                acc = MFMA16(ldfrag_tr(Ks, 264, nt * 16, 32, lane), vf1, acc);
                const f32x4 gl = *(const f32x4*)(glast + nt * 16 + 4 * fq);
                u32x2 w; w.x = pack2(acc[0] * gl[0], acc[1] * gl[1]); w.y = pack2(acc[2] * gl[2], acc[3] * gl[3]);
                *(u32x2*)(kv + (nt >> 1) * 512 + ((nt & 1) * 2 + (fq >> 1)) * 128) = w;
            }
        }
    }
}

__device__ __forceinline__ void phase_hyb_scan(const Ctx& p) {
    const size_t gtid = (size_t)bidx() * NTHREADS + tidx(), gn = (size_t)gridDim.x * NTHREADS;
    for (size_t task = gtid; task < 131072; task += gn) {
        if (task < 65536) {
            const size_t e = task * 4; const int head = (int)(e >> 13);
            const float* loc = (const float*)(p.ws + O_SSDLOC) + e; bf16_t* prev = (bf16_t*)(p.ws + O_SSDPREV) + e;
            const float* cdec = (const float*)(p.ws + O_CDEC) + head;
            float zz = 0.f; asm volatile("" : "+v"(zz));
            float4 run = {zz, zz, zz, zz};
            for (int c0 = 0; c0 < 65; c0 += 13) {
                float4 l[13]; float dcy[13];
#pragma unroll
                for (int i = 0; i < 13; ++i) { l[i] = *(const float4*)(loc + (size_t)(c0 + i) * 262144); dcy[i] = cdec[(c0 + i) * 32]; }
#pragma unroll
                for (int i = 0; i < 13; ++i) {
                    u32x2 w; w.x = pack2(run.x, run.y); w.y = pack2(run.z, run.w);
                    *(u32x2*)(prev + (size_t)(c0 + i) * 262144) = w;
                    run.x = run.x * dcy[i] + l[i].x; run.y = run.y * dcy[i] + l[i].y; run.z = run.z * dcy[i] + l[i].z; run.w = run.w * dcy[i] + l[i].w;
                }
            }
        } else {
            const size_t e = (task - 65536) * 8; const int h = (int)(e >> 17), ch16 = (int)((e & 131071) >> 3), d0 = ((ch16 >> 6) & 7) * 32 + ((ch16 >> 4) & 3) * 8;
            const bf16_t* kv = (const bf16_t*)(p.ws + O_R2) + e; bf16_t* sp = (bf16_t*)(p.ws + O_R2 + GLA_ST_BYTES) + e;
            const float* glast = (const float*)(p.ws + O_GLAST) + h * 256 + d0;
            float run[8]; float zz = 0.f; asm volatile("" : "+v"(zz));
#pragma unroll
            for (int i = 0; i < 8; ++i) run[i] = zz;
            for (int c0 = 0; c0 < 129; c0 += 8) {
                u32x4 lw[8]; float4 ga[8], gb2[8];
#pragma unroll
                for (int i = 0; i < 8; ++i) { const int c = c0 + i < 129 ? c0 + i : 128; lw[i] = *(const u32x4*)(kv + (size_t)c * 524288); ga[i] = *(const float4*)(glast + c * 1024); gb2[i] = *(const float4*)(glast + c * 1024 + 4); }
#pragma unroll
                for (int i = 0; i < 8; ++i) {
                    if (c0 + i < 129) {
                        float l[8]; unpack8(lw[i], l);
                        u32x4 w; w.x = pack2(run[0], run[1]); w.y = pack2(run[2], run[3]); w.z = pack2(run[4], run[5]); w.w = pack2(run[6], run[7]);
                        *(u32x4*)(sp + (size_t)(c0 + i) * 524288) = w;
                        run[0] = run[0] * ga[i].x + l[0]; run[1] = run[1] * ga[i].y + l[1]; run[2] = run[2] * ga[i].z + l[2]; run[3] = run[3] * ga[i].w + l[3];
                        run[4] = run[4] * gb2[i].x + l[4]; run[5] = run[5] * gb2[i].y + l[5]; run[6] = run[6] * gb2[i].z + l[6]; run[7] = run[7] * gb2[i].w + l[7];
                    }
                }
            }
        }
    }
}
__device__ __forceinline__ void phase_hyb_out(const Ctx& p, int jj, LAS unsigned char* lds) {
    const bf16_t* xc = (const bf16_t*)(p.ws + O_XC); const bf16_t* u = (const bf16_t*)(p.ws + O_U);
    const float* dt = (const float*)(p.ws + O_DT); const float* acs = (const float*)(p.ws + O_ACS);
    bf16_t* mix = (bf16_t*)(p.ws + O_MIX);
    for (int task0 = bidx(); task0 < 1036; task0 += gridDim.x) {
        bool is_ssd; int c, sub;
        if (task0 < 8) { is_ssd = true; c = 0; sub = task0; }
        else if (task0 < 12) { is_ssd = false; c = 0; sub = task0 - 8; }
        else if (task0 < 524) { is_ssd = true; c = 1 + ((task0 - 12) >> 3); sub = (task0 - 12) & 7; }
        else { is_ssd = false; c = 1 + ((task0 - 524) >> 2); sub = (task0 - 524) & 3; }
        const int tid = tidx(), lane = tid & 63, wid = tid >> 6, fr = lane & 15, fq = lane >> 4;
        __syncthreads();
        if (is_ssd) {
            const int g = sub, tbase = c * 128 - 112;
            LAS bf16_t* Cs = (LAS bf16_t*)lds;
            LAS bf16_t* Bs = Cs + 128 * 136;
            LAS bf16_t* Xt = Bs + 128 * 136;
            LAS bf16_t* Pv = Xt + 128 * 72;
            LAS float* Acs = (LAS float*)(Pv + 64 * 136);
            for (int item = tid; item < 128 * 32; item += NTHREADS) {
                const int j = item >> 5, cb = item & 31, t = tbase + j;
                u32x4 w = {0u, 0u, 0u, 0u};
                if (t >= 0) w = *(const u32x4*)(xc + (size_t)t * 4096 + 2048 + (cb < 16 ? 0 : 1024) + g * 128 + (cb & 15) * 8);
                *(LAS u32x4*)((cb < 16 ? Bs : Cs) + j * 136 + (cb & 15) * 8) = w;
            }
            { const int j = tid & 127, hh = tid >> 7, t = tbase + j; Acs[hh * 128 + j] = t >= 0 ? acs[(size_t)t * 32 + g * 4 + hh] : 0.f; }
            __syncthreads();
            const int i_row = wid * 16 + fr, ti = tbase + i_row;
            f32x4 cb_acc[8];
#pragma unroll
            for (int nt = 0; nt < 8; ++nt) cb_acc[nt] = (f32x4){0.f, 0.f, 0.f, 0.f};
#pragma unroll
            for (int ks = 0; ks < 4; ++ks) {
                const bf16x8 cf = ldfrag(Cs, 136, wid * 16, ks * 32, lane);
#pragma unroll
                for (int nt = 0; nt < 8; ++nt) cb_acc[nt] = MFMA16(ldfrag(Bs, 136, nt * 16, ks * 32, lane), cf, cb_acc[nt]);
            }
            f32x4 yv[4][4];
#pragma unroll
            for (int k = 0; k < 4; ++k)
#pragma unroll
                for (int pt = 0; pt < 4; ++pt) yv[k][pt] = (f32x4){0.f, 0.f, 0.f, 0.f};
            float ssq = 0.f;
#pragma unroll 1
            for (int hh = 0; hh < 4; ++hh) {
                const int head = g * 4 + hh;
                __syncthreads();
                for (int item = tid; item < 128 * 8; item += NTHREADS) {
                    const int j = item >> 3, cb = item & 7, t = tbase + j;
                    u32x4 w = {0u, 0u, 0u, 0u};
                    if (t >= 0) { float f[8]; unpack8(*(const u32x4*)(xc + (size_t)t * 4096 + head * 64 + cb * 8), f); const float sc = dt[(size_t)t * 32 + head];
                        w.x = pack2(f[0] * sc, f[1] * sc); w.y = pack2(f[2] * sc, f[3] * sc); w.z = pack2(f[4] * sc, f[5] * sc); w.w = pack2(f[6] * sc, f[7] * sc); }
                    *(LAS u32x4*)(Xt + j * 72 + cb * 8) = w;
                }
                { const bf16_t* pv = (const bf16_t*)(p.ws + O_SSDPREV) + ((size_t)c * 32 + head) * 64 * 128;
                  for (int item = tid; item < 64 * 16; item += NTHREADS) { const int pp = item >> 4, cb = item & 15; *(LAS u32x4*)(Pv + pp * 136 + cb * 8) = *(const u32x4*)(pv + pp * 128 + cb * 8); } }
                const float ai = Acs[hh * 128 + i_row];
#pragma unroll
                for (int nt = 0; nt < 8; ++nt) {
                    float m[4];
#pragma unroll
                    for (int q = 0; q < 4; ++q) { const int j = nt * 16 + 4 * fq + q; m[q] = j <= i_row ? cb_acc[nt][q] * __expf(ai - Acs[hh * 128 + j]) : 0.f; }
                    u32x2 w; w.x = pack2(m[0], m[1]); w.y = pack2(m[2], m[3]);
                    *(LAS u32x2*)(Bs + i_row * 136 + nt * 16 + 4 * fq) = w;
                }
                __syncthreads();
                f32x4 yd[4], yo[4];
#pragma unroll
                for (int pt = 0; pt < 4; ++pt) { yd[pt] = (f32x4){0.f, 0.f, 0.f, 0.f}; yo[pt] = (f32x4){0.f, 0.f, 0.f, 0.f}; }
#pragma unroll
                for (int ks = 0; ks < 4; ++ks) {
                    const bf16x8 mf = ldfrag(Bs, 136, wid * 16, ks * 32, lane), cf = ldfrag(Cs, 136, wid * 16, ks * 32, lane);
#pragma unroll
                    for (int pt = 0; pt < 4; ++pt) {
                        yd[pt] = MFMA16(ldfrag_tr(Xt, 72, pt * 16, ks * 32, lane), mf, yd[pt]);
                        yo[pt] = MFMA16(ldfrag(Pv, 136, pt * 16, ks * 32, lane), cf, yo[pt]);
                    }
                }
                const float ea = __expf(ai), dsk = p.in(7)[jj * 32 + head];
#pragma unroll
                for (int pt = 0; pt < 4; ++pt) {
                    const int ch = head * 64 + pt * 16 + 4 * fq;
                    float xs[4] = {0.f, 0.f, 0.f, 0.f}, zz[4] = {0.f, 0.f, 0.f, 0.f};
                    if (ti >= 0) {
                        const u32x2 xw = *(const u32x2*)(xc + (size_t)ti * 4096 + ch), zw = *(const u32x2*)(u + (size_t)ti * HYB_N + UZ + ch);
                        xs[0] = bflo(xw.x); xs[1] = bfhi(xw.x); xs[2] = bflo(xw.y); xs[3] = bfhi(xw.y);
                        zz[0] = bflo(zw.x); zz[1] = bfhi(zw.x); zz[2] = bflo(zw.y); zz[3] = bfhi(zw.y);
                    }
#pragma unroll
                    for (int q = 0; q < 4; ++q) { const float y = (yd[pt][q] + ea * yo[pt][q] + dsk * xs[q]) * silu_f(zz[q]); ssq += y * y;
#pragma unroll
                        for (int k = 0; k < 4; ++k) yv[k][pt][q] = (k == hh) ? y : yv[k][pt][q]; }
                }
            }
            ssq += __shfl_xor(ssq, 16); ssq += __shfl_xor(ssq, 32);
            const float rs = rsqrtf(ssq * (1.f / 256.f) + 1e-6f);
            if (ti >= 0) {
                const float* nw = p.in(8) + (size_t)jj * 2048;
#pragma unroll
                for (int hh = 0; hh < 4; ++hh)
#pragma unroll
                    for (int pt = 0; pt < 4; ++pt) {
                        const int ch = (g * 4 + hh) * 64 + pt * 16 + 4 * fq;
                        const f32x4 wv = *(const f32x4*)(nw + ch);
                        u32x2 w; w.x = pack2(yv[hh][pt][0] * rs * wv[0], yv[hh][pt][1] * rs * wv[1]); w.y = pack2(yv[hh][pt][2] * rs * wv[2], yv[hh][pt][3] * rs * wv[3]);
                        *(u32x2*)(mix + (size_t)ti * 4096 + ch) = w;
                    }
            }
        } else {
            const int h = sub, tbase = c * 64 - 48;
            const bf16_t* qt = (const bf16_t*)(p.ws + O_QT); const bf16_t* kt = (const bf16_t*)(p.ws + O_KT);
            LAS bf16_t* Qs = (LAS bf16_t*)lds;
            LAS bf16_t* Ps = Qs + 64 * 264;
            LAS float* Ssq = (LAS float*)(Ps + 64 * 72);
            LAS bf16_t* Ks = (LAS bf16_t*)(Ssq + 512);
            LAS bf16_t* Vs = Ks;
            for (int item = tid; item < 64 * 64; item += NTHREADS) {
                const int j = item >> 6, cb = item & 63, t = tbase + j;
                u32x4 w = {0u, 0u, 0u, 0u};
                if (t >= 0) w = *(const u32x4*)((cb < 32 ? qt : kt) + (size_t)t * 1024 + h * 256 + (cb & 31) * 8);
                *(LAS u32x4*)((cb < 32 ? Qs : Ks) + j * 264 + (cb & 31) * 8) = w;
            }
            u32x4 vreg[8];
#pragma unroll
            for (int r = 0; r < 8; ++r) { const int item = tid + r * NTHREADS, j = item >> 6, cb = item & 63, t = tbase + j;
                vreg[r] = (u32x4){0u, 0u, 0u, 0u};
                if (t >= 0) vreg[r] = *(const u32x4*)(u + (size_t)t * HYB_N + UV + h * 512 + cb * 8); }
            __syncthreads();
#pragma unroll
            for (int rep = 0; rep < 2; ++rep) {
                const int tix = wid + rep * 8, it = tix >> 2, jt = tix & 3;
                f32x4 acc = {0.f, 0.f, 0.f, 0.f};
                if (jt <= it) {
#pragma unroll
                    for (int ks = 0; ks < 8; ++ks) acc = MFMA16(ldfrag(Ks, 264, jt * 16, ks * 32, lane), ldfrag(Qs, 264, it * 16, ks * 32, lane), acc);
                }
                const int i = it * 16 + fr;
                float m[4];
#pragma unroll
                for (int q = 0; q < 4; ++q) { const int j = jt * 16 + 4 * fq + q; m[q] = (j <= i) ? acc[q] : 0.f; }
                u32x2 w; w.x = pack2(m[0], m[1]); w.y = pack2(m[2], m[3]);
                *(LAS u32x2*)(Ps + i * 72 + jt * 16 + 4 * fq) = w;
            }
            __syncthreads();
#pragma unroll
            for (int r = 0; r < 8; ++r) { const int item = tid + r * NTHREADS, j = item >> 6, cb = item & 63; *(LAS u32x4*)(Vs + j * 520 + cb * 8) = vreg[r]; }
            __syncthreads();
            f32x4 o[4][4];
            float ssq[4] = {0.f, 0.f, 0.f, 0.f};
            const bf16_t* sp = (const bf16_t*)(p.ws + O_R2 + GLA_ST_BYTES) + ((size_t)c * 4 + h) * 512 * 256;
#pragma unroll
            for (int vs = 0; vs < 4; ++vs) {
#pragma unroll
                for (int it = 0; it < 4; ++it) o[vs][it] = (f32x4){0.f, 0.f, 0.f, 0.f};
#pragma unroll
                for (int ks = 0; ks < 2; ++ks) {
                    const bf16x8 vf = ldfrag_tr(Vs, 520, vs * 128 + wid * 16, ks * 32, lane);
#pragma unroll
                    for (int it = 0; it < 4; ++it) o[vs][it] = MFMA16(vf, ldfrag(Ps, 72, it * 16, ks * 32, lane), o[vs][it]);
                }
                const bf16_t* spw = sp + (size_t)(vs * 8 + wid) * 4096 + lane * 8;
#pragma unroll
                for (int ks = 0; ks < 8; ++ks) {
                    const bf16x8 sf = *(const bf16x8*)(spw + ks * 512);
#pragma unroll
                    for (int it = 0; it < 4; ++it) o[vs][it] = MFMA16(sf, ldfrag(Qs, 264, it * 16, ks * 32, lane), o[vs][it]);
                }
#pragma unroll
                for (int it = 0; it < 4; ++it) ssq[it] += o[vs][it][0] * o[vs][it][0] + o[vs][it][1] * o[vs][it][1] + o[vs][it][2] * o[vs][it][2] + o[vs][it][3] * o[vs][it][3];
            }
#pragma unroll
            for (int it = 0; it < 4; ++it) { float s = ssq[it]; s += __shfl_xor(s, 16); s += __shfl_xor(s, 32); if (fq == 0) Ssq[wid * 64 + it * 16 + fr] = s; }
            __syncthreads();
            const float* nw = p.in(11) + (size_t)jj * 2048 + h * 512;
#pragma unroll
            for (int it = 0; it < 4; ++it) {
                const int i = it * 16 + fr, t = tbase + i;
                float s = 0.f;
#pragma unroll
                for (int w8 = 0; w8 < 8; ++w8) s += Ssq[w8 * 64 + i];
                const float rs = rsqrtf(s * (1.f / 512.f) + 1e-6f);
                if (t >= 0) {
#pragma unroll
                    for (int vs = 0; vs < 4; ++vs) {
                        const int v0 = vs * 128 + wid * 16 + 4 * fq;
                        const f32x4 wv = *(const f32x4*)(nw + v0);
                        const u32x2 rw = *(const u32x2*)(u + (size_t)t * HYB_N + UR + h * 512 + v0);
                        const float r0 = bflo(rw.x), r1 = bfhi(rw.x), r2 = bflo(rw.y), r3 = bfhi(rw.y);
                        u32x2 w;
                        w.x = pack2(o[vs][it][0] * rs * wv[0] * silu_f(r0), o[vs][it][1] * rs * wv[1] * silu_f(r1));
                        w.y = pack2(o[vs][it][2] * rs * wv[2] * silu_f(r2), o[vs][it][3] * rs * wv[3] * silu_f(r3));
                        *(u32x2*)(mix + (size_t)t * 4096 + 2048 + h * 512 + v0) = w;
                    }
                }
            }
        }
    }
}
__device__ __forceinline__ void rot_pair(const u32x4 a, const u32x4 b, const float* cs, u32x4& oa, u32x4& ob) {
    float x1[8], x2[8], c[8], s[8]; unpack8(a, x1); unpack8(b, x2); ld8f(cs, c); ld8f(cs + 8, s);
    float r1[8], r2[8];
#pragma unroll
    for (int i = 0; i < 8; ++i) { r1[i] = x1[i] * c[i] - x2[i] * s[i]; r2[i] = x2[i] * c[i] + x1[i] * s[i]; }
    oa.x = pack2(r1[0], r1[1]); oa.y = pack2(r1[2], r1[3]); oa.z = pack2(r1[4], r1[5]); oa.w = pack2(r1[6], r1[7]);
    ob.x = pack2(r2[0], r2[1]); ob.y = pack2(r2[2], r2[3]); ob.z = pack2(r2[4], r2[5]); ob.w = pack2(r2[6], r2[7]);
}
__device__ __forceinline__ void phase_attn(const Ctx& p, int jj, LAS unsigned char* lds) {
    const int tid = tidx(), lane = tid & 63, wid = tid >> 6, fr = lane & 15, fq = lane >> 4;
    const bf16_t* qkv = (const bf16_t*)(p.ws + O_U);
    const float* rope = (const float*)(p.ws + O_ROPE);
    bf16_t* ao = (bf16_t*)(p.ws + O_MIX);
    LAS bf16_t* Ks = (LAS bf16_t*)lds;
    LAS bf16_t* Vt = Ks + 272 * 72;
    LAS bf16_t* Pw = Vt + 64 * 280 + wid * (16 * 168);
    for (int task0 = bidx(); task0 < 520; task0 += gridDim.x) {
        const int task = task0 < 8 ? 512 + task0 : task0 - 8;
        const bool meta = task >= 512;
        const int b = meta ? 0 : (task >> 3), kh = task & 7;
        const int nkeys = meta ? 32 : 272;
        __syncthreads();
        for (int item = tid; item < nkeys * 8; item += NTHREADS) {
            const int key = item >> 3, cb = item & 7;
            const int tok = key < 16 ? key : 16 + 128 * (b - 1) + (key - 16);
            const bool valid = meta ? (key < 16) : (key < 16 || tok >= 16);
            {
                u32x4 w = {0u, 0u, 0u, 0u};
                if (valid) w = *(const u32x4*)(qkv + (size_t)tok * QKV_N + 2560 + kh * 64 + cb * 8);
                const bf16_t e[8] = {(bf16_t)(w.x & 0xffff), (bf16_t)(w.x >> 16), (bf16_t)(w.y & 0xffff), (bf16_t)(w.y >> 16), (bf16_t)(w.z & 0xffff), (bf16_t)(w.z >> 16), (bf16_t)(w.w & 0xffff), (bf16_t)(w.w >> 16)};
#pragma unroll
                for (int i = 0; i < 8; ++i) Vt[(cb * 8 + i) * 280 + key] = e[i];
            }
            if (cb == 1) continue;
            const bf16_t* src = qkv + (size_t)tok * QKV_N + 2048 + kh * 64;
            if (cb == 0) {
                u32x4 oa = {0u, 0u, 0u, 0u}, ob = {0u, 0u, 0u, 0u};
                if (valid) rot_pair(*(const u32x4*)src, *(const u32x4*)(src + 8), rope + (size_t)tok * 16, oa, ob);
                *(LAS u32x4*)(Ks + key * 72) = oa; *(LAS u32x4*)(Ks + key * 72 + 8) = ob;
            } else {
                u32x4 w = {0u, 0u, 0u, 0u};
                if (valid) w = *(const u32x4*)(src + cb * 8);
                *(LAS u32x4*)(Ks + key * 72 + cb * 8) = w;
            }
        }
        __syncthreads();
        if (meta && wid >= 4) continue;
        const int ng = meta ? 1 : 4;
        for (int gi = 0; gi < ng; ++gi) {
            const int g = meta ? wid : gi, hq = kh * 4 + g;
            const int tq = meta ? fr : 16 + 128 * b + 16 * wid + fr;
            u32x4 q0 = *(const u32x4*)(qkv + (size_t)tq * QKV_N + hq * 64 + 8 * fq), q1 = *(const u32x4*)(qkv + (size_t)tq * QKV_N + hq * 64 + 32 + 8 * fq);
            {
                u32x4 ot; ot.x = __shfl_xor((int)q0.x, 16); ot.y = __shfl_xor((int)q0.y, 16); ot.z = __shfl_xor((int)q0.z, 16); ot.w = __shfl_xor((int)q0.w, 16);
                if (fq < 2) {
                    float mine[8], oth[8], c[8], s[8]; unpack8(q0, mine); unpack8(ot, oth); ld8f(rope + (size_t)tq * 16, c); ld8f(rope + (size_t)tq * 16 + 8, s);
                    const float sg = fq == 0 ? -1.f : 1.f;
                    float r[8];
#pragma unroll
                    for (int i = 0; i < 8; ++i) r[i] = mine[i] * c[i] + sg * oth[i] * s[i];
                    q0.x = pack2(r[0], r[1]); q0.y = pack2(r[2], r[3]); q0.z = pack2(r[4], r[5]); q0.w = pack2(r[6], r[7]);
                }
            }
            const bf16x8 qa0 = __builtin_bit_cast(bf16x8, q0), qa1 = __builtin_bit_cast(bf16x8, q1);
            const float sink = p.in(14)[jj * 32 + hq];
            const int nt = meta ? 1 : 10;
            f32x4 sc[10];
            float mx = sink;
#pragma unroll
            for (int t = 0; t < 10; ++t) {
                if (t < nt) {
                    const int krow = t == 0 ? 0 : 16 + 16 * (wid + t - 1);
                    f32x4 a = {0.f, 0.f, 0.f, 0.f};
                    a = MFMA16(ldfrag(Ks, 72, krow, 0, lane), qa0, a);
                    a = MFMA16(ldfrag(Ks, 72, krow, 32, lane), qa1, a);
#pragma unroll
                    for (int j = 0; j < 4; ++j) {
                        bool vis;
                        if (t == 0) vis = meta ? (4 * fq + j <= fr) : true;
                        else { const int rel = 16 * (t - 1) + 4 * fq + j - fr; vis = rel >= 1 && rel <= 128 && (b > 0 || 16 * wid + 16 * (t - 1) + 4 * fq + j >= 128); }
                        const float v = vis ? a[j] * 0.125f : -INFINITY;
                        a[j] = v; mx = fmaxf(mx, v);
                    }
                    sc[t] = a;
                }
            }
            mx = fmaxf(mx, __shfl_xor(mx, 16)); mx = fmaxf(mx, __shfl_xor(mx, 32));
            float den = 0.f;
#pragma unroll
            for (int t = 0; t < 10; ++t) {
                if (t < nt) {
                    float e[4];
#pragma unroll
                    for (int j = 0; j < 4; ++j) { e[j] = __expf(sc[t][j] - mx); den += e[j]; }
                    u32x2 w; w.x = pack2(e[0], e[1]); w.y = pack2(e[2], e[3]);
                    *(LAS u32x2*)(Pw + fr * 168 + t * 16 + 4 * fq) = w;
                }
            }
            if (meta) { unsigned zz = 0u; asm volatile("" : "+v"(zz)); u32x2 z = {zz, zz}; *(LAS u32x2*)(Pw + fr * 168 + 16 + 4 * fq) = z; }
            den += __shfl_xor(den, 16); den += __shfl_xor(den, 32);
            den += __expf(sink - mx);
            const float rden = 1.f / den;
            LDS_FENCE();
            f32x4 oacc[4];
#pragma unroll
            for (int dtl = 0; dtl < 4; ++dtl) oacc[dtl] = (f32x4){0.f, 0.f, 0.f, 0.f};
            const int nks = meta ? 1 : 5;
#pragma unroll
            for (int ks = 0; ks < 5; ++ks) {
                if (ks < nks) {
                    const int pc = 32 * ks + 8 * fq;
                    const bf16x8 pf = *(const LAS bf16x8*)(Pw + fr * 168 + pc);
                    const int vcol = (pc < 16 || meta) ? pc : pc + 16 * wid;
#pragma unroll
                    for (int dtl = 0; dtl < 4; ++dtl) {
                        const bf16x8 vf = *(const LAS bf16x8*)(Vt + (dtl * 16 + fr) * 280 + vcol);
                        oacc[dtl] = MFMA16(vf, pf, oacc[dtl]);
                    }
                }
            }
            LDS_FENCE();
#pragma unroll
            for (int dtl = 0; dtl < 4; ++dtl) {
                u32x2 w; w.x = pack2(oacc[dtl][0] * rden, oacc[dtl][1] * rden); w.y = pack2(oacc[dtl][2] * rden, oacc[dtl][3] * rden);
                *(u32x2*)(ao + (size_t)tq * DM + hq * 64 + dtl * 16 + 4 * fq) = w;
            }
        }
    }
}
enum { K_PREP = 0, K_HIN, K_HPREP, K_HLOCAL, K_HSCAN, K_HOUT, K_GOUT, K_LN1, K_UP, K_CONV, K_DOWN, K_LN2, K_QKV, K_ATTN };
constexpr int N_PHASES = 1 + 2 * 11 + 2 * 8;
__host__ __device__ __forceinline__ void decode_phase(int ph, int& kind, int& layer) {
    if (ph == 0) { kind = K_PREP; layer = 0; return; }
    int r = ph - 1; layer = 0;
    if (r >= 19) { r -= 19; layer = 2; }
    if (r < 11) { kind = K_HIN + r; return; }
    r -= 11; layer += 1;
    kind = r == 0 ? K_QKV : (r == 1 ? K_ATTN : K_GOUT + (r - 2));
}
__global__ void __launch_bounds__(512, 2) fwd_megakernel(Params pin) {
    extern __shared__ __attribute__((aligned(16))) unsigned char shm[];
    LAS unsigned char* lds = (LAS unsigned char*)shm;
    cg::grid_group grid = cg::this_grid();
    volatile LAS unsigned* xst = (volatile LAS unsigned*)(lds + LDS_MAIN);
    if (threadIdx.x == 0) { xst[0] = 0u; xst[1] = 0u; }
    __syncthreads();
    XcdBarrier xb = xcd_barrier_post((unsigned*)(pin.ws + O_BAR), xst);
    if (pin.ph_lo == 0) { phase_prep(pin, lds); if (pin.ph_hi > 1) grid.sync(); }
    for (int ph = pin.ph_lo < 1 ? 1 : pin.ph_lo; ph < pin.ph_hi; ++ph) {
        Ctx p; { unsigned lo = (unsigned)(size_t)pin.ws, hi = (unsigned)((size_t)pin.ws >> 32); asm volatile("" : "+s"(lo), "+s"(hi)); p.ws = (unsigned char*)(__attribute__((address_space(1))) unsigned char*)(((size_t)hi << 32) | lo); p.out = pin.out; }
        ph = __builtin_amdgcn_readfirstlane(ph);
        int kind, layer; decode_phase(ph, kind, layer);
        const int jj = layer >> 1;
        bf16_t* hb = (bf16_t*)(p.ws + O_HB); float* h = (float*)(p.ws + O_H);
        bf16_t* mix = (bf16_t*)(p.ws + O_MIX);
        switch (kind) {
        case K_HIN: case K_QKV: case K_UP: {
            const bf16_t* w; bf16_t* O; int N;
            if (kind == K_HIN) { w = (const bf16_t*)(p.ws + O_WT_HIN) + (size_t)jj * 12288 * 2048; O = (bf16_t*)(p.ws + O_U); N = HYB_N;
                const int lane = tidx() & 63, wid = tidx() >> 6; const bf16_t* ws_ = (const bf16_t*)(p.ws + O_WT_HSIDE) + (size_t)jj * 48 * 2048; float* side = (float*)(p.ws + O_SIDE);
                for (int rt = bidx() * 8 + wid; rt < 513; rt += gridDim.x * 8) {
                    f32x4 a0 = {0.f, 0.f, 0.f, 0.f}, a1 = {0.f, 0.f, 0.f, 0.f}, a2 = {0.f, 0.f, 0.f, 0.f};
                    const bf16_t* pa = hb + (size_t)(rt * 16 + (lane & 15)) * 2048 + 8 * (lane >> 4);
                    const bf16_t* pb = ws_ + (size_t)(lane & 15) * 2048 + 8 * (lane >> 4);
#pragma unroll 8
                    for (int k0 = 0; k0 < 2048; k0 += 32) {
                        const bf16x8 a = *(const bf16x8*)(pa + k0);
                        a0 = MFMA16(*(const bf16x8*)(pb + k0), a, a0); a1 = MFMA16(*(const bf16x8*)(pb + 16 * 2048 + k0), a, a1); a2 = MFMA16(*(const bf16x8*)(pb + 32 * 2048 + k0), a, a2);
                    }
                    float* sr = side + (size_t)(rt * 16 + (lane & 15)) * 64 + 4 * (lane >> 4);
                    *(f32x4*)sr = a0; *(f32x4*)(sr + 16) = a1; *(f32x4*)(sr + 32) = a2; }
            } else if (kind == K_QKV) { w = (const bf16_t*)(p.ws + O_WT_QKV) + (size_t)jj * 3072 * 2048; O = (bf16_t*)(p.ws + O_U); N = QKV_N; }
            else { w = (const bf16_t*)(p.ws + O_WT_UP) + (size_t)layer * 11008 * 2048; O = (bf16_t*)(p.ws + O_R2); N = DFF2; }
            EpiStoreBf16 em{O, N}, e{O + (size_t)16 * N, N};
            gemm_full(lds, hb, w, N, 2048, em, e);
        } break;
        case K_GOUT: case K_DOWN: {
            const bf16_t* w; int K;
            if (kind == K_DOWN) { w = (const bf16_t*)(p.ws + O_WT_DOWN) + (size_t)layer * 2048 * 5504; K = DFF; }
            else if ((layer & 1) == 0) { w = (const bf16_t*)(p.ws + O_WT_HOUT) + (size_t)jj * 2048 * 4096; K = 4096; }
            else { w = (const bf16_t*)(p.ws + O_WT_SOUT) + (size_t)jj * 2048 * 2048; K = 2048; }
            EpiResF32 em{h, hb}, e{h + (size_t)16 * DM, hb + (size_t)16 * DM};
            gemm_full(lds, mix, w, 2048, K, em, e);
        } break;
        case K_HPREP: phase_hyb_prep(p, jj, lds); break;
        case K_HLOCAL: phase_hyb_local(p, lds); break;
        case K_HSCAN: phase_hyb_scan(p); break;
        case K_HOUT: phase_hyb_out(p, jj, lds); break;
        case K_ATTN: phase_attn(p, jj, lds); break;
        case K_LN1: phase_ln(p, p.in(20) + (size_t)layer * DM, p.in(21) + (size_t)layer * DM, false); break;
        case K_LN2: phase_ln(p, p.in(22) + (size_t)layer * DM, p.in(23) + (size_t)layer * DM, layer == 3); break;
        case K_CONV: phase_ffn_conv(p, layer); break;
        default: break;
        }
        if (ph + 1 < pin.ph_hi) xcd_barrier(xb);
    }
}

extern "C" void kernel_launch(void* const* d_in, const int* in_sizes, int n_in, void* d_out, int out_size, void* d_ws, size_t ws_size, hipStream_t stream) {
    static int grid = 0;
    if (grid == 0) {
        if (n_in != 24 || ws_size < WS_END) { fprintf(stderr, "kernel_launch: unexpected inputs (n_in %d, ws %zu, need %zu)\n", n_in, ws_size, (size_t)WS_END); grid = -1; return; }
        int dev = 0, cus = 0, per_cu = 0;
        (void)hipGetDevice(&dev);
        (void)hipDeviceGetAttribute(&cus, hipDeviceAttributeMultiprocessorCount, dev);
        if (hipFuncSetAttribute((const void*)fwd_megakernel, hipFuncAttributeMaxDynamicSharedMemorySize, LDS_BYTES) != hipSuccess) { fprintf(stderr, "kernel_launch: hipFuncSetAttribute failed\n"); grid = -1; return; }
        if (hipOccupancyMaxActiveBlocksPerMultiprocessor(&per_cu, (const void*)fwd_megakernel, NTHREADS, LDS_BYTES) != hipSuccess || per_cu < 1) { fprintf(stderr, "kernel_launch: occupancy query gave %d\n", per_cu); per_cu = 1; }
        (void)hipGetLastError();
        grid = cus * per_cu;
        if (grid > 256) grid = 256;
        fprintf(stderr, "kernel_launch: grid %d (cus %d, per_cu %d), ws need %zu of %zu\n", grid, cus, per_cu, (size_t)WS_END, ws_size);
    }
    if (grid < 0) return;
    Params p{};
    for (int i = 0; i < 24; ++i) p.in[i] = (const float*)d_in[i];
    p.out = (float*)d_out; p.ws = (unsigned char*)d_ws;
    for (int i = 0; i < 8; ++i) p.inv_freq[i] = powf(500000.0f, -(float)i / 8.0f);
#if PER_PHASE_LAUNCH
    for (int ph = 0; ph < N_PHASES; ++ph) {
        p.ph_lo = ph; p.ph_hi = ph + 1;
        hipLaunchKernelGGL(fwd_megakernel, dim3(grid), dim3(NTHREADS), LDS_BYTES, stream, p);
        { int kind, layer; decode_phase(ph, kind, layer); if ((DUP_MASK >> kind) & 1) hipLaunchKernelGGL(fwd_megakernel, dim3(grid), dim3(NTHREADS), LDS_BYTES, stream, p); }
    }
#else
    p.ph_lo = 0; p.ph_hi = N_PHASES;
    if (hipMemsetAsync((unsigned char*)d_ws + O_BAR, 0, XCD_BAR_WORDS * 4, stream) != hipSuccess) fprintf(stderr, "kernel_launch: memset failed\n");
    void* args[] = {&p};
    hipError_t e = hipLaunchCooperativeKernel((const void*)fwd_megakernel, dim3(grid), dim3(NTHREADS), args, LDS_BYTES, stream);
    if (e != hipSuccess) fprintf(stderr, "cooperative launch failed: %s (grid %d)\n", hipGetErrorString(e), grid);
#endif
}
```

```cpp
#include <hip/hip_runtime.h>
#include <hip/hip_cooperative_groups.h>
#include <cstdio>
#include <cmath>
namespace cg = cooperative_groups;
#ifndef PER_PHASE_LAUNCH
#define PER_PHASE_LAUNCH 0
#endif
__device__ __forceinline__ int tidx() { int t = threadIdx.x; asm volatile("" : "+v"(t)); return t; }
__device__ __forceinline__ int bidx() { int b = blockIdx.x; asm volatile("" : "+s"(b)); return b; }
#ifndef DUP_MASK
#define DUP_MASK 0
#endif
namespace pg8 {
#define PG8_LAS __attribute__((address_space(3)))
typedef unsigned short bf16_t;
typedef short bf16x8 __attribute__((ext_vector_type(8)));
typedef float f32x4 __attribute__((ext_vector_type(4)));
typedef unsigned u32x4 __attribute__((ext_vector_type(4)));
constexpr int BM = 256, BK = 64, HALF = 128, HTB = HALF * BK * 2  , STAGE_BYTES = 8 * HTB, NXCD = 8, WGM = 8;

__host__ __device__ __forceinline__ int lds_byte(int r, int c) { const int st = (r >> 4) * 2 + (c >> 5), rr = r & 15, cc = c & 31, ob = rr * 64 + cc * 2; return st * 1024 + (ob ^ (((ob >> 9) & 1) << 5)); }
__host__ __device__ __forceinline__ void stage_rc(int b, int& R, int& C) { const int st = b / 1024, sb = b % 1024, swz = sb ^ (((sb >> 9) & 1) << 5); R = (st >> 1) * 16 + swz / 64; C = (st & 1) * 32 + (swz % 64) / 2; }
__host__ __device__ __forceinline__ int perm32(int rho) { const int n = rho >> 4, i = rho & 15; return 8 * (i >> 2) + 4 * n + (i & 3); }

struct Unit { int pm, pn; };
struct Gemm { const bf16_t* A; const bf16_t* Bt; int M, N, K; };

struct StaticOrder {
    int nM, nN, nwg, G, c;
    __host__ __device__ void init(int M, int N, int G_, int c_) { nM = M / BM; nN = N / BM; nwg = nM * nN; G = G_; c = c_; }
    __host__ __device__ bool next(int i, Unit& u) const {
        const long L = (long)i * G + c; if (L >= nwg) return false;
        int wgid = (int)L; { const int q = nwg / NXCD, r = nwg % NXCD, xcd = wgid % NXCD, off = wgid / NXCD; wgid = (xcd < r ? xcd * (q + 1) : r * (q + 1) + (xcd - r) * q) + off; }
        const int nig = WGM * nN, gid = wgid / nig, fm = gid * WGM, gsz = (nM - fm) < WGM ? (nM - fm) : WGM;
        u.pm = fm + ((wgid % nig) % gsz); u.pn = (wgid % nig) / gsz; return true;
    }
    __device__ __forceinline__ void a_ready(const Unit&) const {}
    __device__ __forceinline__ void done(const Unit&) const {}
};
__device__ __forceinline__ unsigned cvt_pk_bf16(float lo, float hi) { unsigned r; asm volatile("v_cvt_pk_bf16_f32 %0, %1, %2" : "=v"(r) : "v"(lo), "v"(hi)); return r; }
typedef float f32x2 __attribute__((ext_vector_type(2)));

template <class Epi, class Sched, bool STAMP = false>
__device__ __forceinline__ void gemm_phase(PG8_LAS unsigned char* lds, const Gemm g, const Sched& S, const Epi& E, unsigned long long* stamps) {
    const int tid = tidx(), wid = __builtin_amdgcn_readfirstlane(tid >> 6), lane = tid & 63, wr = wid >> 2, wc = wid & 3, fr = lane & 15, fq = lane >> 4;
    const int K = g.K, nt = K / BK;
    int ts_lo = 0, ts_hi = 0, nts = 0; const unsigned long long rt_entry = STAMP ? (unsigned long long)wall_clock64() : 0ull;
#define PG8_STAMP() do { if (STAMP && wid == 0 && nts < 64) { const unsigned long long _c = (unsigned long long)clock64(); \
        ts_lo = (lane == nts) ? (int)(unsigned)_c : ts_lo; ts_hi = (lane == nts) ? (int)(unsigned)(_c >> 32) : ts_hi; ++nts; } } while (0)
    PG8_STAMP();
    unsigned voffA[2], voffB[2];
#pragma unroll
    for (int i = 0; i < 2; ++i) { int R, C; stage_rc(tid * 16 + i * 8192, R, C); const int Rb = Epi::PERM ? ((R & ~31) + perm32(R & 31)) : R;
        voffA[i] = (unsigned)(R * K + C) * 2u; voffB[i] = (unsigned)(Rb * K + C) * 2u; }
    const size_t kstep = (size_t)(BK * 2);
    const size_t hstep = (size_t)HALF * K * 2;
    const size_t tstep = 2 * hstep;
    const unsigned ldsw = (unsigned)wid * 1024u;
    const int aoff = lds_byte(wr * 64 + fr, fq * 8), boff = lds_byte(wc * 32 + fr, fq * 8);
#define PG8_SA(b, h) (((b) * 2 + (h)) * HTB)
#define PG8_SB(b, h) ((4 + (b) * 2 + (h)) * HTB)
#define PG8_STAGE(bufoff, gbase, voff) do { _Pragma("unroll") for (int _i = 0; _i < 2; ++_i) \
        __builtin_amdgcn_global_load_lds((const unsigned*)((const char*)(gbase) + (voff)[_i]), (PG8_LAS unsigned*)(lds + (bufoff) + ldsw + _i * 8192), 16, 0, 0); } while (0)
#define PG8_LDA(dst, b, h) do { _Pragma("unroll") for (int m = 0; m < 4; ++m) _Pragma("unroll") for (int k = 0; k < 2; ++k) dst[m][k] = *(const PG8_LAS bf16x8*)(lds + PG8_SA(b, h) + aoff + m * 2048 + k * 1024); } while (0)
#define PG8_LDB(dst, b, h) do { _Pragma("unroll") for (int n = 0; n < 2; ++n) _Pragma("unroll") for (int k = 0; k < 2; ++k) dst[n][k] = *(const PG8_LAS bf16x8*)(lds + PG8_SB(b, h) + boff + n * 2048 + k * 1024); } while (0)
#define PG8_MMA(ai, bj, At, Bt) do { __builtin_amdgcn_s_setprio(1); _Pragma("unroll") for (int m = 0; m < 4; ++m) _Pragma("unroll") for (int n = 0; n < 2; ++n) _Pragma("unroll") for (int k = 0; k < 2; ++k) \
        acc[ai][bj][m][n] = __builtin_amdgcn_mfma_f32_16x16x32_bf16(Bt[n][k], At[m][k], acc[ai][bj][m][n], 0, 0, 0); __builtin_amdgcn_s_setprio(0); } while (0)
#define PG8_WAIT_V(n) asm volatile("s_waitcnt vmcnt(" #n ")" ::: "memory")
#define PG8_WAIT_L(n) asm volatile("s_waitcnt lgkmcnt(" #n ")" ::: "memory")
#define PG8_BAR __builtin_amdgcn_s_barrier()
#define PG8_SCHED __builtin_amdgcn_sched_barrier(0)
    Unit cur, nxt; int ui = 0;
    if (!S.next(0, cur)) return;
    f32x4 acc[2][2][4][2];
#pragma unroll
    for (int a = 0; a < 2; ++a)
#pragma unroll
        for (int b = 0; b < 2; ++b)
#pragma unroll
            for (int m = 0; m < 4; ++m)
#pragma unroll
                for (int n = 0; n < 2; ++n) acc[a][b][m][n] = (f32x4){0.f, 0.f, 0.f, 0.f};
    bf16x8 At[4][2], B0[2][2], B1[2][2];
    const char* cA = (const char*)g.A + (size_t)cur.pm * tstep; const char* cB = (const char*)g.Bt + (size_t)cur.pn * tstep;
    S.a_ready(cur);
    PG8_STAGE(PG8_SB(0, 0), cB, voffB); PG8_STAGE(PG8_SA(0, 0), cA, voffA); PG8_STAGE(PG8_SB(0, 1), cB + hstep, voffB); PG8_STAGE(PG8_SA(0, 1), cA + hstep, voffA);
    if (wr == 1) PG8_BAR;
    PG8_WAIT_V(4); PG8_BAR;
    PG8_STAGE(PG8_SB(1, 0), cB + kstep, voffB); PG8_STAGE(PG8_SA(1, 0), cA + kstep, voffA); PG8_STAGE(PG8_SB(1, 1), cB + hstep + kstep, voffB);
    PG8_WAIT_V(6); PG8_BAR;
    PG8_STAMP();
    for (;;) {
        const bool has_next = S.next(ui + 1, nxt);
        const char* nA = has_next ? (const char*)g.A + (size_t)nxt.pm * tstep : cA; const char* nB = has_next ? (const char*)g.Bt + (size_t)nxt.pn * tstep : cB;
        for (int t = 0; t < nt; t += 2) {
            const bool last = (t == nt - 2);
            const char* a1 = cA + (size_t)(t + 1) * kstep;
            const char* a2 = last ? nA : cA + (size_t)(t + 2) * kstep; const char* b2 = last ? nB : cB + (size_t)(t + 2) * kstep;
            const char* a3 = a2 + kstep; const char* b3 = b2 + kstep;
            if (last && has_next) S.a_ready(nxt);
            PG8_LDB(B0, 0, 0); PG8_SCHED; PG8_LDA(At, 0, 0); PG8_STAGE(PG8_SA(1, 1), a1 + hstep, voffA);
            PG8_WAIT_L(8); PG8_BAR; PG8_WAIT_L(0); PG8_MMA(0, 0, At, B0); PG8_BAR; PG8_SCHED;
            PG8_LDB(B1, 0, 1); PG8_STAGE(PG8_SB(0, 0), b2, voffB);
            PG8_BAR; PG8_WAIT_L(0); PG8_MMA(0, 1, At, B1); PG8_BAR;
            PG8_LDA(At, 0, 1); PG8_STAGE(PG8_SA(0, 0), a2, voffA);
            PG8_BAR; PG8_WAIT_L(0); PG8_MMA(1, 0, At, B0); PG8_BAR; PG8_SCHED;
            PG8_STAGE(PG8_SB(0, 1), b2 + hstep, voffB);
            PG8_WAIT_V(6); PG8_BAR; PG8_MMA(1, 1, At, B1); PG8_BAR;
            PG8_LDB(B0, 1, 0); PG8_SCHED; PG8_LDA(At, 1, 0); PG8_STAGE(PG8_SA(0, 1), a2 + hstep, voffA);
            PG8_WAIT_L(8); PG8_BAR; PG8_WAIT_L(0); PG8_MMA(0, 0, At, B0); PG8_BAR; PG8_SCHED;
            PG8_LDB(B1, 1, 1); PG8_STAGE(PG8_SB(1, 0), b3, voffB);
            PG8_BAR; PG8_WAIT_L(0); PG8_MMA(0, 1, At, B1); PG8_BAR;
            PG8_LDA(At, 1, 1); PG8_STAGE(PG8_SA(1, 0), a3, voffA);
            PG8_BAR; PG8_WAIT_L(0); PG8_MMA(1, 0, At, B0); PG8_BAR; PG8_SCHED;
            PG8_STAGE(PG8_SB(1, 1), b3 + hstep, voffB);
            PG8_WAIT_V(6); PG8_BAR; PG8_MMA(1, 1, At, B1); PG8_BAR;
        }
        PG8_STAMP();
        if constexpr (!Epi::AFTER_DRAIN) { E(acc, cur, wr, wc, fr, fq); S.done(cur); }
        PG8_STAMP();
        if (!has_next) break;
#pragma unroll
        for (int a = 0; a < 2; ++a)
#pragma unroll
            for (int b = 0; b < 2; ++b)
#pragma unroll
                for (int m = 0; m < 4; ++m)
#pragma unroll
                    for (int n = 0; n < 2; ++n) acc[a][b][m][n] = (f32x4){0.f, 0.f, 0.f, 0.f};
        cur = nxt; cA = nA; cB = nB; ++ui;
    }
    PG8_WAIT_V(0);
    if (wr == 0) PG8_BAR;
    PG8_BAR;
    if constexpr (Epi::AFTER_DRAIN) { E.fused(acc, cur, wr, wc, fr, fq, lds, wid, lane); S.done(cur); }
    PG8_STAMP();
    if (STAMP && wid == 0) { stamps[lane] = lane < nts ? (((unsigned long long)(unsigned)ts_hi << 32) | (unsigned)ts_lo) : 0ull;
        if (lane == 62) stamps[62] = rt_entry; if (lane == 63) stamps[63] = (unsigned long long)wall_clock64(); }
#undef PG8_STAMP
#undef PG8_SA
#undef PG8_SB
#undef PG8_STAGE
#undef PG8_LDA
#undef PG8_LDB
#undef PG8_MMA
#undef PG8_WAIT_V
#undef PG8_WAIT_L
#undef PG8_BAR
#undef PG8_SCHED
}
}
using pg8::bf16_t; using pg8::bf16x8; using pg8::f32x4; using pg8::u32x4;
#define LAS __attribute__((address_space(3)))
typedef unsigned u32x2 __attribute__((ext_vector_type(2)));

constexpr int L_TOK = 8208, DM = 2048;
constexpr int HYB_N = 12288, DFF = 5504, DFF2 = 11008, QKV_N = 3072;
constexpr int UZ = 0, UXBC = 2048, UQ = 6144, UK = 7168, UV = 8192, UR = 10240;
constexpr float ALPHA = 1.6817928305074292f;
constexpr int NTHREADS = 512;
constexpr int LDS_MAIN = 143360;
constexpr int LDS_BYTES = LDS_MAIN + 256;

constexpr size_t al256(size_t x) { return (x + 255) & ~(size_t)255; }
constexpr size_t O_WT_HIN   = 0;
constexpr size_t O_WT_HSIDE = O_WT_HIN   + al256(2ull * 12288 * 2048 * 2);
constexpr size_t O_WT_HOUT  = O_WT_HSIDE + al256(2ull * 48 * 2048 * 2);
constexpr size_t O_WT_QKV   = O_WT_HOUT  + al256(2ull * 2048 * 4096 * 2);
constexpr size_t O_WT_SOUT  = O_WT_QKV   + al256(2ull * 3072 * 2048 * 2);
constexpr size_t O_WT_UP    = O_WT_SOUT  + al256(2ull * 2048 * 2048 * 2);
constexpr size_t O_WT_DOWN  = O_WT_UP    + al256(4ull * 11008 * 2048 * 2);
constexpr size_t O_H        = O_WT_DOWN  + al256(4ull * 2048 * 5504 * 2);
constexpr size_t O_HB       = O_H        + al256((size_t)L_TOK * 2048 * 4);
constexpr size_t O_U        = O_HB       + al256((size_t)L_TOK * 2048 * 2);
constexpr size_t O_R2       = O_U        + al256((size_t)L_TOK * 12288 * 2);
constexpr size_t GLA_ST_BYTES = 129ull * 4 * 512 * 256 * 2;
constexpr size_t O_MIX      = O_R2       + al256(2 * GLA_ST_BYTES);
constexpr size_t O_XC       = O_MIX      + al256((size_t)L_TOK * 5504 * 2);
constexpr size_t O_SIDE     = O_XC       + al256((size_t)L_TOK * 4096 * 2);
constexpr size_t O_DT       = O_SIDE     + al256((size_t)L_TOK * 64 * 4);
constexpr size_t O_ACS      = O_DT       + al256((size_t)L_TOK * 32 * 4);
constexpr size_t O_QT       = O_ACS      + al256((size_t)L_TOK * 32 * 4);
constexpr size_t O_KT       = O_QT       + al256((size_t)L_TOK * 1024 * 2);
constexpr size_t O_GLAST    = O_KT       + al256((size_t)L_TOK * 1024 * 2);
constexpr size_t O_CDEC     = O_GLAST    + al256(129ull * 1024 * 4);
constexpr size_t O_SSDLOC   = O_CDEC     + al256(65ull * 32 * 4);
constexpr size_t O_SSDPREV  = O_SSDLOC   + al256(65ull * 32 * 64 * 128 * 4);
constexpr size_t O_ROPE     = O_SSDPREV  + al256(65ull * 32 * 64 * 128 * 2);
constexpr size_t O_TAB      = O_ROPE     + al256((size_t)L_TOK * 16 * 4);
constexpr size_t O_BAR      = O_TAB      + 256;
constexpr size_t WS_END     = O_BAR      + al256(4096 * 4);
static_assert(WS_END <= 1442840576ull, "workspace too large");

struct Params {
    const float* in[24];
    float* out;
    unsigned char* ws;
    float inv_freq[8];
    int ph_lo, ph_hi;
};

struct Ctx { unsigned char* ws; float* out;
    __device__ __forceinline__ const float* in(int k) const { const size_t a = ((const size_t*)(ws + O_TAB))[k]; return (const float*)(const __attribute__((address_space(1))) float*)a; } };

__device__ __forceinline__ bf16_t f2bf(float f) { unsigned u = __float_as_uint(f); u += 0x7FFFu + ((u >> 16) & 1u); return (bf16_t)(u >> 16); }
__device__ __forceinline__ float bf2f(bf16_t b) { return __uint_as_float(((unsigned)b) << 16); }
__device__ __forceinline__ unsigned pack2(float lo, float hi) { unsigned r; asm("v_cvt_pk_bf16_f32 %0, %1, %2" : "=v"(r) : "v"(lo), "v"(hi)); return r; }
__device__ __forceinline__ float bflo(unsigned w) { return __uint_as_float(w << 16); }
__device__ __forceinline__ float bfhi(unsigned w) { return __uint_as_float(w & 0xffff0000u); }
__device__ __forceinline__ float silu_f(float x) { return x * __builtin_amdgcn_rcpf(1.f + __expf(-x)); }
__device__ __forceinline__ float wave_sum(float v) {
#pragma unroll
    for (int o = 32; o > 0; o >>= 1) v += __shfl_xor(v, o);
    return v;
}
__device__ __forceinline__ bf16x8 ldfrag(const LAS bf16_t* base, int ld, int row0, int k0, int lane) {
    return *(const LAS bf16x8*)(base + (row0 + (lane & 15)) * ld + k0 + 8 * (lane >> 4));
}
__device__ __forceinline__ bf16x8 gfrag(const bf16_t* base, size_t ld, int row0, int k0, int lane) {
    return *(const bf16x8*)(base + (size_t)(row0 + (lane & 15)) * ld + k0 + 8 * (lane >> 4));
}
typedef short s16x4 __attribute__((ext_vector_type(4)));
__device__ __forceinline__ bf16x8 ldfrag_tr(const LAS bf16_t* base, int ld, int n0, int k0, int lane) {
    const int g = lane >> 4, i = lane & 15, q = i >> 2, pp = i & 3;
    const LAS bf16_t* a = base + (k0 + 8 * g + q) * ld + n0 + 4 * pp;
    const s16x4 r1 = __builtin_amdgcn_ds_read_tr16_b64_v4i16((LAS s16x4*)a);
    const s16x4 r2 = __builtin_amdgcn_ds_read_tr16_b64_v4i16((LAS s16x4*)(a + 4 * ld));
    return __builtin_shufflevector(r1, r2, 0, 1, 2, 3, 4, 5, 6, 7);
}
#define MFMA16(a, b, c) __builtin_amdgcn_mfma_f32_16x16x32_bf16((a), (b), (c), 0, 0, 0)
#define LDS_FENCE() asm volatile("s_waitcnt lgkmcnt(0)" ::: "memory")

struct EpiStoreBf16 {
    static constexpr bool PERM = true, AFTER_DRAIN = false;
    bf16_t* O; int ldc;
    __device__ __forceinline__ void operator()(const f32x4 (&acc)[2][2][4][2], const pg8::Unit& u, int wr, int wc, int fr, int fq) const {
        const int row0 = u.pm * 256 + wr * 64 + fr, col0 = u.pn * 256 + wc * 32 + 8 * fq;
#pragma unroll
        for (int ai = 0; ai < 2; ++ai)
#pragma unroll
            for (int m = 0; m < 4; ++m) { bf16_t* rowp = O + (size_t)(row0 + ai * 128 + m * 16) * ldc + col0;
#pragma unroll
                for (int bj = 0; bj < 2; ++bj) { const f32x4 v0 = acc[ai][bj][m][0], v1 = acc[ai][bj][m][1];
                    u32x4 w; w.x = pg8::cvt_pk_bf16(v0[0], v0[1]); w.y = pg8::cvt_pk_bf16(v0[2], v0[3]); w.z = pg8::cvt_pk_bf16(v1[0], v1[1]); w.w = pg8::cvt_pk_bf16(v1[2], v1[3]);
                    *(u32x4*)(rowp + bj * 128) = w; } }
    }
    __device__ __forceinline__ void meta(int row, int col, f32x4 v) const {
        u32x2 w; w.x = pg8::cvt_pk_bf16(v[0], v[1]); w.y = pg8::cvt_pk_bf16(v[2], v[3]);
        *(u32x2*)(O + (size_t)row * ldc + col) = w;
    }
};
struct EpiResF32 {
    static constexpr bool PERM = false, AFTER_DRAIN = false;
    float* H; const bf16_t* HB;
    __device__ __forceinline__ void operator()(const f32x4 (&acc)[2][2][4][2], const pg8::Unit& u, int wr, int wc, int fr, int fq) const {
        const int row0 = u.pm * 256 + wr * 64 + fr, col0 = u.pn * 256 + wc * 32 + 4 * fq;
#pragma unroll
        for (int ai = 0; ai < 2; ++ai)
#pragma unroll
            for (int m = 0; m < 4; ++m) { const size_t ro = (size_t)(row0 + ai * 128 + m * 16) * DM + col0;
#pragma unroll
                for (int bj = 0; bj < 2; ++bj)
#pragma unroll
                    for (int n = 0; n < 2; ++n) { const size_t o = ro + bj * 128 + n * 16; const u32x2 hw = *(const u32x2*)(HB + o);
                        const f32x4 hv = {bflo(hw.x), bfhi(hw.x), bflo(hw.y), bfhi(hw.y)}; *(f32x4*)(H + o) = hv * ALPHA + acc[ai][bj][m][n]; } }
    }
    __device__ __forceinline__ void meta(int row, int col, f32x4 v) const {
        const size_t o = (size_t)row * DM + col; const u32x2 hw = *(const u32x2*)(HB + o);
        const f32x4 hv = {bflo(hw.x), bfhi(hw.x), bflo(hw.y), bfhi(hw.y)}; *(f32x4*)(H + o) = hv * ALPHA + v;
    }
};
__device__ __forceinline__ f32x4 wave_gemm16(const bf16_t* A, const bf16_t* Bt, int K, int lane) {
    f32x4 acc = {0.f, 0.f, 0.f, 0.f};
    const bf16_t* pa = A + (size_t)(lane & 15) * K + 8 * (lane >> 4);
    const bf16_t* pb = Bt + (size_t)(lane & 15) * K + 8 * (lane >> 4);
#pragma unroll 16
    for (int k0 = 0; k0 < K; k0 += 32) {
        const bf16x8 a = *(const bf16x8*)(pa + k0), b = *(const bf16x8*)(pb + k0);
        acc = MFMA16(b, a, acc);
    }
    return acc;
}
template <class Epi>
__device__ __forceinline__ void gemm_full(LAS unsigned char* lds, const bf16_t* A, const bf16_t* Bt, int N, int K, const Epi& Emeta, const Epi& Emain) {
    const int lane = tidx() & 63, wid = tidx() >> 6;
    if (N == 2048) {
        if (bidx() < 64) {
            LAS f32x4* red = (LAS f32x4*)lds;
            const int ksteps = K / 32, per = (ksteps + 7) / 8, k_lo = wid * per, k_hi = (k_lo + per < ksteps ? k_lo + per : ksteps);
#pragma unroll
            for (int t = 0; t < 2; ++t) {
                const int tile = bidx() * 2 + t;
                f32x4 acc = {0.f, 0.f, 0.f, 0.f};
                const bf16_t* pa = A + (size_t)(lane & 15) * K + 8 * (lane >> 4);
                const bf16_t* pb = Bt + (size_t)(tile * 16 + (lane & 15)) * K + 8 * (lane >> 4);
#pragma unroll 8
                for (int ks = k_lo; ks < k_hi; ++ks) acc = MFMA16(*(const bf16x8*)(pb + ks * 32), *(const bf16x8*)(pa + ks * 32), acc);
                red[(t * 8 + wid) * 64 + lane] = acc;
            }
            __syncthreads();
            if (wid < 2) {
                f32x4 s = red[(wid * 8) * 64 + lane];
#pragma unroll
                for (int w = 1; w < 8; ++w) s += red[(wid * 8 + w) * 64 + lane];
                Emeta.meta(lane & 15, (bidx() * 2 + wid) * 16 + 4 * (lane >> 4), s);
            }
            __syncthreads();
        }
    } else {
        for (int tile = ((int)gridDim.x - 1 - bidx()) * 8 + wid; tile < N / 16; tile += gridDim.x * 8) {
            const f32x4 acc = wave_gemm16(A, Bt + (size_t)tile * 16 * K, K, lane);
            Emeta.meta(lane & 15, tile * 16 + 4 * (lane >> 4), acc);
        }
    }
    pg8::Gemm g{A + (size_t)16 * K, Bt, 8192, N, K};
    pg8::StaticOrder S; S.init(8192, N, (int)gridDim.x, (int)bidx());
    pg8::gemm_phase<Epi, pg8::StaticOrder, false>(lds, g, S, Emain, nullptr);
    __syncthreads();
}
#define XB_TMO      128
#define XB_XCNT(j)  (256  + 64 * (j))
#define XB_XSUB(j)  (1280 + 64 * (j))
#define XB_XGEN(j)  (2304 + 64 * (j))
#define XB_TOP      3328
#define XB_TOPGEN   3392
#define XCD_BAR_WORDS 3456
#define XB_SPIN_CAP (1u << 18)

__device__ __forceinline__ unsigned xb_ld(unsigned* p)              { return __hip_atomic_load(p, __ATOMIC_RELAXED, __HIP_MEMORY_SCOPE_AGENT); }
__device__ __forceinline__ unsigned xb_add(unsigned* p, unsigned v) { return __hip_atomic_fetch_add(p, v, __ATOMIC_RELAXED, __HIP_MEMORY_SCOPE_AGENT); }
__device__ __forceinline__ unsigned xb_xcc_id() { return (unsigned)__builtin_amdgcn_s_getreg((3 << 11) | 20) & 0xFu; }
#define XB_SPIN(cond, bar) do { unsigned _sp = 0; while (cond) { __builtin_amdgcn_s_sleep(1); \
    if ((++_sp & 255u) == 0u) { if (xb_ld(&(bar)[XB_TMO])) break; if (_sp > XB_SPIN_CAP) { atomicAdd(&(bar)[XB_TMO], 1u); break; } } } } while (0)

struct XcdBarrier {
    unsigned* bar; unsigned x;
    volatile LAS unsigned* st;
};

__device__ __forceinline__ XcdBarrier xcd_barrier_post(unsigned* bar, volatile LAS unsigned* st) {
    XcdBarrier b; b.bar = bar; b.x = xb_xcc_id(); b.st = st;
    if (threadIdx.x == 0) (void)xb_add(&bar[XB_XCNT(b.x)], 1u);
    return b;
}
__device__ __forceinline__ void xcd_barrier_complete(unsigned* bar, unsigned x, unsigned& nloc, unsigned& nx) {
    const unsigned G = gridDim.x * gridDim.y * gridDim.z;
    unsigned sum, cnt, mine, sp = 0u;
    for (;;) {
        sum = 0u; cnt = 0u; mine = 0u;
#pragma unroll
        for (unsigned j = 0; j < 16; ++j) { const unsigned c = xb_ld(&bar[XB_XCNT(j)]); sum += c; cnt += (c > 0u) ? 1u : 0u; mine = (j == x) ? c : mine; }
        if (sum == G) break;
        __builtin_amdgcn_s_sleep(1);
        if ((++sp & 255u) == 0u) { if (xb_ld(&bar[XB_TMO])) break; if (sp > XB_SPIN_CAP) { atomicAdd(&bar[XB_TMO], 1u); break; } }
    }
    nloc = mine > 0u ? mine : 1u; nx = cnt > 0u ? cnt : 1u;
}

__device__ __forceinline__ void xcd_barrier(const XcdBarrier& b) {
    asm volatile("s_waitcnt vmcnt(0)" ::: "memory");
    __syncthreads();
    if (threadIdx.x == 0) {
        unsigned* bar = b.bar;
        __builtin_amdgcn_s_waitcnt(0);
        unsigned nloc = b.st[0], nx = b.st[1];
        if (nloc == 0u) { xcd_barrier_complete(bar, b.x, nloc, nx); b.st[0] = nloc; b.st[1] = nx; }
        const unsigned old = xb_add(&bar[XB_XSUB(b.x)], 1u);
        const unsigned gen = old / nloc;
        if (old + 1u == (gen + 1u) * nloc) {
            __builtin_amdgcn_fence(__ATOMIC_RELEASE, "agent");
            asm volatile("s_waitcnt vmcnt(0)" ::: "memory");
            const unsigned og = xb_add(&bar[XB_TOP], 1u);
            const unsigned tg = og / nx;
            if (og + 1u == (tg + 1u) * nx) xb_add(&bar[XB_TOPGEN], 1u);
            else XB_SPIN(xb_ld(&bar[XB_TOPGEN]) == tg, bar);
            __builtin_amdgcn_fence(__ATOMIC_ACQUIRE, "agent");
            xb_add(&bar[XB_XGEN(b.x)], 1u);
            asm volatile("s_waitcnt vmcnt(0)" ::: "memory");
        } else {
            XB_SPIN(xb_ld(&bar[XB_XGEN(b.x)]) == gen, bar);
            __builtin_amdgcn_fence(__ATOMIC_ACQUIRE, "agent");
            asm volatile("s_waitcnt vmcnt(0)" ::: "memory");
        }
    }
    __syncthreads();
}
struct TJob { const float* src; int ld, ncols, K; bf16_t* dst; };
__device__ __forceinline__ TJob get_job(const Params& p, int j) {
    TJob J;
    bf16_t* ws16 = (bf16_t*)p.ws;
    if (j < 10) {
        const int jj = j / 5, sub = j % 5;
        const float* base = p.in[2] + (size_t)jj * 2048 * 12336;
        bf16_t* wmain = (bf16_t*)(p.ws + O_WT_HIN) + (size_t)jj * 12288 * 2048;
        bf16_t* wside = (bf16_t*)(p.ws + O_WT_HSIDE) + (size_t)jj * 48 * 2048;
        J.ld = 12336; J.K = 2048;
        if (sub == 0)      { J.src = base;          J.ncols = 6144; J.dst = wmain; }
        else if (sub == 1) { J.src = base + 6176;   J.ncols = 4096; J.dst = wmain + (size_t)6144 * 2048; }
        else if (sub == 2) { J.src = base + 10288;  J.ncols = 2048; J.dst = wmain + (size_t)10240 * 2048; }
        else if (sub == 3) { J.src = base + 6144;   J.ncols = 32;   J.dst = wside; }
        else               { J.src = base + 10272;  J.ncols = 16;   J.dst = wside + (size_t)32 * 2048; }
    } else if (j < 12) { const int jj = j - 10; J.src = p.in[12] + (size_t)jj * 4096 * 2048; J.ld = 2048; J.ncols = 2048; J.K = 4096; J.dst = (bf16_t*)(p.ws + O_WT_HOUT) + (size_t)jj * 2048 * 4096; }
    else if (j < 14) { const int jj = j - 12; J.src = p.in[13] + (size_t)jj * 2048 * 3072; J.ld = 3072; J.ncols = 3072; J.K = 2048; J.dst = (bf16_t*)(p.ws + O_WT_QKV) + (size_t)jj * 3072 * 2048; }
    else if (j < 16) { const int jj = j - 14; J.src = p.in[15] + (size_t)jj * 2048 * 2048; J.ld = 2048; J.ncols = 2048; J.K = 2048; J.dst = (bf16_t*)(p.ws + O_WT_SOUT) + (size_t)jj * 2048 * 2048; }
    else if (j < 20) { const int l = j - 16; J.src = p.in[16] + (size_t)l * 2048 * 11008; J.ld = 11008; J.ncols = 11008; J.K = 2048; J.dst = (bf16_t*)(p.ws + O_WT_UP) + (size_t)l * 11008 * 2048; }
    else { const int l = j - 20; J.src = p.in[19] + (size_t)l * 5504 * 2048; J.ld = 2048; J.ncols = 2048; J.K = 5504; J.dst = (bf16_t*)(p.ws + O_WT_DOWN) + (size_t)l * 2048 * 5504; }
    (void)ws16;
    return J;
}
__device__ __forceinline__ void phase_prep(const Params& p, LAS unsigned char* lds) {
    const int tid = tidx();
    LAS float* ts = (LAS float*)lds;
    for (int j = 0; j < 24; ++j) {
        const TJob J = get_job(p, j);
        const int tn = (J.ncols + 127) / 128, tk = J.K / 128;
        for (int tile = bidx(); tile < tn * tk; tile += gridDim.x) {
            const int kb = tile / tn, nb = tile % tn;
            __syncthreads();
            {
                const int c4 = (tid & 31) * 4, n = nb * 128 + c4, r0 = tid >> 5;
                if (n < J.ncols) {
                    float4 v[8];
#pragma unroll
                    for (int i = 0; i < 8; ++i) v[i] = *(const float4*)(J.src + (size_t)(kb * 128 + r0 + 16 * i) * J.ld + n);
#pragma unroll
                    for (int i = 0; i < 8; ++i) { const int r = r0 + 16 * i; ts[r * 129 + c4] = v[i].x; ts[r * 129 + c4 + 1] = v[i].y; ts[r * 129 + c4 + 2] = v[i].z; ts[r * 129 + c4 + 3] = v[i].w; }
                }
            }
            __syncthreads();
            const int n = tid >> 2, kc = tid & 3;
            if (nb * 128 + n < J.ncols) {
#pragma unroll
                for (int q = 0; q < 4; ++q) {
                    const int kk = kc * 32 + q * 8;
                    u32x4 w;
                    w.x = pack2(ts[(kk + 0) * 129 + n], ts[(kk + 1) * 129 + n]);
                    w.y = pack2(ts[(kk + 2) * 129 + n], ts[(kk + 3) * 129 + n]);
                    w.z = pack2(ts[(kk + 4) * 129 + n], ts[(kk + 5) * 129 + n]);
                    w.w = pack2(ts[(kk + 6) * 129 + n], ts[(kk + 7) * 129 + n]);
                    *(u32x4*)(J.dst + (size_t)(nb * 128 + n) * J.K + kb * 128 + kk) = w;
                }
            }
        }
    }
    __syncthreads();
    const size_t gtid = (size_t)bidx() * NTHREADS + tid, gn = (size_t)gridDim.x * NTHREADS;
    float* h = (float*)(p.ws + O_H); bf16_t* hb = (bf16_t*)(p.ws + O_HB);
    for (size_t i = gtid; i < (size_t)L_TOK * 512; i += gn) {
        const int row = (int)(i >> 9), c4 = (int)(i & 511) * 4;
        const float4 v = row < 16 ? *(const float4*)(p.in[1] + (size_t)row * DM + c4) : *(const float4*)(p.in[0] + (size_t)(row - 16) * DM + c4);
        u32x2 w; w.x = pack2(v.x, v.y); w.y = pack2(v.z, v.w);
        *(u32x2*)(hb + i * 4) = w;
    }
    if (gtid < 24) ((const float**)(p.ws + O_TAB))[gtid] = p.in[gtid];
    float* rope = (float*)(p.ws + O_ROPE);
    for (size_t i = gtid; i < (size_t)L_TOK * 8; i += gn) {
        const int pos = (int)(i >> 3), f = (int)(i & 7);
        const float ang = (float)pos * p.inv_freq[f];
        double rev = (double)ang * 0.15915494309189535;
        rev -= rint(rev);
        rope[pos * 16 + f] = __builtin_amdgcn_cosf((float)rev);
        rope[pos * 16 + 8 + f] = __builtin_amdgcn_sinf((float)rev);
    }
}

__device__ __forceinline__ void phase_ln(const Ctx& p, const float* g, const float* b, bool last) {
    const int lane = tidx() & 63, wid = tidx() >> 6;
    float* h = (float*)(p.ws + O_H); bf16_t* hb = (bf16_t*)(p.ws + O_HB);
    for (int row = bidx() * 8 + wid; row < L_TOK; row += gridDim.x * 8) {
        float4 v[8]; float s = 0.f;
#pragma unroll
        for (int i = 0; i < 8; ++i) { v[i] = *(const float4*)(h + (size_t)row * DM + i * 256 + lane * 4); s += v[i].x + v[i].y + v[i].z + v[i].w; }
        const float mean = wave_sum(s) * (1.f / 2048.f);
        float q = 0.f;
#pragma unroll
        for (int i = 0; i < 8; ++i) { v[i].x -= mean; v[i].y -= mean; v[i].z -= mean; v[i].w -= mean; q += v[i].x * v[i].x + v[i].y * v[i].y + v[i].z * v[i].z + v[i].w * v[i].w; }
        const float rstd = rsqrtf(wave_sum(q) * (1.f / 2048.f) + 1e-5f);
#pragma unroll
        for (int i = 0; i < 8; ++i) {
            const int c = i * 256 + lane * 4;
            const float4 gg = *(const float4*)(g + c), bb = *(const float4*)(b + c);
            float4 y; y.x = v[i].x * rstd * gg.x + bb.x; y.y = v[i].y * rstd * gg.y + bb.y; y.z = v[i].z * rstd * gg.z + bb.z; y.w = v[i].w * rstd * gg.w + bb.w;
            if (last) { if (row >= 16) *(float4*)(p.out + (size_t)(row - 16) * DM + c) = y; }
            else { u32x2 w; w.x = pack2(y.x, y.y); w.y = pack2(y.z, y.w); *(u32x2*)(hb + (size_t)row * DM + c) = w; }
        }
    }
}

__device__ __forceinline__ void unpack8(const u32x4 w, float (&f)[8]) {
    f[0] = bflo(w.x); f[1] = bfhi(w.x); f[2] = bflo(w.y); f[3] = bfhi(w.y); f[4] = bflo(w.z); f[5] = bfhi(w.z); f[6] = bflo(w.w); f[7] = bfhi(w.w);
}
__device__ __forceinline__ void ld8f(const float* q, float (&f)[8]) {
    const float4 a = *(const float4*)q, b = *(const float4*)(q + 4);
    f[0] = a.x; f[1] = a.y; f[2] = a.z; f[3] = a.w; f[4] = b.x; f[5] = b.y; f[6] = b.z; f[7] = b.w;
}
__device__ __forceinline__ void phase_ffn_conv(const Ctx& p, int layer) {
    const bf16_t* up = (const bf16_t*)(p.ws + O_R2); bf16_t* act = (bf16_t*)(p.ws + O_MIX);
    const float* cw = p.in(17) + (size_t)layer * 3 * DFF2; const float* cb = p.in(18) + (size_t)layer * DFF2;
    const size_t gtid = (size_t)bidx() * NTHREADS + tidx(), gn = (size_t)gridDim.x * NTHREADS;
    const int nlanes = (int)(gn / 688);
    if (gtid >= (size_t)nlanes * 688) return;
    const int jb = (int)(gtid % 688), j0 = jb * 8;
    float wg[3][8], wv[3][8], bg[8], bv[8];
#pragma unroll
    for (int k = 0; k < 3; ++k) { ld8f(cw + (size_t)k * DFF2 + j0, wg[k]); ld8f(cw + (size_t)k * DFF2 + DFF + j0, wv[k]); }
    ld8f(cb + j0, bg); ld8f(cb + DFF + j0, bv);
    for (int tb = (int)(gtid / 688); tb < 1026; tb += nlanes) {
        const int t0 = tb * 8;
        u32x4 gr[10], vr[10];
#pragma unroll
        for (int r = 0; r < 10; ++r) {
            const int t = t0 - 2 + r;
            gr[r] = (u32x4){0u, 0u, 0u, 0u}; vr[r] = (u32x4){0u, 0u, 0u, 0u};
            if (t >= 0) { gr[r] = *(const u32x4*)(up + (size_t)t * DFF2 + j0); vr[r] = *(const u32x4*)(up + (size_t)t * DFF2 + DFF + j0); }
        }
        float g2[8], g1[8], v2[8], v1[8];
        unpack8(gr[0], g2); unpack8(vr[0], v2); unpack8(gr[1], g1); unpack8(vr[1], v1);
#pragma unroll
        for (int tt = 0; tt < 8; ++tt) {
            const int t = t0 + tt;
            float g0[8], v0[8], o[8];
            unpack8(gr[tt + 2], g0); unpack8(vr[tt + 2], v0);
#pragma unroll
            for (int i = 0; i < 8; ++i) {
                const float gg = bg[i] + wg[0][i] * g2[i] + wg[1][i] * g1[i] + wg[2][i] * g0[i];
                const float vv = bv[i] + wv[0][i] * v2[i] + wv[1][i] * v1[i] + wv[2][i] * v0[i];
                o[i] = silu_f(gg) * vv;
                g2[i] = g1[i]; g1[i] = g0[i]; v2[i] = v1[i]; v1[i] = v0[i];
            }
            u32x4 w; w.x = pack2(o[0], o[1]); w.y = pack2(o[2], o[3]); w.z = pack2(o[4], o[5]); w.w = pack2(o[6], o[7]);
            *(u32x4*)(act + (size_t)t * DFF + j0) = w;
        }
    }
}
__device__ __forceinline__ void phase_hyb_prep(const Ctx& p, int jj, LAS unsigned char* lds) {
    const bf16_t* u = (const bf16_t*)(p.ws + O_U);
    const float* side = (const float*)(p.ws + O_SIDE);
    const int tid = tidx(), lane = tid & 63, wid = tid >> 6;
    const size_t gtid = (size_t)bidx() * NTHREADS + tid, gn = (size_t)gridDim.x * NTHREADS;
    {
        bf16_t* xc = (bf16_t*)(p.ws + O_XC);
        const float* cw = p.in(3) + (size_t)jj * 4 * 4096; const float* cb = p.in(4) + (size_t)jj * 4096;
        for (size_t task = gtid; task < (size_t)1026 * 512; task += gn) {
            const int cbk = (int)(task & 511), tb = (int)(task >> 9), c0 = cbk * 8, t0 = tb * 8;
            float w[4][8], bb[8], x3[8], x2[8], x1[8];
#pragma unroll
            for (int k = 0; k < 4; ++k) ld8f(cw + (size_t)k * 4096 + c0, w[k]);
            ld8f(cb + c0, bb);
            u32x4 xr[11];
#pragma unroll
            for (int r = 0; r < 11; ++r) { const int t = t0 - 3 + r; xr[r] = (u32x4){0u, 0u, 0u, 0u}; if (t >= 0) xr[r] = *(const u32x4*)(u + (size_t)t * HYB_N + UXBC + c0); }
            unpack8(xr[0], x3); unpack8(xr[1], x2); unpack8(xr[2], x1);
#pragma unroll
            for (int tt = 0; tt < 8; ++tt) {
                const int t = t0 + tt;
                float x0[8], o[8];
                unpack8(xr[tt + 3], x0);
#pragma unroll
                for (int i = 0; i < 8; ++i) {
                    const float y = bb[i] + w[0][i] * x3[i] + w[1][i] * x2[i] + w[2][i] * x1[i] + w[3][i] * x0[i];
                    o[i] = silu_f(y);
                    x3[i] = x2[i]; x2[i] = x1[i]; x1[i] = x0[i];
                }
                u32x4 ww; ww.x = pack2(o[0], o[1]); ww.y = pack2(o[2], o[3]); ww.z = pack2(o[4], o[5]); ww.w = pack2(o[6], o[7]);
                *(u32x4*)(xc + (size_t)t * 4096 + c0) = ww;
            }
        }
    }
    {
        float* dt = (float*)(p.ws + O_DT); float* acs = (float*)(p.ws + O_ACS); float* cdec = (float*)(p.ws + O_CDEC);
        for (int c = bidx(); c < 65; c += gridDim.x)
        for (int head = wid; head < 32; head += 8) {
            const float bias = p.in(5)[jj * 32 + head], a = -__expf(p.in(6)[jj * 32 + head]);
            const int t0 = c * 128 - 112 + 2 * lane;
            float d0 = 0.f, d1 = 0.f;
            if (t0 >= 0) {
                const float x0 = side[(size_t)t0 * 64 + head] + bias, x1 = side[(size_t)(t0 + 1) * 64 + head] + bias;
                d0 = x0 > 20.f ? x0 : __logf(1.f + __expf(x0)); d1 = x1 > 20.f ? x1 : __logf(1.f + __expf(x1));
            }
            const float a0 = d0 * a, a1 = d1 * a;
            float s = a0 + a1;
#pragma unroll
            for (int o = 1; o < 64; o <<= 1) { const float v = __shfl_up(s, o); if (lane >= o) s += v; }
            const float ex = s - (a0 + a1);
            if (t0 >= 0) {
                dt[(size_t)t0 * 32 + head] = d0; dt[(size_t)(t0 + 1) * 32 + head] = d1;
                acs[(size_t)t0 * 32 + head] = ex + a0; acs[(size_t)(t0 + 1) * 32 + head] = s;
            }
            if (lane == 63) cdec[c * 32 + head] = __expf(s);
        }
    }
    {
        bf16_t* qt = (bf16_t*)(p.ws + O_QT); bf16_t* kt = (bf16_t*)(p.ws + O_KT); float* glast = (float*)(p.ws + O_GLAST);
        const float* w2 = p.in(9) + (size_t)jj * 16 * 1024; const float* gb = p.in(10) + (size_t)jj * 1024;
        LAS float* tot = (LAS float*)lds;
        const int d4 = tid & 15, pg = tid >> 4;
        for (int task = bidx(); task < 129 * 16; task += gridDim.x) {
            const int c = task >> 4, dbase = (task & 15) * 64 + d4 * 4, tbase = c * 64 - 48 + 2 * pg;
            f32x4 w[16];
#pragma unroll
            for (int r = 0; r < 16; ++r) w[r] = *(const f32x4*)(w2 + r * 1024 + dbase);
            const f32x4 b = *(const f32x4*)(gb + dbase);
            f32x4 g0 = {0.f, 0.f, 0.f, 0.f}, g1 = {0.f, 0.f, 0.f, 0.f};
            if (tbase >= 0) {
#pragma unroll
                for (int pos = 0; pos < 2; ++pos) {
                    const float* gl = side + (size_t)(tbase + pos) * 64 + 32;
                    f32x4 x = b;
#pragma unroll
                    for (int r4 = 0; r4 < 4; ++r4) { const f32x4 gv = *(const f32x4*)(gl + r4 * 4); x += w[r4 * 4] * gv[0] + w[r4 * 4 + 1] * gv[1] + w[r4 * 4 + 2] * gv[2] + w[r4 * 4 + 3] * gv[3]; }
                    f32x4 ls;
#pragma unroll
                    for (int e = 0; e < 4; ++e) ls[e] = (fminf(x[e], 0.f) - __logf(1.f + __expf(-fabsf(x[e])))) * (1.f / 16.f);
                    if (pos == 0) g0 = ls; else g1 = ls;
                }
            }
            __syncthreads();
            *(LAS f32x4*)(tot + pg * 64 + d4 * 4) = g0 + g1;
            __syncthreads();
            f32x4 pre = {0.f, 0.f, 0.f, 0.f};
            for (int g = 0; g < pg; ++g) pre += *(const LAS f32x4*)(tot + g * 64 + d4 * 4);
            const f32x4 gc0 = pre + g0, gc1 = gc0 + g1;
            if (tbase >= 0) {
#pragma unroll
                for (int pos = 0; pos < 2; ++pos) {
                    const f32x4 gc = pos == 0 ? gc0 : gc1;
                    const size_t t = (size_t)(tbase + pos);
                    const u32x2 qw = *(const u32x2*)(u + t * HYB_N + UQ + dbase), kw = *(const u32x2*)(u + t * HYB_N + UK + dbase);
                    const float q[4] = {bflo(qw.x), bfhi(qw.x), bflo(qw.y), bfhi(qw.y)}, k[4] = {bflo(kw.x), bfhi(kw.x), bflo(kw.y), bfhi(kw.y)};
                    u32x2 qo, ko;
                    qo.x = pack2(q[0] * 0.0625f * __expf(gc[0]), q[1] * 0.0625f * __expf(gc[1])); qo.y = pack2(q[2] * 0.0625f * __expf(gc[2]), q[3] * 0.0625f * __expf(gc[3]));
                    ko.x = pack2(k[0] * __expf(-gc[0]), k[1] * __expf(-gc[1])); ko.y = pack2(k[2] * __expf(-gc[2]), k[3] * __expf(-gc[3]));
                    *(u32x2*)(qt + t * 1024 + dbase) = qo; *(u32x2*)(kt + t * 1024 + dbase) = ko;
                }
            }
            if (pg == 31) { f32x4 e; e[0] = __expf(gc1[0]); e[1] = __expf(gc1[1]); e[2] = __expf(gc1[2]); e[3] = __expf(gc1[3]); *(f32x4*)(glast + c * 1024 + dbase) = e; }
        }
    }
}

__device__ __forceinline__ void phase_hyb_local(const Ctx& p, LAS unsigned char* lds) {
    const int tid = tidx(), lane = tid & 63, wid = tid >> 6, fr = lane & 15, fq = lane >> 4;
    const bf16_t* xc = (const bf16_t*)(p.ws + O_XC);
    const float* dt = (const float*)(p.ws + O_DT); const float* acs = (const float*)(p.ws + O_ACS);
    const int NSSD = 65 * 8, NGLA = 129 * 16;
    for (int task = bidx(); task < NSSD + NGLA; task += gridDim.x) {
        __syncthreads();
        if (task < NSSD) {
            const int c = task >> 3, g = task & 7, tbase = c * 128 - 112;
            LAS bf16_t* Bs = (LAS bf16_t*)lds;
            LAS bf16_t* Xs = Bs + 128 * 136;
            const int tlast = tbase + 127;
            for (int item = tid; item < 128 * 16; item += NTHREADS) {
                const int j = item >> 4, cb = item & 15, t = tbase + j;
                u32x4 w = {0u, 0u, 0u, 0u};
                if (t >= 0) w = *(const u32x4*)(xc + (size_t)t * 4096 + 2048 + g * 128 + cb * 8);
                *(LAS u32x4*)(Bs + j * 136 + cb * 8) = w;
            }
            for (int item = tid; item < 128 * 32; item += NTHREADS) {
                const int j = item >> 5, cb = item & 31, hh = cb >> 3, t = tbase + j, head = g * 4 + hh;
                u32x4 w = {0u, 0u, 0u, 0u};
                if (t >= 0) {
                    float f[8]; unpack8(*(const u32x4*)(xc + (size_t)t * 4096 + g * 256 + cb * 8), f);
                    const float sc = dt[(size_t)t * 32 + head] * __expf(acs[(size_t)tlast * 32 + head] - acs[(size_t)t * 32 + head]);
                    w.x = pack2(f[0] * sc, f[1] * sc); w.y = pack2(f[2] * sc, f[3] * sc); w.z = pack2(f[4] * sc, f[5] * sc); w.w = pack2(f[6] * sc, f[7] * sc);
                }
                *(LAS u32x4*)(Xs + j * 264 + cb * 8) = w;
            }
            __syncthreads();
            float* loc = (float*)(p.ws + O_SSDLOC) + ((size_t)c * 32 + g * 4) * 64 * 128;
            const int pt = wid & 3, nh = wid >> 2;
            for (int hh = 0; hh < 4; ++hh) {
                f32x4 acc[4];
#pragma unroll
                for (int nt = 0; nt < 4; ++nt) acc[nt] = (f32x4){0.f, 0.f, 0.f, 0.f};
#pragma unroll
                for (int ks = 0; ks < 4; ++ks) {
                    const bf16x8 xf = ldfrag_tr(Xs, 264, hh * 64 + pt * 16, ks * 32, lane);
#pragma unroll
                    for (int nt = 0; nt < 4; ++nt) { const bf16x8 bf = ldfrag_tr(Bs, 136, nh * 64 + nt * 16, ks * 32, lane); acc[nt] = MFMA16(bf, xf, acc[nt]); }
                }
#pragma unroll
                for (int nt = 0; nt < 4; ++nt) *(f32x4*)(loc + ((size_t)hh * 64 + pt * 16 + fr) * 128 + nh * 64 + nt * 16 + 4 * fq) = acc[nt];
            }
        } else {
            const int gt = task - NSSD, c = gt >> 4, h = (gt >> 2) & 3, vs = gt & 3, tbase = c * 64 - 48;
            const bf16_t* u = (const bf16_t*)(p.ws + O_U); const bf16_t* kt = (const bf16_t*)(p.ws + O_KT);
            LAS bf16_t* Ks = (LAS bf16_t*)lds;
            LAS bf16_t* Vs = Ks + 64 * 264;
            for (int item = tid; item < 64 * 32; item += NTHREADS) {
                const int j = item >> 5, cb = item & 31, t = tbase + j;
                u32x4 w = {0u, 0u, 0u, 0u};
                if (t >= 0) w = *(const u32x4*)(kt + (size_t)t * 1024 + h * 256 + cb * 8);
                *(LAS u32x4*)(Ks + j * 264 + cb * 8) = w;
            }
            for (int item = tid; item < 64 * 16; item += NTHREADS) {
                const int j = item >> 4, cb = item & 15, t = tbase + j;
                u32x4 w = {0u, 0u, 0u, 0u};
                if (t >= 0) w = *(const u32x4*)(u + (size_t)t * HYB_N + UV + h * 512 + vs * 128 + cb * 8);
                *(LAS u32x4*)(Vs + j * 136 + cb * 8) = w;
            }
            __syncthreads();
            const float* glast = (const float*)(p.ws + O_GLAST) + c * 1024 + h * 256;
            bf16_t* kv = (bf16_t*)(p.ws + O_R2) + ((size_t)c * 4 + h) * 131072 + (size_t)(vs * 8 + wid) * 4096 + fr * 8 + (fq & 1) * 4;
            const bf16x8 vf0 = ldfrag_tr(Vs, 136, wid * 16, 0, lane), vf1 = ldfrag_tr(Vs, 136, wid * 16, 32, lane);
#pragma unroll
            for (int nt = 0; nt < 16; ++nt) {
                f32x4 acc = {0.f, 0.f, 0.f, 0.f};
                acc = MFMA16(ldfrag_tr(Ks, 264, nt * 16, 0, lane), vf0, acc);
                acc = MFMA16(ldfrag_tr(Ks, 264, nt * 16, 32, lane), vf1, acc);
                const f32x4 gl = *(const f32x4*)(glast + nt * 16 + 4 * fq);
                u32x2 w; w.x = pack2(acc[0] * gl[0], acc[1] * gl[1]); w.y = pack2(acc[2] * gl[2], acc[3] * gl[3]);
                *(u32x2*)(kv + (nt >> 1) * 512 + ((nt & 1) * 2 + (fq >> 1)) * 128) = w;
            }
        }
    }
}

__device__ __forceinline__ void phase_hyb_scan(const Ctx& p) {
    const size_t gtid = (size_t)bidx() * NTHREADS + tidx(), gn = (size_t)gridDim.x * NTHREADS;
    for (size_t task = gtid; task < 131072; task += gn) {
        if (task < 65536) {
            const size_t e = task * 4; const int head = (int)(e >> 13);
            const float* loc = (const float*)(p.ws + O_SSDLOC) + e; bf16_t* prev = (bf16_t*)(p.ws + O_SSDPREV) + e;
            const float* cdec = (const float*)(p.ws + O_CDEC) + head;
            float zz = 0.f; asm volatile("" : "+v"(zz));
            float4 run = {zz, zz, zz, zz};
            for (int c0 = 0; c0 < 65; c0 += 13) {
                float4 l[13]; float dcy[13];
#pragma unroll
                for (int i = 0; i < 13; ++i) { l[i] = *(const float4*)(loc + (size_t)(c0 + i) * 262144); dcy[i] = cdec[(c0 + i) * 32]; }
#pragma unroll
                for (int i = 0; i < 13; ++i) {
                    u32x2 w; w.x = pack2(run.x, run.y); w.y = pack2(run.z, run.w);
                    *(u32x2*)(prev + (size_t)(c0 + i) * 262144) = w;
                    run.x = run.x * dcy[i] + l[i].x; run.y = run.y * dcy[i] + l[i].y; run.z = run.z * dcy[i] + l[i].z; run.w = run.w * dcy[i] + l[i].w;
                }
            }
        } else {
            const size_t e = (task - 65536) * 8; const int h = (int)(e >> 17), ch16 = (int)((e & 131071) >> 3), d0 = ((ch16 >> 6) & 7) * 32 + ((ch16 >> 4) & 3) * 8;
            const bf16_t* kv = (const bf16_t*)(p.ws + O_R2) + e; bf16_t* sp = (bf16_t*)(p.ws + O_R2 + GLA_ST_BYTES) + e;
            const float* glast = (const float*)(p.ws + O_GLAST) + h * 256 + d0;
            float run[8]; float zz = 0.f; asm volatile("" : "+v"(zz));
#pragma unroll
            for (int i = 0; i < 8; ++i) run[i] = zz;
            for (int c0 = 0; c0 < 129; c0 += 8) {
                u32x4 lw[8]; float4 ga[8], gb2[8];
#pragma unroll
                for (int i = 0; i < 8; ++i) { const int c = c0 + i < 129 ? c0 + i : 128; lw[i] = *(const u32x4*)(kv + (size_t)c * 524288); ga[i] = *(const float4*)(glast + c * 1024); gb2[i] = *(const float4*)(glast + c * 1024 + 4); }
#pragma unroll
                for (int i = 0; i < 8; ++i) {
                    if (c0 + i < 129) {
                        float l[8]; unpack8(lw[i], l);
                        u32x4 w; w.x = pack2(run[0], run[1]); w.y = pack2(run[2], run[3]); w.z = pack2(run[4], run[5]); w.w = pack2(run[6], run[7]);
                        *(u32x4*)(sp + (size_t)(c0 + i) * 524288) = w;
                        run[0] = run[0] * ga[i].x + l[0]; run[1] = run[1] * ga[i].y + l[1]; run[2] = run[2] * ga[i].z + l[2]; run[3] = run[3] * ga[i].w + l[3];
                        run[4] = run[4] * gb2[i].x + l[4]; run[5] = run[5] * gb2[i].y + l[5]; run[6] = run[6] * gb2[i].z + l[6]; run[7] = run[7] * gb2[i].w + l[7];
                    }
                }
            }
        }
    }
}
__device__ __forceinline__ void phase_hyb_out(const Ctx& p, int jj, LAS unsigned char* lds) {
    const bf16_t* xc = (const bf16_t*)(p.ws + O_XC); const bf16_t* u = (const bf16_t*)(p.ws + O_U);
    const float* dt = (const float*)(p.ws + O_DT); const float* acs = (const float*)(p.ws + O_ACS);
    bf16_t* mix = (bf16_t*)(p.ws + O_MIX);
    for (int task0 = bidx(); task0 < 1036; task0 += gridDim.x) {
        bool is_ssd; int c, sub;
        if (task0 < 8) { is_ssd = true; c = 0; sub = task0; }
        else if (task0 < 12) { is_ssd = false; c = 0; sub = task0 - 8; }
        else if (task0 < 524) { is_ssd = true; c = 1 + ((task0 - 12) >> 3); sub = (task0 - 12) & 7; }
        else { is_ssd = false; c = 1 + ((task0 - 524) >> 2); sub = (task0 - 524) & 3; }
        const int tid = tidx(), lane = tid & 63, wid = tid >> 6, fr = lane & 15, fq = lane >> 4;
        __syncthreads();
        if (is_ssd) {
            const int g = sub, tbase = c * 128 - 112;
            LAS bf16_t* Cs = (LAS bf16_t*)lds;
            LAS bf16_t* Bs = Cs + 128 * 136;
            LAS bf16_t* Xt = Bs + 128 * 136;
            LAS bf16_t* Pv = Xt + 128 * 72;
            LAS float* Acs = (LAS float*)(Pv + 64 * 136);
            for (int item = tid; item < 128 * 32; item += NTHREADS) {
                const int j = item >> 5, cb = item & 31, t = tbase + j;
                u32x4 w = {0u, 0u, 0u, 0u};
                if (t >= 0) w = *(const u32x4*)(xc + (size_t)t * 4096 + 2048 + (cb < 16 ? 0 : 1024) + g * 128 + (cb & 15) * 8);
                *(LAS u32x4*)((cb < 16 ? Bs : Cs) + j * 136 + (cb & 15) * 8) = w;
            }
            { const int j = tid & 127, hh = tid >> 7, t = tbase + j; Acs[hh * 128 + j] = t >= 0 ? acs[(size_t)t * 32 + g * 4 + hh] : 0.f; }
            __syncthreads();
            const int i_row = wid * 16 + fr, ti = tbase + i_row;
            f32x4 cb_acc[8];
#pragma unroll
            for (int nt = 0; nt < 8; ++nt) cb_acc[nt] = (f32x4){0.f, 0.f, 0.f, 0.f};
#pragma unroll
            for (int ks = 0; ks < 4; ++ks) {
                const bf16x8 cf = ldfrag(Cs, 136, wid * 16, ks * 32, lane);
#pragma unroll
                for (int nt = 0; nt < 8; ++nt) cb_acc[nt] = MFMA16(ldfrag(Bs, 136, nt * 16, ks * 32, lane), cf, cb_acc[nt]);
            }
            f32x4 yv[4][4];
#pragma unroll
            for (int k = 0; k < 4; ++k)
#pragma unroll
                for (int pt = 0; pt < 4; ++pt) yv[k][pt] = (f32x4){0.f, 0.f, 0.f, 0.f};
            float ssq = 0.f;
#pragma unroll 1
            for (int hh = 0; hh < 4; ++hh) {
                const int head = g * 4 + hh;
                __syncthreads();
                for (int item = tid; item < 128 * 8; item += NTHREADS) {
                    const int j = item >> 3, cb = item & 7, t = tbase + j;
                    u32x4 w = {0u, 0u, 0u, 0u};
                    if (t >= 0) { float f[8]; unpack8(*(const u32x4*)(xc + (size_t)t * 4096 + head * 64 + cb * 8), f); const float sc = dt[(size_t)t * 32 + head];
                        w.x = pack2(f[0] * sc, f[1] * sc); w.y = pack2(f[2] * sc, f[3] * sc); w.z = pack2(f[4] * sc, f[5] * sc); w.w = pack2(f[6] * sc, f[7] * sc); }
                    *(LAS u32x4*)(Xt + j * 72 + cb * 8) = w;
                }
                { const bf16_t* pv = (const bf16_t*)(p.ws + O_SSDPREV) + ((size_t)c * 32 + head) * 64 * 128;
                  for (int item = tid; item < 64 * 16; item += NTHREADS) { const int pp = item >> 4, cb = item & 15; *(LAS u32x4*)(Pv + pp * 136 + cb * 8) = *(const u32x4*)(pv + pp * 128 + cb * 8); } }
                const float ai = Acs[hh * 128 + i_row];
#pragma unroll
                for (int nt = 0; nt < 8; ++nt) {
                    float m[4];
#pragma unroll
                    for (int q = 0; q < 4; ++q) { const int j = nt * 16 + 4 * fq + q; m[q] = j <= i_row ? cb_acc[nt][q] * __expf(ai - Acs[hh * 128 + j]) : 0.f; }
                    u32x2 w; w.x = pack2(m[0], m[1]); w.y = pack2(m[2], m[3]);
                    *(LAS u32x2*)(Bs + i_row * 136 + nt * 16 + 4 * fq) = w;
                }
                __syncthreads();
                f32x4 yd[4], yo[4];
#pragma unroll
                for (int pt = 0; pt < 4; ++pt) { yd[pt] = (f32x4){0.f, 0.f, 0.f, 0.f}; yo[pt] = (f32x4){0.f, 0.f, 0.f, 0.f}; }
#pragma unroll
                for (int ks = 0; ks < 4; ++ks) {
                    const bf16x8 mf = ldfrag(Bs, 136, wid * 16, ks * 32, lane), cf = ldfrag(Cs, 136, wid * 16, ks * 32, lane);
#pragma unroll
                    for (int pt = 0; pt < 4; ++pt) {
                        yd[pt] = MFMA16(ldfrag_tr(Xt, 72, pt * 16, ks * 32, lane), mf, yd[pt]);
                        yo[pt] = MFMA16(ldfrag(Pv, 136, pt * 16, ks * 32, lane), cf, yo[pt]);
                    }
                }
                const float ea = __expf(ai), dsk = p.in(7)[jj * 32 + head];
#pragma unroll
                for (int pt = 0; pt < 4; ++pt) {
                    const int ch = head * 64 + pt * 16 + 4 * fq;
                    float xs[4] = {0.f, 0.f, 0.f, 0.f}, zz[4] = {0.f, 0.f, 0.f, 0.f};
                    if (ti >= 0) {
                        const u32x2 xw = *(const u32x2*)(xc + (size_t)ti * 4096 + ch), zw = *(const u32x2*)(u + (size_t)ti * HYB_N + UZ + ch);
                        xs[0] = bflo(xw.x); xs[1] = bfhi(xw.x); xs[2] = bflo(xw.y); xs[3] = bfhi(xw.y);
                        zz[0] = bflo(zw.x); zz[1] = bfhi(zw.x); zz[2] = bflo(zw.y); zz[3] = bfhi(zw.y);
                    }
#pragma unroll
                    for (int q = 0; q < 4; ++q) { const float y = (yd[pt][q] + ea * yo[pt][q] + dsk * xs[q]) * silu_f(zz[q]); ssq += y * y;
#pragma unroll
                        for (int k = 0; k < 4; ++k) yv[k][pt][q] = (k == hh) ? y : yv[k][pt][q]; }
                }
            }
            ssq += __shfl_xor(ssq, 16); ssq += __shfl_xor(ssq, 32);
            const float rs = rsqrtf(ssq * (1.f / 256.f) + 1e-6f);
            if (ti >= 0) {
                const float* nw = p.in(8) + (size_t)jj * 2048;
#pragma unroll
                for (int hh = 0; hh < 4; ++hh)
#pragma unroll
                    for (int pt = 0; pt < 4; ++pt) {
                        const int ch = (g * 4 + hh) * 64 + pt * 16 + 4 * fq;
                        const f32x4 wv = *(const f32x4*)(nw + ch);
                        u32x2 w; w.x = pack2(yv[hh][pt][0] * rs * wv[0], yv[hh][pt][1] * rs * wv[1]); w.y = pack2(yv[hh][pt][2] * rs * wv[2], yv[hh][pt][3] * rs * wv[3]);
                        *(u32x2*)(mix + (size_t)ti * 4096 + ch) = w;
                    }
            }
        } else {
            const int h = sub, tbase = c * 64 - 48;
            const bf16_t* qt = (const bf16_t*)(p.ws + O_QT); const bf16_t* kt = (const bf16_t*)(p.ws + O_KT);
            LAS bf16_t* Qs = (LAS bf16_t*)lds;
            LAS bf16_t* Ps = Qs + 64 * 264;
            LAS float* Ssq = (LAS float*)(Ps + 64 * 72);
            LAS bf16_t* Ks = (LAS bf16_t*)(Ssq + 512);
            LAS bf16_t* Vs = Ks;
            for (int item = tid; item < 64 * 64; item += NTHREADS) {
                const int j = item >> 6, cb = item & 63, t = tbase + j;
                u32x4 w = {0u, 0u, 0u, 0u};
                if (t >= 0) w = *(const u32x4*)((cb < 32 ? qt : kt) + (size_t)t * 1024 + h * 256 + (cb & 31) * 8);
                *(LAS u32x4*)((cb < 32 ? Qs : Ks) + j * 264 + (cb & 31) * 8) = w;
            }
            u32x4 vreg[8];
#pragma unroll
            for (int r = 0; r < 8; ++r) { const int item = tid + r * NTHREADS, j = item >> 6, cb = item & 63, t = tbase + j;
                vreg[r] = (u32x4){0u, 0u, 0u, 0u};
                if (t >= 0) vreg[r] = *(const u32x4*)(u + (size_t)t * HYB_N + UV + h * 512 + cb * 8); }
            __syncthreads();
#pragma unroll
            for (int rep = 0; rep < 2; ++rep) {
                const int tix = wid + rep * 8, it = tix >> 2, jt = tix & 3;
                f32x4 acc = {0.f, 0.f, 0.f, 0.f};
                if (jt <= it) {
#pragma unroll
                    for (int ks = 0; ks < 8; ++ks) acc = MFMA16(ldfrag(Ks, 264, jt * 16, ks * 32, lane), ldfrag(Qs, 264, it * 16, ks * 32, lane), acc);
                }
                const int i = it * 16 + fr;
                float m[4];
#pragma unroll
                for (int q = 0; q < 4; ++q) { const int j = jt * 16 + 4 * fq + q; m[q] = (j <= i) ? acc[q] : 0.f; }
                u32x2 w; w.x = pack2(m[0], m[1]); w.y = pack2(m[2], m[3]);
                *(LAS u32x2*)(Ps + i * 72 + jt * 16 + 4 * fq) = w;
            }
            __syncthreads();
#pragma unroll
            for (int r = 0; r < 8; ++r) { const int item = tid + r * NTHREADS, j = item >> 6, cb = item & 63; *(LAS u32x4*)(Vs + j * 520 + cb * 8) = vreg[r]; }
            __syncthreads();
            f32x4 o[4][4];
            float ssq[4] = {0.f, 0.f, 0.f, 0.f};
            const bf16_t* sp = (const bf16_t*)(p.ws + O_R2 + GLA_ST_BYTES) + ((size_t)c * 4 + h) * 512 * 256;
#pragma unroll
            for (int vs = 0; vs < 4; ++vs) {
#pragma unroll
                for (int it = 0; it < 4; ++it) o[vs][it] = (f32x4){0.f, 0.f, 0.f, 0.f};
#pragma unroll
                for (int ks = 0; ks < 2; ++ks) {
                    const bf16x8 vf = ldfrag_tr(Vs, 520, vs * 128 + wid * 16, ks * 32, lane);
#pragma unroll
                    for (int it = 0; it < 4; ++it) o[vs][it] = MFMA16(vf, ldfrag(Ps, 72, it * 16, ks * 32, lane), o[vs][it]);
                }
                const bf16_t* spw = sp + (size_t)(vs * 8 + wid) * 4096 + lane * 8;
#pragma unroll
                for (int ks = 0; ks < 8; ++ks) {
                    const bf16x8 sf = *(const bf16x8*)(spw + ks * 512);
#pragma unroll
                    for (int it = 0; it < 4; ++it) o[vs][it] = MFMA16(sf, ldfrag(Qs, 264, it * 16, ks * 32, lane), o[vs][it]);
                }
#pragma unroll
                for (int it = 0; it < 4; ++it) ssq[it] += o[vs][it][0] * o[vs][it][0] + o[vs][it][1] * o[vs][it][1] + o[vs][it][2] * o[vs][it][2] + o[vs][it][3] * o[vs][it][3];
            }
#pragma unroll
            for (int it = 0; it < 4; ++it) { float s = ssq[it]; s += __shfl_xor(s, 16); s += __shfl_xor(s, 32); if (fq == 0) Ssq[wid * 64 + it * 16 + fr] = s; }
            __syncthreads();
            const float* nw = p.in(11) + (size_t)jj * 2048 + h * 512;
#pragma unroll
            for (int it = 0; it < 4; ++it) {
                const int i = it * 16 + fr, t = tbase + i;
                float s = 0.f;
#pragma unroll
                for (int w8 = 0; w8 < 8; ++w8) s += Ssq[w8 * 64 + i];
                const float rs = rsqrtf(s * (1.f / 512.f) + 1e-6f);
                if (t >= 0) {
#pragma unroll
                    for (int vs = 0; vs < 4; ++vs) {
                        const int v0 = vs * 128 + wid * 16 + 4 * fq;
                        const f32x4 wv = *(const f32x4*)(nw + v0);
                        const u32x2 rw = *(const u32x2*)(u + (size_t)t * HYB_N + UR + h * 512 + v0);
                        const float r0 = bflo(rw.x), r1 = bfhi(rw.x), r2 = bflo(rw.y), r3 = bfhi(rw.y);
                        u32x2 w;
                        w.x = pack2(o[vs][it][0] * rs * wv[0] * silu_f(r0), o[vs][it][1] * rs * wv[1] * silu_f(r1));
                        w.y = pack2(o[vs][it][2] * rs * wv[2] * silu_f(r2), o[vs][it][3] * rs * wv[3] * silu_f(r3));
                        *(u32x2*)(mix + (size_t)t * 4096 + 2048 + h * 512 + v0) = w;
                    }
                }
            }
        }
    }
}
__device__ __forceinline__ void rot_pair(const u32x4 a, const u32x4 b, const float* cs, u32x4& oa, u32x4& ob) {
    float x1[8], x2[8], c[8], s[8]; unpack8(a, x1); unpack8(b, x2); ld8f(cs, c); ld8f(cs + 8, s);
    float r1[8], r2[8];
#pragma unroll
    for (int i = 0; i < 8; ++i) { r1[i] = x1[i] * c[i] - x2[i] * s[i]; r2[i] = x2[i] * c[i] + x1[i] * s[i]; }
    oa.x = pack2(r1[0], r1[1]); oa.y = pack2(r1[2], r1[3]); oa.z = pack2(r1[4], r1[5]); oa.w = pack2(r1[6], r1[7]);
    ob.x = pack2(r2[0], r2[1]); ob.y = pack2(r2[2], r2[3]); ob.z = pack2(r2[4], r2[5]); ob.w = pack2(r2[6], r2[7]);
}
__device__ __forceinline__ void phase_attn(const Ctx& p, int jj, LAS unsigned char* lds) {
    const int tid = tidx(), lane = tid & 63, wid = tid >> 6, fr = lane & 15, fq = lane >> 4;
    const bf16_t* qkv = (const bf16_t*)(p.ws + O_U);
    const float* rope = (const float*)(p.ws + O_ROPE);
    bf16_t* ao = (bf16_t*)(p.ws + O_MIX);
    LAS bf16_t* Ks = (LAS bf16_t*)lds;
    LAS bf16_t* Vt = Ks + 272 * 72;
    LAS bf16_t* Pw = Vt + 64 * 280 + wid * (16 * 168);
    for (int task0 = bidx(); task0 < 520; task0 += gridDim.x) {
        const int task = task0 < 8 ? 512 + task0 : task0 - 8;
        const bool meta = task >= 512;
        const int b = meta ? 0 : (task >> 3), kh = task & 7;
        const int nkeys = meta ? 32 : 272;
        __syncthreads();
        for (int item = tid; item < nkeys * 8; item += NTHREADS) {
            const int key = item >> 3, cb = item & 7;
            const int tok = key < 16 ? key : 16 + 128 * (b - 1) + (key - 16);
            const bool valid = meta ? (key < 16) : (key < 16 || tok >= 16);
            {
                u32x4 w = {0u, 0u, 0u, 0u};
                if (valid) w = *(const u32x4*)(qkv + (size_t)tok * QKV_N + 2560 + kh * 64 + cb * 8);
                const bf16_t e[8] = {(bf16_t)(w.x & 0xffff), (bf16_t)(w.x >> 16), (bf16_t)(w.y & 0xffff), (bf16_t)(w.y >> 16), (bf16_t)(w.z & 0xffff), (bf16_t)(w.z >> 16), (bf16_t)(w.w & 0xffff), (bf16_t)(w.w >> 16)};
#pragma unroll
                for (int i = 0; i < 8; ++i) Vt[(cb * 8 + i) * 280 + key] = e[i];
            }
            if (cb == 1) continue;
            const bf16_t* src = qkv + (size_t)tok * QKV_N + 2048 + kh * 64;
            if (cb == 0) {
                u32x4 oa = {0u, 0u, 0u, 0u}, ob = {0u, 0u, 0u, 0u};
                if (valid) rot_pair(*(const u32x4*)src, *(const u32x4*)(src + 8), rope + (size_t)tok * 16, oa, ob);
                *(LAS u32x4*)(Ks + key * 72) = oa; *(LAS u32x4*)(Ks + key * 72 + 8) = ob;
            } else {
                u32x4 w = {0u, 0u, 0u, 0u};
                if (valid) w = *(const u32x4*)(src + cb * 8);
                *(LAS u32x4*)(Ks + key * 72 + cb * 8) = w;
            }
        }
        __syncthreads();
        if (meta && wid >= 4) continue;
        const int ng = meta ? 1 : 4;
        for (int gi = 0; gi < ng; ++gi) {
            const int g = meta ? wid : gi, hq = kh * 4 + g;
            const int tq = meta ? fr : 16 + 128 * b + 16 * wid + fr;
            u32x4 q0 = *(const u32x4*)(qkv + (size_t)tq * QKV_N + hq * 64 + 8 * fq), q1 = *(const u32x4*)(qkv + (size_t)tq * QKV_N + hq * 64 + 32 + 8 * fq);
            {
                u32x4 ot; ot.x = __shfl_xor((int)q0.x, 16); ot.y = __shfl_xor((int)q0.y, 16); ot.z = __shfl_xor((int)q0.z, 16); ot.w = __shfl_xor((int)q0.w, 16);
                if (fq < 2) {
                    float mine[8], oth[8], c[8], s[8]; unpack8(q0, mine); unpack8(ot, oth); ld8f(rope + (size_t)tq * 16, c); ld8f(rope + (size_t)tq * 16 + 8, s);
                    const float sg = fq == 0 ? -1.f : 1.f;
                    float r[8];
#pragma unroll
                    for (int i = 0; i < 8; ++i) r[i] = mine[i] * c[i] + sg * oth[i] * s[i];
                    q0.x = pack2(r[0], r[1]); q0.y = pack2(r[2], r[3]); q0.z = pack2(r[4], r[5]); q0.w = pack2(r[6], r[7]);
                }
            }
            const bf16x8 qa0 = __builtin_bit_cast(bf16x8, q0), qa1 = __builtin_bit_cast(bf16x8, q1);
            const float sink = p.in(14)[jj * 32 + hq];
            const int nt = meta ? 1 : 10;
            f32x4 sc[10];
            float mx = sink;
#pragma unroll
            for (int t = 0; t < 10; ++t) {
                if (t < nt) {
                    const int krow = t == 0 ? 0 : 16 + 16 * (wid + t - 1);
                    f32x4 a = {0.f, 0.f, 0.f, 0.f};
                    a = MFMA16(ldfrag(Ks, 72, krow, 0, lane), qa0, a);
                    a = MFMA16(ldfrag(Ks, 72, krow, 32, lane), qa1, a);
#pragma unroll
                    for (int j = 0; j < 4; ++j) {
                        bool vis;
                        if (t == 0) vis = meta ? (4 * fq + j <= fr) : true;
                        else { const int rel = 16 * (t - 1) + 4 * fq + j - fr; vis = rel >= 1 && rel <= 128 && (b > 0 || 16 * wid + 16 * (t - 1) + 4 * fq + j >= 128); }
                        const float v = vis ? a[j] * 0.125f : -INFINITY;
                        a[j] = v; mx = fmaxf(mx, v);
                    }
                    sc[t] = a;
                }
            }
            mx = fmaxf(mx, __shfl_xor(mx, 16)); mx = fmaxf(mx, __shfl_xor(mx, 32));
            float den = 0.f;
#pragma unroll
            for (int t = 0; t < 10; ++t) {
                if (t < nt) {
                    float e[4];
#pragma unroll
                    for (int j = 0; j < 4; ++j) { e[j] = __expf(sc[t][j] - mx); den += e[j]; }
                    u32x2 w; w.x = pack2(e[0], e[1]); w.y = pack2(e[2], e[3]);
                    *(LAS u32x2*)(Pw + fr * 168 + t * 16 + 4 * fq) = w;
                }
            }
            if (meta) { unsigned zz = 0u; asm volatile("" : "+v"(zz)); u32x2 z = {zz, zz}; *(LAS u32x2*)(Pw + fr * 168 + 16 + 4 * fq) = z; }
            den += __shfl_xor(den, 16); den += __shfl_xor(den, 32);
            den += __expf(sink - mx);
            const float rden = 1.f / den;
            LDS_FENCE();
            f32x4 oacc[4];
#pragma unroll
            for (int dtl = 0; dtl < 4; ++dtl) oacc[dtl] = (f32x4){0.f, 0.f, 0.f, 0.f};
            const int nks = meta ? 1 : 5;
#pragma unroll
            for (int ks = 0; ks < 5; ++ks) {
                if (ks < nks) {
                    const int pc = 32 * ks + 8 * fq;
                    const bf16x8 pf = *(const LAS bf16x8*)(Pw + fr * 168 + pc);
                    const int vcol = (pc < 16 || meta) ? pc : pc + 16 * wid;
#pragma unroll
                    for (int dtl = 0; dtl < 4; ++dtl) {
                        const bf16x8 vf = *(const LAS bf16x8*)(Vt + (dtl * 16 + fr) * 280 + vcol);
                        oacc[dtl] = MFMA16(vf, pf, oacc[dtl]);
                    }
                }
            }
            LDS_FENCE();
#pragma unroll
            for (int dtl = 0; dtl < 4; ++dtl) {
                u32x2 w; w.x = pack2(oacc[dtl][0] * rden, oacc[dtl][1] * rden); w.y = pack2(oacc[dtl][2] * rden, oacc[dtl][3] * rden);
                *(u32x2*)(ao + (size_t)tq * DM + hq * 64 + dtl * 16 + 4 * fq) = w;
            }
        }
    }
}
enum { K_PREP = 0, K_HIN, K_HPREP, K_HLOCAL, K_HSCAN, K_HOUT, K_GOUT, K_LN1, K_UP, K_CONV, K_DOWN, K_LN2, K_QKV, K_ATTN };
constexpr int N_PHASES = 1 + 2 * 11 + 2 * 8;
__host__ __device__ __forceinline__ void decode_phase(int ph, int& kind, int& layer) {
    if (ph == 0) { kind = K_PREP; layer = 0; return; }
    int r = ph - 1; layer = 0;
    if (r >= 19) { r -= 19; layer = 2; }
    if (r < 11) { kind = K_HIN + r; return; }
    r -= 11; layer += 1;
    kind = r == 0 ? K_QKV : (r == 1 ? K_ATTN : K_GOUT + (r - 2));
}
__global__ void __launch_bounds__(512, 2) fwd_megakernel(Params pin) {
    extern __shared__ __attribute__((aligned(16))) unsigned char shm[];
    LAS unsigned char* lds = (LAS unsigned char*)shm;
    cg::grid_group grid = cg::this_grid();
    volatile LAS unsigned* xst = (volatile LAS unsigned*)(lds + LDS_MAIN);
    if (threadIdx.x == 0) { xst[0] = 0u; xst[1] = 0u; }
    __syncthreads();
    XcdBarrier xb = xcd_barrier_post((unsigned*)(pin.ws + O_BAR), xst);
    if (pin.ph_lo == 0) { phase_prep(pin, lds); if (pin.ph_hi > 1) grid.sync(); }
    for (int ph = pin.ph_lo < 1 ? 1 : pin.ph_lo; ph < pin.ph_hi; ++ph) {
        Ctx p; { unsigned lo = (unsigned)(size_t)pin.ws, hi = (unsigned)((size_t)pin.ws >> 32); asm volatile("" : "+s"(lo), "+s"(hi)); p.ws = (unsigned char*)(__attribute__((address_space(1))) unsigned char*)(((size_t)hi << 32) | lo); p.out = pin.out; }
        ph = __builtin_amdgcn_readfirstlane(ph);
        int kind, layer; decode_phase(ph, kind, layer);
        const int jj = layer >> 1;
        bf16_t* hb = (bf16_t*)(p.ws + O_HB); float* h = (float*)(p.ws + O_H);
        bf16_t* mix = (bf16_t*)(p.ws + O_MIX);
        switch (kind) {
        case K_HIN: case K_QKV: case K_UP: {
            const bf16_t* w; bf16_t* O; int N;
            if (kind == K_HIN) { w = (const bf16_t*)(p.ws + O_WT_HIN) + (size_t)jj * 12288 * 2048; O = (bf16_t*)(p.ws + O_U); N = HYB_N;
                const int lane = tidx() & 63, wid = tidx() >> 6; const bf16_t* ws_ = (const bf16_t*)(p.ws + O_WT_HSIDE) + (size_t)jj * 48 * 2048; float* side = (float*)(p.ws + O_SIDE);
                for (int rt = bidx() * 8 + wid; rt < 513; rt += gridDim.x * 8) {
                    f32x4 a0 = {0.f, 0.f, 0.f, 0.f}, a1 = {0.f, 0.f, 0.f, 0.f}, a2 = {0.f, 0.f, 0.f, 0.f};
                    const bf16_t* pa = hb + (size_t)(rt * 16 + (lane & 15)) * 2048 + 8 * (lane >> 4);
                    const bf16_t* pb = ws_ + (size_t)(lane & 15) * 2048 + 8 * (lane >> 4);
#pragma unroll 8
                    for (int k0 = 0; k0 < 2048; k0 += 32) {
                        const bf16x8 a = *(const bf16x8*)(pa + k0);
                        a0 = MFMA16(*(const bf16x8*)(pb + k0), a, a0); a1 = MFMA16(*(const bf16x8*)(pb + 16 * 2048 + k0), a, a1); a2 = MFMA16(*(const bf16x8*)(pb + 32 * 2048 + k0), a, a2);
                    }
                    float* sr = side + (size_t)(rt * 16 + (lane & 15)) * 64 + 4 * (lane >> 4);
                    *(f32x4*)sr = a0; *(f32x4*)(sr + 16) = a1; *(f32x4*)(sr + 32) = a2; }
            } else if (kind == K_QKV) { w = (const bf16_t*)(p.ws + O_WT_QKV) + (size_t)jj * 3072 * 2048; O = (bf16_t*)(p.ws + O_U); N = QKV_N; }
            else { w = (const bf16_t*)(p.ws + O_WT_UP) + (size_t)layer * 11008 * 2048; O = (bf16_t*)(p.ws + O_R2); N = DFF2; }
            EpiStoreBf16 em{O, N}, e{O + (size_t)16 * N, N};
            gemm_full(lds, hb, w, N, 2048, em, e);
        } break;
        case K_GOUT: case K_DOWN: {
            const bf16_t* w; int K;
            if (kind == K_DOWN) { w = (const bf16_t*)(p.ws + O_WT_DOWN) + (size_t)layer * 2048 * 5504; K = DFF; }
            else if ((layer & 1) == 0) { w = (const bf16_t*)(p.ws + O_WT_HOUT) + (size_t)jj * 2048 * 4096; K = 4096; }
            else { w = (const bf16_t*)(p.ws + O_WT_SOUT) + (size_t)jj * 2048 * 2048; K = 2048; }
            EpiResF32 em{h, hb}, e{h + (size_t)16 * DM, hb + (size_t)16 * DM};
            gemm_full(lds, mix, w, 2048, K, em, e);
        } break;
        case K_HPREP: phase_hyb_prep(p, jj, lds); break;
        case K_HLOCAL: phase_hyb_local(p, lds); break;
        case K_HSCAN: phase_hyb_scan(p); break;
        case K_HOUT: phase_hyb_out(p, jj, lds); break;
        case K_ATTN: phase_attn(p, jj, lds); break;
        case K_LN1: phase_ln(p, p.in(20) + (size_t)layer * DM, p.in(21) + (size_t)layer * DM, false); break;
        case K_LN2: phase_ln(p, p.in(22) + (size_t)layer * DM, p.in(23) + (size_t)layer * DM, layer == 3); break;
        case K_CONV: phase_ffn_conv(p, layer); break;
        default: break;
        }
        if (ph + 1 < pin.ph_hi) xcd_barrier(xb);
    }
}

extern "C" void kernel_launch(void* const* d_in, const int* in_sizes, int n_in, void* d_out, int out_size, void* d_ws, size_t ws_size, hipStream_t stream) {
    static int grid = 0;
    if (grid == 0) {
        if (n_in != 24 || ws_size < WS_END) { fprintf(stderr, "kernel_launch: unexpected inputs (n_in %d, ws %zu, need %zu)\n", n_in, ws_size, (size_t)WS_END); grid = -1; return; }
        int dev = 0, cus = 0, per_cu = 0;
        (void)hipGetDevice(&dev);
        (void)hipDeviceGetAttribute(&cus, hipDeviceAttributeMultiprocessorCount, dev);
        if (hipFuncSetAttribute((const void*)fwd_megakernel, hipFuncAttributeMaxDynamicSharedMemorySize, LDS_BYTES) != hipSuccess) { fprintf(stderr, "kernel_launch: hipFuncSetAttribute failed\n"); grid = -1; return; }
        if (hipOccupancyMaxActiveBlocksPerMultiprocessor(&per_cu, (const void*)fwd_megakernel, NTHREADS, LDS_BYTES) != hipSuccess || per_cu < 1) { fprintf(stderr, "kernel_launch: occupancy query gave %d\n", per_cu); per_cu = 1; }
        (void)hipGetLastError();
        grid = cus * per_cu;
        if (grid > 256) grid = 256;
        fprintf(stderr, "kernel_launch: grid %d (cus %d, per_cu %d), ws need %zu of %zu\n", grid, cus, per_cu, (size_t)WS_END, ws_size);
    }
    if (grid < 0) return;
    Params p{};
    for (int i = 0; i < 24; ++i) p.in[i] = (const float*)d_in[i];
    p.out = (float*)d_out; p.ws = (unsigned char*)d_ws;
    for (int i = 0; i < 8; ++i) p.inv_freq[i] = powf(500000.0f, -(float)i / 8.0f);
#if PER_PHASE_LAUNCH
    for (int ph = 0; ph < N_PHASES; ++ph) {
        p.ph_lo = ph; p.ph_hi = ph + 1;
        hipLaunchKernelGGL(fwd_megakernel, dim3(grid), dim3(NTHREADS), LDS_BYTES, stream, p);
        { int kind, layer; decode_phase(ph, kind, layer); if ((DUP_MASK >> kind) & 1) hipLaunchKernelGGL(fwd_megakernel, dim3(grid), dim3(NTHREADS), LDS_BYTES, stream, p); }
    }
#else
    p.ph_lo = 0; p.ph_hi = N_PHASES;
    if (hipMemsetAsync((unsigned char*)d_ws + O_BAR, 0, XCD_BAR_WORDS * 4, stream) != hipSuccess) fprintf(stderr, "kernel_launch: memset failed\n");
    void* args[] = {&p};
    hipError_t e = hipLaunchCooperativeKernel((const void*)fwd_megakernel, dim3(grid), dim3(NTHREADS), args, LDS_BYTES, stream);
    if (e != hipSuccess) fprintf(stderr, "cooperative launch failed: %s (grid %d)\n", hipGetErrorString(e), grid);
#endif
}
```

```cpp
#include <hip/hip_runtime.h>
#include <hip/hip_cooperative_groups.h>
#include <cstdio>
#include <cmath>
namespace cg = cooperative_groups;
#ifndef PER_PHASE_LAUNCH
#define PER_PHASE_LAUNCH 0
#endif
__device__ __forceinline__ int tidx() { int t = threadIdx.x; asm volatile("" : "+v"(t)); return t; }
__device__ __forceinline__ int bidx() { int b = blockIdx.x; asm volatile("" : "+s"(b)); return b; }
#ifndef DUP_MASK
#define DUP_MASK 0
#endif
namespace pg8 {
#define PG8_LAS __attribute__((address_space(3)))
typedef unsigned short bf16_t;
typedef short bf16x8 __attribute__((ext_vector_type(8)));
typedef float f32x4 __attribute__((ext_vector_type(4)));
typedef unsigned u32x4 __attribute__((ext_vector_type(4)));
constexpr int BM = 256, BK = 64, HALF = 128, HTB = HALF * BK * 2  , STAGE_BYTES = 8 * HTB, NXCD = 8, WGM = 8;

__host__ __device__ __forceinline__ int lds_byte(int r, int c) { const int st = (r >> 4) * 2 + (c >> 5), rr = r & 15, cc = c & 31, ob = rr * 64 + cc * 2; return st * 1024 + (ob ^ (((ob >> 9) & 1) << 5)); }
__host__ __device__ __forceinline__ void stage_rc(int b, int& R, int& C) { const int st = b / 1024, sb = b % 1024, swz = sb ^ (((sb >> 9) & 1) << 5); R = (st >> 1) * 16 + swz / 64; C = (st & 1) * 32 + (swz % 64) / 2; }
__host__ __device__ __forceinline__ int perm32(int rho) { const int n = rho >> 4, i = rho & 15; return 8 * (i >> 2) + 4 * n + (i & 3); }

struct Unit { int pm, pn; };
struct Gemm { const bf16_t* A; const bf16_t* Bt; int M, N, K; };

struct StaticOrder {
    int nM, nN, nwg, G, c;
    __host__ __device__ void init(int M, int N, int G_, int c_) { nM = M / BM; nN = N / BM; nwg = nM * nN; G = G_; c = c_; }
    __host__ __device__ bool next(int i, Unit& u) const {
        const long L = (long)i * G + c; if (L >= nwg) return false;
        int wgid = (int)L; { const int q = nwg / NXCD, r = nwg % NXCD, xcd = wgid % NXCD, off = wgid / NXCD; wgid = (xcd < r ? xcd * (q + 1) : r * (q + 1) + (xcd - r) * q) + off; }
        const int nig = WGM * nN, gid = wgid / nig, fm = gid * WGM, gsz = (nM - fm) < WGM ? (nM - fm) : WGM;
        u.pm = fm + ((wgid % nig) % gsz); u.pn = (wgid % nig) / gsz; return true;
    }
    __device__ __forceinline__ void a_ready(const Unit&) const {}
    __device__ __forceinline__ void done(const Unit&) const {}
};
__device__ __forceinline__ unsigned cvt_pk_bf16(float lo, float hi) { unsigned r; asm volatile("v_cvt_pk_bf16_f32 %0, %1, %2" : "=v"(r) : "v"(lo), "v"(hi)); return r; }
typedef float f32x2 __attribute__((ext_vector_type(2)));

template <class Epi, class Sched, bool STAMP = false>
__device__ __forceinline__ void gemm_phase(PG8_LAS unsigned char* lds, const Gemm g, const Sched& S, const Epi& E, unsigned long long* stamps) {
    const int tid = tidx(), wid = __builtin_amdgcn_readfirstlane(tid >> 6), lane = tid & 63, wr = wid >> 2, wc = wid & 3, fr = lane & 15, fq = lane >> 4;
    const int K = g.K, nt = K / BK;
    int ts_lo = 0, ts_hi = 0, nts = 0; const unsigned long long rt_entry = STAMP ? (unsigned long long)wall_clock64() : 0ull;
#define PG8_STAMP() do { if (STAMP && wid == 0 && nts < 64) { const unsigned long long _c = (unsigned long long)clock64(); \
        ts_lo = (lane == nts) ? (int)(unsigned)_c : ts_lo; ts_hi = (lane == nts) ? (int)(unsigned)(_c >> 32) : ts_hi; ++nts; } } while (0)
    PG8_STAMP();
    unsigned voffA[2], voffB[2];
#pragma unroll
    for (int i = 0; i < 2; ++i) { int R, C; stage_rc(tid * 16 + i * 8192, R, C); const int Rb = Epi::PERM ? ((R & ~31) + perm32(R & 31)) : R;
        voffA[i] = (unsigned)(R * K + C) * 2u; voffB[i] = (unsigned)(Rb * K + C) * 2u; }
    const size_t kstep = (size_t)(BK * 2);
    const size_t hstep = (size_t)HALF * K * 2;
    const size_t tstep = 2 * hstep;
    const unsigned ldsw = (unsigned)wid * 1024u;
    const int aoff = lds_byte(wr * 64 + fr, fq * 8), boff = lds_byte(wc * 32 + fr, fq * 8);
#define PG8_SA(b, h) (((b) * 2 + (h)) * HTB)
#define PG8_SB(b, h) ((4 + (b) * 2 + (h)) * HTB)
#define PG8_STAGE(bufoff, gbase, voff) do { _Pragma("unroll") for (int _i = 0; _i < 2; ++_i) \
        __builtin_amdgcn_global_load_lds((const unsigned*)((const char*)(gbase) + (voff)[_i]), (PG8_LAS unsigned*)(lds + (bufoff) + ldsw + _i * 8192), 16, 0, 0); } while (0)
#define PG8_LDA(dst, b, h) do { _Pragma("unroll") for (int m = 0; m < 4; ++m) _Pragma("unroll") for (int k = 0; k < 2; ++k) dst[m][k] = *(const PG8_LAS bf16x8*)(lds + PG8_SA(b, h) + aoff + m * 2048 + k * 1024); } while (0)
#define PG8_LDB(dst, b, h) do { _Pragma("unroll") for (int n = 0; n < 2; ++n) _Pragma("unroll") for (int k = 0; k < 2; ++k) dst[n][k] = *(const PG8_LAS bf16x8*)(lds + PG8_SB(b, h) + boff + n * 2048 + k * 1024); } while (0)
#define PG8_MMA(ai, bj, At, Bt) do { __builtin_amdgcn_s_setprio(1); _Pragma("unroll") for (int m = 0; m < 4; ++m) _Pragma("unroll") for (int n = 0; n < 2; ++n) _Pragma("unroll") for (int k = 0; k < 2; ++k) \
        acc[ai][bj][m][n] = __builtin_amdgcn_mfma_f32_16x16x32_bf16(Bt[n][k], At[m][k], acc[ai][bj][m][n], 0, 0, 0); __builtin_amdgcn_s_setprio(0); } while (0)
#define PG8_WAIT_V(n) asm volatile("s_waitcnt vmcnt(" #n ")" ::: "memory")
#define PG8_WAIT_L(n) asm volatile("s_waitcnt lgkmcnt(" #n ")" ::: "memory")
#define PG8_BAR __builtin_amdgcn_s_barrier()
#define PG8_SCHED __builtin_amdgcn_sched_barrier(0)
    Unit cur, nxt; int ui = 0;
    if (!S.next(0, cur)) return;
    f32x4 acc[2][2][4][2];
#pragma unroll
    for (int a = 0; a < 2; ++a)
#pragma unroll
        for (int b = 0; b < 2; ++b)
#pragma unroll
            for (int m = 0; m < 4; ++m)
#pragma unroll
                for (int n = 0; n < 2; ++n) acc[a][b][m][n] = (f32x4){0.f, 0.f, 0.f, 0.f};
    bf16x8 At[4][2], B0[2][2], B1[2][2];
    const char* cA = (const char*)g.A + (size_t)cur.pm * tstep; const char* cB = (const char*)g.Bt + (size_t)cur.pn * tstep;
    S.a_ready(cur);
    PG8_STAGE(PG8_SB(0, 0), cB, voffB); PG8_STAGE(PG8_SA(0, 0), cA, voffA); PG8_STAGE(PG8_SB(0, 1), cB + hstep, voffB); PG8_STAGE(PG8_SA(0, 1), cA + hstep, voffA);
    if (wr == 1) PG8_BAR;
    PG8_WAIT_V(4); PG8_BAR;
    PG8_STAGE(PG8_SB(1, 0), cB + kstep, voffB); PG8_STAGE(PG8_SA(1, 0), cA + kstep, voffA); PG8_STAGE(PG8_SB(1, 1), cB + hstep + kstep, voffB);
    PG8_WAIT_V(6); PG8_BAR;
    PG8_STAMP();
    for (;;) {
        const bool has_next = S.next(ui + 1, nxt);
        const char* nA = has_next ? (const char*)g.A + (size_t)nxt.pm * tstep : cA; const char* nB = has_next ? (const char*)g.Bt + (size_t)nxt.pn * tstep : cB;
        for (int t = 0; t < nt; t += 2) {
            const bool last = (t == nt - 2);
            const char* a1 = cA + (size_t)(t + 1) * kstep;
            const char* a2 = last ? nA : cA + (size_t)(t + 2) * kstep; const char* b2 = last ? nB : cB + (size_t)(t + 2) * kstep;
            const char* a3 = a2 + kstep; const char* b3 = b2 + kstep;
            if (last && has_next) S.a_ready(nxt);
            PG8_LDB(B0, 0, 0); PG8_SCHED; PG8_LDA(At, 0, 0); PG8_STAGE(PG8_SA(1, 1), a1 + hstep, voffA);
            PG8_WAIT_L(8); PG8_BAR; PG8_WAIT_L(0); PG8_MMA(0, 0, At, B0); PG8_BAR; PG8_SCHED;
            PG8_LDB(B1, 0, 1); PG8_STAGE(PG8_SB(0, 0), b2, voffB);
            PG8_BAR; PG8_WAIT_L(0); PG8_MMA(0, 1, At, B1); PG8_BAR;
            PG8_LDA(At, 0, 1); PG8_STAGE(PG8_SA(0, 0), a2, voffA);
            PG8_BAR; PG8_WAIT_L(0); PG8_MMA(1, 0, At, B0); PG8_BAR; PG8_SCHED;
            PG8_STAGE(PG8_SB(0, 1), b2 + hstep, voffB);
            PG8_WAIT_V(6); PG8_BAR; PG8_MMA(1, 1, At, B1); PG8_BAR;
            PG8_LDB(B0, 1, 0); PG8_SCHED; PG8_LDA(At, 1, 0); PG8_STAGE(PG8_SA(0, 1), a2 + hstep, voffA);
            PG8_WAIT_L(8); PG8_BAR; PG8_WAIT_L(0); PG8_MMA(0, 0, At, B0); PG8_BAR; PG8_SCHED;
            PG8_LDB(B1, 1, 1); PG8_STAGE(PG8_SB(1, 0), b3, voffB);
            PG8_BAR; PG8_WAIT_L(0); PG8_MMA(0, 1, At, B1); PG8_BAR;
            PG8_LDA(At, 1, 1); PG8_STAGE(PG8_SA(1, 0), a3, voffA);
            PG8_BAR; PG8_WAIT_L(0); PG8_MMA(1, 0, At, B0); PG8_BAR; PG8_SCHED;
            PG8_STAGE(PG8_SB(1, 1), b3 + hstep, voffB);
            PG8_WAIT_V(6); PG8_BAR; PG8_MMA(1, 1, At, B1); PG8_BAR;
        }
        PG8_STAMP();
        if constexpr (!Epi::AFTER_DRAIN) { E(acc, cur, wr, wc, fr, fq); S.done(cur); }
        PG8_STAMP();
        if (!has_next) break;
#pragma unroll
        for (int a = 0; a < 2; ++a)
#pragma unroll
            for (int b = 0; b < 2; ++b)
#pragma unroll
                for (int m = 0; m < 4; ++m)
#pragma unroll
                    for (int n = 0; n < 2; ++n) acc[a][b][m][n] = (f32x4){0.f, 0.f, 0.f, 0.f};
        cur = nxt; cA = nA; cB = nB; ++ui;
    }
    PG8_WAIT_V(0);
    if (wr == 0) PG8_BAR;
    PG8_BAR;
    if constexpr (Epi::AFTER_DRAIN) { E.fused(acc, cur, wr, wc, fr, fq, lds, wid, lane); S.done(cur); }
    PG8_STAMP();
    if (STAMP && wid == 0) { stamps[lane] = lane < nts ? (((unsigned long long)(unsigned)ts_hi << 32) | (unsigned)ts_lo) : 0ull;
        if (lane == 62) stamps[62] = rt_entry; if (lane == 63) stamps[63] = (unsigned long long)wall_clock64(); }
#undef PG8_STAMP
#undef PG8_SA
#undef PG8_SB
#undef PG8_STAGE
#undef PG8_LDA
#undef PG8_LDB
#undef PG8_MMA
#undef PG8_WAIT_V
#undef PG8_WAIT_L
#undef PG8_BAR
#undef PG8_SCHED
}
}
using pg8::bf16_t; using pg8::bf16x8; using pg8::f32x4; using pg8::u32x4;
#define LAS __attribute__((address_space(3)))
typedef unsigned u32x2 __attribute__((ext_vector_type(2)));

constexpr int L_TOK = 8208, DM = 2048;
constexpr int HYB_N = 12288, DFF = 5504, DFF2 = 11008, QKV_N = 3072;
constexpr int UZ = 0, UXBC = 2048, UQ = 6144, UK = 7168, UV = 8192, UR = 10240;
constexpr float ALPHA = 1.6817928305074292f;
constexpr int NTHREADS = 512;
constexpr int LDS_MAIN = 143360;
constexpr int LDS_BYTES = LDS_MAIN + 256;

constexpr size_t al256(size_t x) { return (x + 255) & ~(size_t)255; }
constexpr size_t O_WT_HIN   = 0;
constexpr size_t O_WT_HSIDE = O_WT_HIN   + al256(2ull * 12288 * 2048 * 2);
constexpr size_t O_WT_HOUT  = O_WT_HSIDE + al256(2ull * 48 * 2048 * 2);
constexpr size_t O_WT_QKV   = O_WT_HOUT  + al256(2ull * 2048 * 4096 * 2);
constexpr size_t O_WT_SOUT  = O_WT_QKV   + al256(2ull * 3072 * 2048 * 2);
constexpr size_t O_WT_UP    = O_WT_SOUT  + al256(2ull * 2048 * 2048 * 2);
constexpr size_t O_WT_DOWN  = O_WT_UP    + al256(4ull * 11008 * 2048 * 2);
constexpr size_t O_H        = O_WT_DOWN  + al256(4ull * 2048 * 5504 * 2);
constexpr size_t O_HB       = O_H        + al256((size_t)L_TOK * 2048 * 4);
constexpr size_t O_U        = O_HB       + al256((size_t)L_TOK * 2048 * 2);
constexpr size_t O_R2       = O_U        + al256((size_t)L_TOK * 12288 * 2);
constexpr size_t GLA_ST_BYTES = 129ull * 4 * 512 * 256 * 2;
constexpr size_t O_MIX      = O_R2       + al256(2 * GLA_ST_BYTES);
constexpr size_t O_XC       = O_MIX      + al256((size_t)L_TOK * 5504 * 2);
constexpr size_t O_SIDE     = O_XC       + al256((size_t)L_TOK * 4096 * 2);
constexpr size_t O_DT       = O_SIDE     + al256((size_t)L_TOK * 64 * 4);
constexpr size_t O_ACS      = O_DT       + al256((size_t)L_TOK * 32 * 4);
constexpr size_t O_QT       = O_ACS      + al256((size_t)L_TOK * 32 * 4);
constexpr size_t O_KT       = O_QT       + al256((size_t)L_TOK * 1024 * 2);
constexpr size_t O_GLAST    = O_KT       + al256((size_t)L_TOK * 1024 * 2);
constexpr size_t O_CDEC     = O_GLAST    + al256(129ull * 1024 * 4);
constexpr size_t O_SSDLOC   = O_CDEC     + al256(65ull * 32 * 4);
constexpr size_t O_SSDPREV  = O_SSDLOC   + al256(65ull * 32 * 64 * 128 * 4);
constexpr size_t O_ROPE     = O_SSDPREV  + al256(65ull * 32 * 64 * 128 * 2);
constexpr size_t O_TAB      = O_ROPE     + al256((size_t)L_TOK * 16 * 4);
constexpr size_t O_BAR      = O_TAB      + 256;
constexpr size_t WS_END     = O_BAR      + al256(4096 * 4);
static_assert(WS_END <= 1442840576ull, "workspace too large");

struct Params {
    const float* in[24];
    float* out;
    unsigned char* ws;
    float inv_freq[8];
    int ph_lo, ph_hi;
};

struct Ctx { unsigned char* ws; float* out;
    __device__ __forceinline__ const float* in(int k) const { const size_t a = ((const size_t*)(ws + O_TAB))[k]; return (const float*)(const __attribute__((address_space(1))) float*)a; } };

__device__ __forceinline__ bf16_t f2bf(float f) { unsigned u = __float_as_uint(f); u += 0x7FFFu + ((u >> 16) & 1u); return (bf16_t)(u >> 16); }
__device__ __forceinline__ float bf2f(bf16_t b) { return __uint_as_float(((unsigned)b) << 16); }
__device__ __forceinline__ unsigned pack2(float lo, float hi) { unsigned r; asm("v_cvt_pk_bf16_f32 %0, %1, %2" : "=v"(r) : "v"(lo), "v"(hi)); return r; }
__device__ __forceinline__ float bflo(unsigned w) { return __uint_as_float(w << 16); }
__device__ __forceinline__ float bfhi(unsigned w) { return __uint_as_float(w & 0xffff0000u); }
__device__ __forceinline__ float silu_f(float x) { return x * __builtin_amdgcn_rcpf(1.f + __expf(-x)); }
__device__ __forceinline__ float wave_sum(float v) {
#pragma unroll
    for (int o = 32; o > 0; o >>= 1) v += __shfl_xor(v, o);
    return v;
}
__device__ __forceinline__ bf16x8 ldfrag(const LAS bf16_t* base, int ld, int row0, int k0, int lane) {
    return *(const LAS bf16x8*)(base + (row0 + (lane & 15)) * ld + k0 + 8 * (lane >> 4));
}
__device__ __forceinline__ bf16x8 gfrag(const bf16_t* base, size_t ld, int row0, int k0, int lane) {
    return *(const bf16x8*)(base + (size_t)(row0 + (lane & 15)) * ld + k0 + 8 * (lane >> 4));
}
typedef short s16x4 __attribute__((ext_vector_type(4)));
__device__ __forceinline__ bf16x8 ldfrag_tr(const LAS bf16_t* base, int ld, int n0, int k0, int lane) {
    const int g = lane >> 4, i = lane & 15, q = i >> 2, pp = i & 3;
    const LAS bf16_t* a = base + (k0 + 8 * g + q) * ld + n0 + 4 * pp;
    const s16x4 r1 = __builtin_amdgcn_ds_read_tr16_b64_v4i16((LAS s16x4*)a);
    const s16x4 r2 = __builtin_amdgcn_ds_read_tr16_b64_v4i16((LAS s16x4*)(a + 4 * ld));
    return __builtin_shufflevector(r1, r2, 0, 1, 2, 3, 4, 5, 6, 7);
}
#define MFMA16(a, b, c) __builtin_amdgcn_mfma_f32_16x16x32_bf16((a), (b), (c), 0, 0, 0)
#define LDS_FENCE() asm volatile("s_waitcnt lgkmcnt(0)" ::: "memory")

struct EpiStoreBf16 {
    static constexpr bool PERM = true, AFTER_DRAIN = false;
    bf16_t* O; int ldc;
    __device__ __forceinline__ void operator()(const f32x4 (&acc)[2][2][4][2], const pg8::Unit& u, int wr, int wc, int fr, int fq) const {
        const int row0 = u.pm * 256 + wr * 64 + fr, col0 = u.pn * 256 + wc * 32 + 8 * fq;
#pragma unroll
        for (int ai = 0; ai < 2; ++ai)
#pragma unroll
            for (int m = 0; m < 4; ++m) { bf16_t* rowp = O + (size_t)(row0 + ai * 128 + m * 16) * ldc + col0;
#pragma unroll
                for (int bj = 0; bj < 2; ++bj) { const f32x4 v0 = acc[ai][bj][m][0], v1 = acc[ai][bj][m][1];
                    u32x4 w; w.x = pg8::cvt_pk_bf16(v0[0], v0[1]); w.y = pg8::cvt_pk_bf16(v0[2], v0[3]); w.z = pg8::cvt_pk_bf16(v1[0], v1[1]); w.w = pg8::cvt_pk_bf16(v1[2], v1[3]);
                    *(u32x4*)(rowp + bj * 128) = w; } }
    }
    __device__ __forceinline__ void meta(int row, int col, f32x4 v) const {
        u32x2 w; w.x = pg8::cvt_pk_bf16(v[0], v[1]); w.y = pg8::cvt_pk_bf16(v[2], v[3]);
        *(u32x2*)(O + (size_t)row * ldc + col) = w;
    }
};
struct EpiResF32 {
    static constexpr bool PERM = false, AFTER_DRAIN = false;
    float* H; const bf16_t* HB;
    __device__ __forceinline__ void operator()(const f32x4 (&acc)[2][2][4][2], const pg8::Unit& u, int wr, int wc, int fr, int fq) const {
        const int row0 = u.pm * 256 + wr * 64 + fr, col0 = u.pn * 256 + wc * 32 + 4 * fq;
#pragma unroll
        for (int ai = 0; ai < 2; ++ai)
#pragma unroll
            for (int m = 0; m < 4; ++m) { const size_t ro = (size_t)(row0 + ai * 128 + m * 16) * DM + col0;
#pragma unroll
                for (int bj = 0; bj < 2; ++bj)
#pragma unroll
                    for (int n = 0; n < 2; ++n) { const size_t o = ro + bj * 128 + n * 16; const u32x2 hw = *(const u32x2*)(HB + o);
                        const f32x4 hv = {bflo(hw.x), bfhi(hw.x), bflo(hw.y), bfhi(hw.y)}; *(f32x4*)(H + o) = hv * ALPHA + acc[ai][bj][m][n]; } }
    }
    __device__ __forceinline__ void meta(int row, int col, f32x4 v) const {
        const size_t o = (size_t)row * DM + col; const u32x2 hw = *(const u32x2*)(HB + o);
        const f32x4 hv = {bflo(hw.x), bfhi(hw.x), bflo(hw.y), bfhi(hw.y)}; *(f32x4*)(H + o) = hv * ALPHA + v;
    }
};
__device__ __forceinline__ f32x4 wave_gemm16(const bf16_t* A, const bf16_t* Bt, int K, int lane) {
    f32x4 acc = {0.f, 0.f, 0.f, 0.f};
    const bf16_t* pa = A + (size_t)(lane & 15) * K + 8 * (lane >> 4);
    const bf16_t* pb = Bt + (size_t)(lane & 15) * K + 8 * (lane >> 4);
#pragma unroll 16
    for (int k0 = 0; k0 < K; k0 += 32) {
        const bf16x8 a = *(const bf16x8*)(pa + k0), b = *(const bf16x8*)(pb + k0);
        acc = MFMA16(b, a, acc);
    }
    return acc;
}
template <class Epi>
__device__ __forceinline__ void gemm_full(LAS unsigned char* lds, const bf16_t* A, const bf16_t* Bt, int N, int K, const Epi& Emeta, const Epi& Emain) {
    const int lane = tidx() & 63, wid = tidx() >> 6;
    if (N == 2048) {
        if (bidx() < 64) {
            LAS f32x4* red = (LAS f32x4*)lds;
            const int ksteps = K / 32, per = (ksteps + 7) / 8, k_lo = wid * per, k_hi = (k_lo + per < ksteps ? k_lo + per : ksteps);
#pragma unroll
            for (int t = 0; t < 2; ++t) {
                const int tile = bidx() * 2 + t;
                f32x4 acc = {0.f, 0.f, 0.f, 0.f};
                const bf16_t* pa = A + (size_t)(lane & 15) * K + 8 * (lane >> 4);
                const bf16_t* pb = Bt + (size_t)(tile * 16 + (lane & 15)) * K + 8 * (lane >> 4);
#pragma unroll 8
                for (int ks = k_lo; ks < k_hi; ++ks) acc = MFMA16(*(const bf16x8*)(pb + ks * 32), *(const bf16x8*)(pa + ks * 32), acc);
                red[(t * 8 + wid) * 64 + lane] = acc;
            }
            __syncthreads();
            if (wid < 2) {
                f32x4 s = red[(wid * 8) * 64 + lane];
#pragma unroll
                for (int w = 1; w < 8; ++w) s += red[(wid * 8 + w) * 64 + lane];
                Emeta.meta(lane & 15, (bidx() * 2 + wid) * 16 + 4 * (lane >> 4), s);
            }
            __syncthreads();
        }
    } else {
        for (int tile = ((int)gridDim.x - 1 - bidx()) * 8 + wid; tile < N / 16; tile += gridDim.x * 8) {
            const f32x4 acc = wave_gemm16(A, Bt + (size_t)tile * 16 * K, K, lane);
            Emeta.meta(lane & 15, tile * 16 + 4 * (lane >> 4), acc);
        }
    }
    pg8::Gemm g{A + (size_t)16 * K, Bt, 8192, N, K};
    pg8::StaticOrder S; S.init(8192, N, (int)gridDim.x, (int)bidx());
    pg8::gemm_phase<Epi, pg8::StaticOrder, false>(lds, g, S, Emain, nullptr);
    __syncthreads();
}
#define XB_TMO      128
#define XB_XCNT(j)  (256  + 64 * (j))
#define XB_XSUB(j)  (1280 + 64 * (j))
#define XB_XGEN(j)  (2304 + 64 * (j))
#define XB_TOP      3328
#define XB_TOPGEN   3392
#define XCD_BAR_WORDS 3456
#define XB_SPIN_CAP (1u << 18)

__device__ __forceinline__ unsigned xb_ld(unsigned* p)              { return __hip_atomic_load(p, __ATOMIC_RELAXED, __HIP_MEMORY_SCOPE_AGENT); }
__device__ __forceinline__ unsigned xb_add(unsigned* p, unsigned v) { return __hip_atomic_fetch_add(p, v, __ATOMIC_RELAXED, __HIP_MEMORY_SCOPE_AGENT); }
__device__ __forceinline__ unsigned xb_xcc_id() { return (unsigned)__builtin_amdgcn_s_getreg((3 << 11) | 20) & 0xFu; }
#define XB_SPIN(cond, bar) do { unsigned _sp = 0; while (cond) { __builtin_amdgcn_s_sleep(1); \
    if ((++_sp & 255u) == 0u) { if (xb_ld(&(bar)[XB_TMO])) break; if (_sp > XB_SPIN_CAP) { atomicAdd(&(bar)[XB_TMO], 1u); break; } } } } while (0)

struct XcdBarrier {
    unsigned* bar; unsigned x;
    volatile LAS unsigned* st;
};

__device__ __forceinline__ XcdBarrier xcd_barrier_post(unsigned* bar, volatile LAS unsigned* st) {
    XcdBarrier b; b.bar = bar; b.x = xb_xcc_id(); b.st = st;
    if (threadIdx.x == 0) (void)xb_add(&bar[XB_XCNT(b.x)], 1u);
    return b;
}
__device__ __forceinline__ void xcd_barrier_complete(unsigned* bar, unsigned x, unsigned& nloc, unsigned& nx) {
    const unsigned G = gridDim.x * gridDim.y * gridDim.z;
    unsigned sum, cnt, mine, sp = 0u;
    for (;;) {
        sum = 0u; cnt = 0u; mine = 0u;
#pragma unroll
        for (unsigned j = 0; j < 16; ++j) { const unsigned c = xb_ld(&bar[XB_XCNT(j)]); sum += c; cnt += (c > 0u) ? 1u : 0u; mine = (j == x) ? c : mine; }
        if (sum == G) break;
        __builtin_amdgcn_s_sleep(1);
        if ((++sp & 255u) == 0u) { if (xb_ld(&bar[XB_TMO])) break; if (sp > XB_SPIN_CAP) { atomicAdd(&bar[XB_TMO], 1u); break; } }
    }
    nloc = mine > 0u ? mine : 1u; nx = cnt > 0u ? cnt : 1u;
}

__device__ __forceinline__ void xcd_barrier(const XcdBarrier& b) {
    asm volatile("s_waitcnt vmcnt(0)" ::: "memory");
    __syncthreads();
    if (threadIdx.x == 0) {
        unsigned* bar = b.bar;
        __builtin_amdgcn_s_waitcnt(0);
        unsigned nloc = b.st[0], nx = b.st[1];
        if (nloc == 0u) { xcd_barrier_complete(bar, b.x, nloc, nx); b.st[0] = nloc; b.st[1] = nx; }
        const unsigned old = xb_add(&bar[XB_XSUB(b.x)], 1u);
        const unsigned gen = old / nloc;
        if (old + 1u == (gen + 1u) * nloc) {
            __builtin_amdgcn_fence(__ATOMIC_RELEASE, "agent");
            asm volatile("s_waitcnt vmcnt(0)" ::: "memory");
            const unsigned og = xb_add(&bar[XB_TOP], 1u);
            const unsigned tg = og / nx;
            if (og + 1u == (tg + 1u) * nx) xb_add(&bar[XB_TOPGEN], 1u);
            else XB_SPIN(xb_ld(&bar[XB_TOPGEN]) == tg, bar);
            __builtin_amdgcn_fence(__ATOMIC_ACQUIRE, "agent");
            xb_add(&bar[XB_XGEN(b.x)], 1u);
            asm volatile("s_waitcnt vmcnt(0)" ::: "memory");
        } else {
            XB_SPIN(xb_ld(&bar[XB_XGEN(b.x)]) == gen, bar);
            __builtin_amdgcn_fence(__ATOMIC_ACQUIRE, "agent");
            asm volatile("s_waitcnt vmcnt(0)" ::: "memory");
        }
    }
    __syncthreads();
}
struct TJob { const float* src; int ld, ncols, K; bf16_t* dst; };
__device__ __forceinline__ TJob get_job(const Params& p, int j) {
    TJob J;
    bf16_t* ws16 = (bf16_t*)p.ws;
    if (j < 10) {
        const int jj = j / 5, sub = j % 5;
        const float* base = p.in[2] + (size_t)jj * 2048 * 12336;
        bf16_t* wmain = (bf16_t*)(p.ws + O_WT_HIN) + (size_t)jj * 12288 * 2048;
        bf16_t* wside = (bf16_t*)(p.ws + O_WT_HSIDE) + (size_t)jj * 48 * 2048;
        J.ld = 12336; J.K = 2048;
        if (sub == 0)      { J.src = base;          J.ncols = 6144; J.dst = wmain; }
        else if (sub == 1) { J.src = base + 6176;   J.ncols = 4096; J.dst = wmain + (size_t)6144 * 2048; }
        else if (sub == 2) { J.src = base + 10288;  J.ncols = 2048; J.dst = wmain + (size_t)10240 * 2048; }
        else if (sub == 3) { J.src = base + 6144;   J.ncols = 32;   J.dst = wside; }
        else               { J.src = base + 10272;  J.ncols = 16;   J.dst = wside + (size_t)32 * 2048; }
    } else if (j < 12) { const int jj = j - 10; J.src = p.in[12] + (size_t)jj * 4096 * 2048; J.ld = 2048; J.ncols = 2048; J.K = 4096; J.dst = (bf16_t*)(p.ws + O_WT_HOUT) + (size_t)jj * 2048 * 4096; }
    else if (j < 14) { const int jj = j - 12; J.src = p.in[13] + (size_t)jj * 2048 * 3072; J.ld = 3072; J.ncols = 3072; J.K = 2048; J.dst = (bf16_t*)(p.ws + O_WT_QKV) + (size_t)jj * 3072 * 2048; }
    else if (j < 16) { const int jj = j - 14; J.src = p.in[15] + (size_t)jj * 2048 * 2048; J.ld = 2048; J.ncols = 2048; J.K = 2048; J.dst = (bf16_t*)(p.ws + O_WT_SOUT) + (size_t)jj * 2048 * 2048; }
    else if (j < 20) { const int l = j - 16; J.src = p.in[16] + (size_t)l * 2048 * 11008; J.ld = 11008; J.ncols = 11008; J.K = 2048; J.dst = (bf16_t*)(p.ws + O_WT_UP) + (size_t)l * 11008 * 2048; }
    else { const int l = j - 20; J.src = p.in[19] + (size_t)l * 5504 * 2048; J.ld = 2048; J.ncols = 2048; J.K = 5504; J.dst = (bf16_t*)(p.ws + O_WT_DOWN) + (size_t)l * 2048 * 5504; }
    (void)ws16;
    return J;
}
__device__ __forceinline__ void phase_prep(const Params& p, LAS unsigned char* lds) {
    const int tid = tidx();
    LAS float* ts = (LAS float*)lds;
    for (int j = 0; j < 24; ++j) {
        const TJob J = get_job(p, j);
        const int tn = (J.ncols + 127) / 128, tk = J.K / 128;
        for (int tile = bidx(); tile < tn * tk; tile += gridDim.x) {
            const int kb = tile / tn, nb = tile % tn;
            __syncthreads();
            {
                const int c4 = (tid & 31) * 4, n = nb * 128 + c4, r0 = tid >> 5;
                if (n < J.ncols) {
                    float4 v[8];
#pragma unroll
                    for (int i = 0; i < 8; ++i) v[i] = *(const float4*)(J.src + (size_t)(kb * 128 + r0 + 16 * i) * J.ld + n);
#pragma unroll
                    for (int i = 0; i < 8; ++i) { const int r = r0 + 16 * i; ts[r * 129 + c4] = v[i].x; ts[r * 129 + c4 + 1] = v[i].y; ts[r * 129 + c4 + 2] = v[i].z; ts[r * 129 + c4 + 3] = v[i].w; }
                }
            }
            __syncthreads();
            const int n = tid >> 2, kc = tid & 3;
            if (nb * 128 + n < J.ncols) {
#pragma unroll
                for (int q = 0; q < 4; ++q) {
                    const int kk = kc * 32 + q * 8;
                    u32x4 w;
                    w.x = pack2(ts[(kk + 0) * 129 + n], ts[(kk + 1) * 129 + n]);
                    w.y = pack2(ts[(kk + 2) * 129 + n], ts[(kk + 3) * 129 + n]);
                    w.z = pack2(ts[(kk + 4) * 129 + n], ts[(kk + 5) * 129 + n]);
                    w.w = pack2(ts[(kk + 6) * 129 + n], ts[(kk + 7) * 129 + n]);
                    *(u32x4*)(J.dst + (size_t)(nb * 128 + n) * J.K + kb * 128 + kk) = w;
                }
            }
        }
    }
    __syncthreads();
    const size_t gtid = (size_t)bidx() * NTHREADS + tid, gn = (size_t)gridDim.x * NTHREADS;
    float* h = (float*)(p.ws + O_H); bf16_t* hb = (bf16_t*)(p.ws + O_HB);
    for (size_t i = gtid; i < (size_t)L_TOK * 512; i += gn) {
        const int row = (int)(i >> 9), c4 = (int)(i & 511) * 4;
        const float4 v = row < 16 ? *(const float4*)(p.in[1] + (size_t)row * DM + c4) : *(const float4*)(p.in[0] + (size_t)(row - 16) * DM + c4);
        u32x2 w; w.x = pack2(v.x, v.y); w.y = pack2(v.z, v.w);
        *(u32x2*)(hb + i * 4) = w;
    }
    if (gtid < 24) ((const float**)(p.ws + O_TAB))[gtid] = p.in[gtid];
    float* rope = (float*)(p.ws + O_ROPE);
    for (size_t i = gtid; i < (size_t)L_TOK * 8; i += gn) {
        const int pos = (int)(i >> 3), f = (int)(i & 7);
        const float ang = (float)pos * p.inv_freq[f];
        double rev = (double)ang * 0.15915494309189535;
        rev -= rint(rev);
        rope[pos * 16 + f] = __builtin_amdgcn_cosf((float)rev);
        rope[pos * 16 + 8 + f] = __builtin_amdgcn_sinf((float)rev);
    }
}

__device__ __forceinline__ void phase_ln(const Ctx& p, const float* g, const float* b, bool last) {
    const int lane = tidx() & 63, wid = tidx() >> 6;
    float* h = (float*)(p.ws + O_H); bf16_t* hb = (bf16_t*)(p.ws + O_HB);
    for (int row = bidx() * 8 + wid; row < L_TOK; row += gridDim.x * 8) {
        float4 v[8]; float s = 0.f;
#pragma unroll
        for (int i = 0; i < 8; ++i) { v[i] = *(const float4*)(h + (size_t)row * DM + i * 256 + lane * 4); s += v[i].x + v[i].y + v[i].z + v[i].w; }
        const float mean = wave_sum(s) * (1.f / 2048.f);
        float q = 0.f;
#pragma unroll
        for (int i = 0; i < 8; ++i) { v[i].x -= mean; v[i].y -= mean; v[i].z -= mean; v[i].w -= mean; q += v[i].x * v[i].x + v[i].y * v[i].y + v[i].z * v[i].z + v[i].w * v[i].w; }
        const float rstd = rsqrtf(wave_sum(q) * (1.f / 2048.f) + 1e-5f);
#pragma unroll
        for (int i = 0; i < 8; ++i) {
            const int c = i * 256 + lane * 4;
            const float4 gg = *(const float4*)(g + c), bb = *(const float4*)(b + c);
            float4 y; y.x = v[i].x * rstd * gg.x + bb.x; y.y = v[i].y * rstd * gg.y + bb.y; y.z = v[i].z * rstd * gg.z + bb.z; y.w = v[i].w * rstd * gg.w + bb.w;
            if (last) { if (row >= 16) *(float4*)(p.out + (size_t)(row - 16) * DM + c) = y; }
            else { u32x2 w; w.x = pack2(y.x, y.y); w.y = pack2(y.z, y.w); *(u32x2*)(hb + (size_t)row * DM + c) = w; }
        }
    }
}

__device__ __forceinline__ void unpack8(const u32x4 w, float (&f)[8]) {
    f[0] = bflo(w.x); f[1] = bfhi(w.x); f[2] = bflo(w.y); f[3] = bfhi(w.y); f[4] = bflo(w.z); f[5] = bfhi(w.z); f[6] = bflo(w.w); f[7] = bfhi(w.w);
}
__device__ __forceinline__ void ld8f(const float* q, float (&f)[8]) {
    const float4 a = *(const float4*)q, b = *(const float4*)(q + 4);
    f[0] = a.x; f[1] = a.y; f[2] = a.z; f[3] = a.w; f[4] = b.x; f[5] = b.y; f[6] = b.z; f[7] = b.w;
}
__device__ __forceinline__ void phase_ffn_conv(const Ctx& p, int layer) {
    const bf16_t* up = (const bf16_t*)(p.ws + O_R2); bf16_t* act = (bf16_t*)(p.ws + O_MIX);
    const float* cw = p.in(17) + (size_t)layer * 3 * DFF2; const float* cb = p.in(18) + (size_t)layer * DFF2;
    const size_t gtid = (size_t)bidx() * NTHREADS + tidx(), gn = (size_t)gridDim.x * NTHREADS;
    const int nlanes = (int)(gn / 688);
    if (gtid >= (size_t)nlanes * 688) return;
    const int jb = (int)(gtid % 688), j0 = jb * 8;
    float wg[3][8], wv[3][8], bg[8], bv[8];
#pragma unroll
    for (int k = 0; k < 3; ++k) { ld8f(cw + (size_t)k * DFF2 + j0, wg[k]); ld8f(cw + (size_t)k * DFF2 + DFF + j0, wv[k]); }
    ld8f(cb + j0, bg); ld8f(cb + DFF + j0, bv);
    for (int tb = (int)(gtid / 688); tb < 1026; tb += nlanes) {
        const int t0 = tb * 8;
        u32x4 gr[10], vr[10];
#pragma unroll
        for (int r = 0; r < 10; ++r) {
            const int t = t0 - 2 + r;
            gr[r] = (u32x4){0u, 0u, 0u, 0u}; vr[r] = (u32x4){0u, 0u, 0u, 0u};
            if (t >= 0) { gr[r] = *(const u32x4*)(up + (size_t)t * DFF2 + j0); vr[r] = *(const u32x4*)(up + (size_t)t * DFF2 + DFF + j0); }
        }
        float g2[8], g1[8], v2[8], v1[8];
        unpack8(gr[0], g2); unpack8(vr[0], v2); unpack8(gr[1], g1); unpack8(vr[1], v1);
#pragma unroll
        for (int tt = 0; tt < 8; ++tt) {
            const int t = t0 + tt;
            float g0[8], v0[8], o[8];
            unpack8(gr[tt + 2], g0); unpack8(vr[tt + 2], v0);
#pragma unroll
            for (int i = 0; i < 8; ++i) {
                const float gg = bg[i] + wg[0][i] * g2[i] + wg[1][i] * g1[i] + wg[2][i] * g0[i];
                const float vv = bv[i] + wv[0][i] * v2[i] + wv[1][i] * v1[i] + wv[2][i] * v0[i];
                o[i] = silu_f(gg) * vv;
                g2[i] = g1[i]; g1[i] = g0[i]; v2[i] = v1[i]; v1[i] = v0[i];
            }
            u32x4 w; w.x = pack2(o[0], o[1]); w.y = pack2(o[2], o[3]); w.z = pack2(o[4], o[5]); w.w = pack2(o[6], o[7]);
            *(u32x4*)(act + (size_t)t * DFF + j0) = w;
        }
    }
}
__device__ __forceinline__ void phase_hyb_prep(const Ctx& p, int jj, LAS unsigned char* lds) {
    const bf16_t* u = (const bf16_t*)(p.ws + O_U);
    const float* side = (const float*)(p.ws + O_SIDE);
    const int tid = tidx(), lane = tid & 63, wid = tid >> 6;
    const size_t gtid = (size_t)bidx() * NTHREADS + tid, gn = (size_t)gridDim.x * NTHREADS;
    {
        bf16_t* xc = (bf16_t*)(p.ws + O_XC);
        const float* cw = p.in(3) + (size_t)jj * 4 * 4096; const float* cb = p.in(4) + (size_t)jj * 4096;
        for (size_t task = gtid; task < (size_t)1026 * 512; task += gn) {
            const int cbk = (int)(task & 511), tb = (int)(task >> 9), c0 = cbk * 8, t0 = tb * 8;
            float w[4][8], bb[8], x3[8], x2[8], x1[8];
#pragma unroll
            for (int k = 0; k < 4; ++k) ld8f(cw + (size_t)k * 4096 + c0, w[k]);
            ld8f(cb + c0, bb);
            u32x4 xr[11];
#pragma unroll
            for (int r = 0; r < 11; ++r) { const int t = t0 - 3 + r; xr[r] = (u32x4){0u, 0u, 0u, 0u}; if (t >= 0) xr[r] = *(const u32x4*)(u + (size_t)t * HYB_N + UXBC + c0); }
            unpack8(xr[0], x3); unpack8(xr[1], x2); unpack8(xr[2], x1);
#pragma unroll
            for (int tt = 0; tt < 8; ++tt) {
                const int t = t0 + tt;
                float x0[8], o[8];
                unpack8(xr[tt + 3], x0);
#pragma unroll
                for (int i = 0; i < 8; ++i) {
                    const float y = bb[i] + w[0][i] * x3[i] + w[1][i] * x2[i] + w[2][i] * x1[i] + w[3][i] * x0[i];
                    o[i] = silu_f(y);
                    x3[i] = x2[i]; x2[i] = x1[i]; x1[i] = x0[i];
                }
                u32x4 ww; ww.x = pack2(o[0], o[1]); ww.y = pack2(o[2], o[3]); ww.z = pack2(o[4], o[5]); ww.w = pack2(o[6], o[7]);
                *(u32x4*)(xc + (size_t)t * 4096 + c0) = ww;
            }
        }
    }
    {
        float* dt = (float*)(p.ws + O_DT); float* acs = (float*)(p.ws + O_ACS); float* cdec = (float*)(p.ws + O_CDEC);
        for (int c = bidx(); c < 65; c += gridDim.x)
        for (int head = wid; head < 32; head += 8) {
            const float bias = p.in(5)[jj * 32 + head], a = -__expf(p.in(6)[jj * 32 + head]);
            const int t0 = c * 128 - 112 + 2 * lane;
            float d0 = 0.f, d1 = 0.f;
            if (t0 >= 0) {
                const float x0 = side[(size_t)t0 * 64 + head] + bias, x1 = side[(size_t)(t0 + 1) * 64 + head] + bias;
                d0 = x0 > 20.f ? x0 : __logf(1.f + __expf(x0)); d1 = x1 > 20.f ? x1 : __logf(1.f + __expf(x1));
            }
            const float a0 = d0 * a, a1 = d1 * a;
            float s = a0 + a1;
#pragma unroll
            for (int o = 1; o < 64; o <<= 1) { const float v = __shfl_up(s, o); if (lane >= o) s += v; }
            const float ex = s - (a0 + a1);
            if (t0 >= 0) {
                dt[(size_t)t0 * 32 + head] = d0; dt[(size_t)(t0 + 1) * 32 + head] = d1;
                acs[(size_t)t0 * 32 + head] = ex + a0; acs[(size_t)(t0 + 1) * 32 + head] = s;
            }
            if (lane == 63) cdec[c * 32 + head] = __expf(s);
        }
    }
    {
        bf16_t* qt = (bf16_t*)(p.ws + O_QT); bf16_t* kt = (bf16_t*)(p.ws + O_KT); float* glast = (float*)(p.ws + O_GLAST);
        const float* w2 = p.in(9) + (size_t)jj * 16 * 1024; const float* gb = p.in(10) + (size_t)jj * 1024;
        LAS float* tot = (LAS float*)lds;
        const int d4 = tid & 15, pg = tid >> 4;
        for (int task = bidx(); task < 129 * 16; task += gridDim.x) {
            const int c = task >> 4, dbase = (task & 15) * 64 + d4 * 4, tbase = c * 64 - 48 + 2 * pg;
            f32x4 w[16];
#pragma unroll
            for (int r = 0; r < 16; ++r) w[r] = *(const f32x4*)(w2 + r * 1024 + dbase);
            const f32x4 b = *(const f32x4*)(gb + dbase);
            f32x4 g0 = {0.f, 0.f, 0.f, 0.f}, g1 = {0.f, 0.f, 0.f, 0.f};
            if (tbase >= 0) {
#pragma unroll
                for (int pos = 0; pos < 2; ++pos) {
                    const float* gl = side + (size_t)(tbase + pos) * 64 + 32;
                    f32x4 x = b;
#pragma unroll
                    for (int r4 = 0; r4 < 4; ++r4) { const f32x4 gv = *(const f32x4*)(gl + r4 * 4); x += w[r4 * 4] * gv[0] + w[r4 * 4 + 1] * gv[1] + w[r4 * 4 + 2] * gv[2] + w[r4 * 4 + 3] * gv[3]; }
                    f32x4 ls;
#pragma unroll
                    for (int e = 0; e < 4; ++e) ls[e] = (fminf(x[e], 0.f) - __logf(1.f + __expf(-fabsf(x[e])))) * (1.f / 16.f);
                    if (pos == 0) g0 = ls; else g1 = ls;
                }
            }
            __syncthreads();
            *(LAS f32x4*)(tot + pg * 64 + d4 * 4) = g0 + g1;
            __syncthreads();
            f32x4 pre = {0.f, 0.f, 0.f, 0.f};
            for (int g = 0; g < pg; ++g) pre += *(const LAS f32x4*)(tot + g * 64 + d4 * 4);
            const f32x4 gc0 = pre + g0, gc1 = gc0 + g1;
            if (tbase >= 0) {
#pragma unroll
                for (int pos = 0; pos < 2; ++pos) {
                    const f32x4 gc = pos == 0 ? gc0 : gc1;
                    const size_t t = (size_t)(tbase + pos);
                    const u32x2 qw = *(const u32x2*)(u + t * HYB_N + UQ + dbase), kw = *(const u32x2*)(u + t * HYB_N + UK + dbase);
                    const float q[4] = {bflo(qw.x), bfhi(qw.x), bflo(qw.y), bfhi(qw.y)}, k[4] = {bflo(kw.x), bfhi(kw.x), bflo(kw.y), bfhi(kw.y)};
                    u32x2 qo, ko;
                    qo.x = pack2(q[0] * 0.0625f * __expf(gc[0]), q[1] * 0.0625f * __expf(gc[1])); qo.y = pack2(q[2] * 0.0625f * __expf(gc[2]), q[3] * 0.0625f * __expf(gc[3]));
                    ko.x = pack2(k[0] * __expf(-gc[0]), k[1] * __expf(-gc[1])); ko.y = pack2(k[2] * __expf(-gc[2]), k[3] * __expf(-gc[3]));
                    *(u32x2*)(qt + t * 1024 + dbase) = qo; *(u32x2*)(kt + t * 1024 + dbase) = ko;
                }
            }
            if (pg == 31) { f32x4 e; e[0] = __expf(gc1[0]); e[1] = __expf(gc1[1]); e[2] = __expf(gc1[2]); e[3] = __expf(gc1[3]); *(f32x4*)(glast + c * 1024 + dbase) = e; }
        }
    }
}

__device__ __forceinline__ void phase_hyb_local(const Ctx& p, LAS unsigned char* lds) {
    const int tid = tidx(), lane = tid & 63, wid = tid >> 6, fr = lane & 15, fq = lane >> 4;
    const bf16_t* xc = (const bf16_t*)(p.ws + O_XC);
    const float* dt = (const float*)(p.ws + O_DT); const float* acs = (const float*)(p.ws + O_ACS);
    for (int task0 = bidx(); task0 < 65 * 8 + 129 * 16; task0 += gridDim.x) {
        bool is_ssd; int c, sub;
        if (task0 < 8) { is_ssd = true; c = 0; sub = task0; }
        else if (task0 < 24) { is_ssd = false; c = 0; sub = task0 - 8; }
        else if (task0 < 536) { is_ssd = true; c = 1 + ((task0 - 24) >> 3); sub = (task0 - 24) & 7; }
        else { is_ssd = false; c = 1 + ((task0 - 536) >> 4); sub = (task0 - 536) & 15; }
        __syncthreads();
        if (is_ssd) {
            const int g = sub, tbase = c * 128 - 112;
            LAS bf16_t* Bs = (LAS bf16_t*)lds;
            LAS bf16_t* Xs = Bs + 128 * 136;
            const int tlast = tbase + 127;
            for (int item = tid; item < 128 * 16; item += NTHREADS) {
                const int j = item >> 4, cb = item & 15, t = tbase + j;
                u32x4 w = {0u, 0u, 0u, 0u};
                if (t >= 0) w = *(const u32x4*)(xc + (size_t)t * 4096 + 2048 + g * 128 + cb * 8);
                *(LAS u32x4*)(Bs + j * 136 + cb * 8) = w;
            }
            for (int item = tid; item < 128 * 32; item += NTHREADS) {
                const int j = item >> 5, cb = item & 31, hh = cb >> 3, t = tbase + j, head = g * 4 + hh;
                u32x4 w = {0u, 0u, 0u, 0u};
                if (t >= 0) {
                    float f[8]; unpack8(*(const u32x4*)(xc + (size_t)t * 4096 + g * 256 + cb * 8), f);
                    const float sc = dt[(size_t)t * 32 + head] * __expf(acs[(size_t)tlast * 32 + head] - acs[(size_t)t * 32 + head]);
                    w.x = pack2(f[0] * sc, f[1] * sc); w.y = pack2(f[2] * sc, f[3] * sc); w.z = pack2(f[4] * sc, f[5] * sc); w.w = pack2(f[6] * sc, f[7] * sc);
                }
                *(LAS u32x4*)(Xs + j * 264 + cb * 8) = w;
            }
            __syncthreads();
            float* loc = (float*)(p.ws + O_SSDLOC) + ((size_t)c * 32 + g * 4) * 64 * 128;
            const int pt = wid & 3, nh = wid >> 2;
            for (int hh = 0; hh < 4; ++hh) {
                f32x4 acc[4];
#pragma unroll
                for (int nt = 0; nt < 4; ++nt) acc[nt] = (f32x4){0.f, 0.f, 0.f, 0.f};
#pragma unroll
                for (int ks = 0; ks < 4; ++ks) {
                    const bf16x8 xf = ldfrag_tr(Xs, 264, hh * 64 + pt * 16, ks * 32, lane);
#pragma unroll
                    for (int nt = 0; nt < 4; ++nt) { const bf16x8 bf = ldfrag_tr(Bs, 136, nh * 64 + nt * 16, ks * 32, lane); acc[nt] = MFMA16(bf, xf, acc[nt]); }
                }
#pragma unroll
                for (int nt = 0; nt < 4; ++nt) *(f32x4*)(loc + ((size_t)hh * 64 + pt * 16 + fr) * 128 + nh * 64 + nt * 16 + 4 * fq) = acc[nt];
            }
        } else {
            const int h = (sub >> 2) & 3, vs = sub & 3, tbase = c * 64 - 48;
            const bf16_t* u = (const bf16_t*)(p.ws + O_U); const bf16_t* kt = (const bf16_t*)(p.ws + O_KT);
            LAS bf16_t* Ks = (LAS bf16_t*)lds;
            LAS bf16_t* Vs = Ks + 64 * 264;
            for (int item = tid; item < 64 * 32; item += NTHREADS) {
                const int j = item >> 5, cb = item & 31, t = tbase + j;
                u32x4 w = {0u, 0u, 0u, 0u};
                if (t >= 0) w = *(const u32x4*)(kt + (size_t)t * 1024 + h * 256 + cb * 8);
                *(LAS u32x4*)(Ks + j * 264 + cb * 8) = w;
            }
            for (int item = tid; item < 64 * 16; item += NTHREADS) {
                const int j = item >> 4, cb = item & 15, t = tbase + j;
                u32x4 w = {0u, 0u, 0u, 0u};
                if (t >= 0) w = *(const u32x4*)(u + (size_t)t * HYB_N + UV + h * 512 + vs * 128 + cb * 8);
                *(LAS u32x4*)(Vs + j * 136 + cb * 8) = w;
            }
            __syncthreads();
            const float* glast = (const float*)(p.ws + O_GLAST) + c * 1024 + h * 256;
            bf16_t* kv = (bf16_t*)(p.ws + O_R2) + ((size_t)c * 4 + h) * 131072 + (size_t)(vs * 8 + wid) * 4096 + fr * 8 + (fq & 1) * 4;
            const bf16x8 vf0 = ldfrag_tr(Vs, 136, wid * 16, 0, lane), vf1 = ldfrag_tr(Vs, 136, wid * 16, 32, lane);
#pragma unroll
            for (int nt = 0; nt < 16; ++nt) {
                f32x4 acc = {0.f, 0.f, 0.f, 0.f};
                acc = MFMA16(ldfrag_tr(Ks, 264, nt * 16, 0, lane), vf0, acc);
                acc = MFMA16(ldfrag_tr(Ks, 264, nt * 16, 32, lane), vf1, acc);
                const f32x4 gl = *(const f32x4*)(glast + nt * 16 + 4 * fq);
                u32x2 w; w.x = pack2(acc[0] * gl[0], acc[1] * gl[1]); w.y = pack2(acc[2] * gl[2], acc[3] * gl[3]);
                *(u32x2*)(kv + (nt >> 1) * 512 + ((nt & 1) * 2 + (fq >> 1)) * 128) = w;
            }
        }
    }
}

__device__ __forceinline__ void phase_hyb_scan(const Ctx& p) {
    const size_t gtid = (size_t)bidx() * NTHREADS + tidx(), gn = (size_t)gridDim.x * NTHREADS;
    for (size_t task = gtid; task < 131072; task += gn) {
        if (task < 65536) {
            const size_t e = task * 4; const int head = (int)(e >> 13);
            const float* loc = (const float*)(p.ws + O_SSDLOC) + e; bf16_t* prev = (bf16_t*)(p.ws + O_SSDPREV) + e;
            const float* cdec = (const float*)(p.ws + O_CDEC) + head;
            float zz = 0.f; asm volatile("" : "+v"(zz));
            float4 run = {zz, zz, zz, zz};
            for (int c0 = 0; c0 < 65; c0 += 13) {
                float4 l[13]; float dcy[13];
#pragma unroll
                for (int i = 0; i < 13; ++i) { l[i] = *(const float4*)(loc + (size_t)(c0 + i) * 262144); dcy[i] = cdec[(c0 + i) * 32]; }
#pragma unroll
                for (int i = 0; i < 13; ++i) {
                    u32x2 w; w.x = pack2(run.x, run.y); w.y = pack2(run.z, run.w);
                    *(u32x2*)(prev + (size_t)(c0 + i) * 262144) = w;
                    run.x = run.x * dcy[i] + l[i].x; run.y = run.y * dcy[i] + l[i].y; run.z = run.z * dcy[i] + l[i].z; run.w = run.w * dcy[i] + l[i].w;
                }
            }
        } else {
            const size_t e = (task - 65536) * 8; const int h = (int)(e >> 17), ch16 = (int)((e & 131071) >> 3), d0 = ((ch16 >> 6) & 7) * 32 + ((ch16 >> 4) & 3) * 8;
            const bf16_t* kv = (const bf16_t*)(p.ws + O_R2) + e; bf16_t* sp = (bf16_t*)(p.ws + O_R2 + GLA_ST_BYTES) + e;
            const float* glast = (const float*)(p.ws + O_GLAST) + h * 256 + d0;
            float run[8]; float zz = 0.f; asm volatile("" : "+v"(zz));
#pragma unroll
            for (int i = 0; i < 8; ++i) run[i] = zz;
            for (int c0 = 0; c0 < 129; c0 += 8) {
                u32x4 lw[8]; float4 ga[8], gb2[8];
#pragma unroll
                for (int i = 0; i < 8; ++i) { const int c = c0 + i < 129 ? c0 + i : 128; lw[i] = *(const u32x4*)(kv + (size_t)c * 524288); ga[i] = *(const float4*)(glast + c * 1024); gb2[i] = *(const float4*)(glast + c * 1024 + 4); }
#pragma unroll
                for (int i = 0; i < 8; ++i) {
                    if (c0 + i < 129) {
                        float l[8]; unpack8(lw[i], l);
                        u32x4 w; w.x = pack2(run[0], run[1]); w.y = pack2(run[2], run[3]); w.z = pack2(run[4], run[5]); w.w = pack2(run[6], run[7]);
                        *(u32x4*)(sp + (size_t)(c0 + i) * 524288) = w;
                        run[0] = run[0] * ga[i].x + l[0]; run[1] = run[1] * ga[i].y + l[1]; run[2] = run[2] * ga[i].z + l[2]; run[3] = run[3] * ga[i].w + l[3];
                        run[4] = run[4] * gb2[i].x + l[4]; run[5] = run[5] * gb2[i].y + l[5]; run[6] = run[6] * gb2[i].z + l[6]; run[7] = run[7] * gb2[i].w + l[7];
                    }
                }
            }
        }
    }
}
__device__ __forceinline__ void phase_hyb_out(const Ctx& p, int jj, LAS unsigned char* lds) {
    const bf16_t* xc = (const bf16_t*)(p.ws + O_XC); const bf16_t* u = (const bf16_t*)(p.ws + O_U);
    const float* dt = (const float*)(p.ws + O_DT); const float* acs = (const float*)(p.ws + O_ACS);
    bf16_t* mix = (bf16_t*)(p.ws + O_MIX);
    for (int task0 = bidx(); task0 < 1036; task0 += gridDim.x) {
        bool is_ssd; int c, sub;
        if (task0 < 8) { is_ssd = true; c = 0; sub = task0; }
        else if (task0 < 12) { is_ssd = false; c = 0; sub = task0 - 8; }
        else if (task0 < 524) { is_ssd = true; c = 1 + ((task0 - 12) >> 3); sub = (task0 - 12) & 7; }
        else { is_ssd = false; c = 1 + ((task0 - 524) >> 2); sub = (task0 - 524) & 3; }
        const int tid = tidx(), lane = tid & 63, wid = tid >> 6, fr = lane & 15, fq = lane >> 4;
        __syncthreads();
        if (is_ssd) {
            const int g = sub, tbase = c * 128 - 112;
            LAS bf16_t* Cs = (LAS bf16_t*)lds;
            LAS bf16_t* Bs = Cs + 128 * 136;
            LAS bf16_t* Xt = Bs + 128 * 136;
            LAS bf16_t* Pv = Xt + 128 * 72;
            LAS float* Acs = (LAS float*)(Pv + 64 * 136);
            for (int item = tid; item < 128 * 32; item += NTHREADS) {
                const int j = item >> 5, cb = item & 31, t = tbase + j;
                u32x4 w = {0u, 0u, 0u, 0u};
                if (t >= 0) w = *(const u32x4*)(xc + (size_t)t * 4096 + 2048 + (cb < 16 ? 0 : 1024) + g * 128 + (cb & 15) * 8);
                *(LAS u32x4*)((cb < 16 ? Bs : Cs) + j * 136 + (cb & 15) * 8) = w;
            }
            { const int j = tid & 127, hh = tid >> 7, t = tbase + j; Acs[hh * 128 + j] = t >= 0 ? acs[(size_t)t * 32 + g * 4 + hh] : 0.f; }
            __syncthreads();
            const int i_row = wid * 16 + fr, ti = tbase + i_row;
            f32x4 cb_acc[8];
#pragma unroll
            for (int nt = 0; nt < 8; ++nt) cb_acc[nt] = (f32x4){0.f, 0.f, 0.f, 0.f};
#pragma unroll
            for (int ks = 0; ks < 4; ++ks) {
                const bf16x8 cf = ldfrag(Cs, 136, wid * 16, ks * 32, lane);
#pragma unroll
                for (int nt = 0; nt < 8; ++nt) cb_acc[nt] = MFMA16(ldfrag(Bs, 136, nt * 16, ks * 32, lane), cf, cb_acc[nt]);
            }
            f32x4 yv[4][4];
#pragma unroll
            for (int k = 0; k < 4; ++k)
#pragma unroll
                for (int pt = 0; pt < 4; ++pt) yv[k][pt] = (f32x4){0.f, 0.f, 0.f, 0.f};
            float ssq = 0.f;
#pragma unroll 1
            for (int hh = 0; hh < 4; ++hh) {
                const int head = g * 4 + hh;
                __syncthreads();
                for (int item = tid; item < 128 * 8; item += NTHREADS) {
                    const int j = item >> 3, cb = item & 7, t = tbase + j;
                    u32x4 w = {0u, 0u, 0u, 0u};
                    if (t >= 0) { float f[8]; unpack8(*(const u32x4*)(xc + (size_t)t * 4096 + head * 64 + cb * 8), f); const float sc = dt[(size_t)t * 32 + head];
                        w.x = pack2(f[0] * sc, f[1] * sc); w.y = pack2(f[2] * sc, f[3] * sc); w.z = pack2(f[4] * sc, f[5] * sc); w.w = pack2(f[6] * sc, f[7] * sc); }
                    *(LAS u32x4*)(Xt + j * 72 + cb * 8) = w;
                }
                { const bf16_t* pv = (const bf16_t*)(p.ws + O_SSDPREV) + ((size_t)c * 32 + head) * 64 * 128;
                  for (int item = tid; item < 64 * 16; item += NTHREADS) { const int pp = item >> 4, cb = item & 15; *(LAS u32x4*)(Pv + pp * 136 + cb * 8) = *(const u32x4*)(pv + pp * 128 + cb * 8); } }
                const float ai = Acs[hh * 128 + i_row];
#pragma unroll
                for (int nt = 0; nt < 8; ++nt) {
                    float m[4];
#pragma unroll
                    for (int q = 0; q < 4; ++q) { const int j = nt * 16 + 4 * fq + q; m[q] = j <= i_row ? cb_acc[nt][q] * __expf(ai - Acs[hh * 128 + j]) : 0.f; }
                    u32x2 w; w.x = pack2(m[0], m[1]); w.y = pack2(m[2], m[3]);
                    *(LAS u32x2*)(Bs + i_row * 136 + nt * 16 + 4 * fq) = w;
                }
                __syncthreads();
                f32x4 yd[4], yo[4];
#pragma unroll
                for (int pt = 0; pt < 4; ++pt) { yd[pt] = (f32x4){0.f, 0.f, 0.f, 0.f}; yo[pt] = (f32x4){0.f, 0.f, 0.f, 0.f}; }
#pragma unroll
                for (int ks = 0; ks < 4; ++ks) {
                    const bf16x8 mf = ldfrag(Bs, 136, wid * 16, ks * 32, lane), cf = ldfrag(Cs, 136, wid * 16, ks * 32, lane);
#pragma unroll
                    for (int pt = 0; pt < 4; ++pt) {
                        yd[pt] = MFMA16(ldfrag_tr(Xt, 72, pt * 16, ks * 32, lane), mf, yd[pt]);
                        yo[pt] = MFMA16(ldfrag(Pv, 136, pt * 16, ks * 32, lane), cf, yo[pt]);
                    }
                }
                const float ea = __expf(ai), dsk = p.in(7)[jj * 32 + head];
#pragma unroll
                for (int pt = 0; pt < 4; ++pt) {
                    const int ch = head * 64 + pt * 16 + 4 * fq;
                    float xs[4] = {0.f, 0.f, 0.f, 0.f}, zz[4] = {0.f, 0.f, 0.f, 0.f};
                    if (ti >= 0) {
                        const u32x2 xw = *(const u32x2*)(xc + (size_t)ti * 4096 + ch), zw = *(const u32x2*)(u + (size_t)ti * HYB_N + UZ + ch);
                        xs[0] = bflo(xw.x); xs[1] = bfhi(xw.x); xs[2] = bflo(xw.y); xs[3] = bfhi(xw.y);
                        zz[0] = bflo(zw.x); zz[1] = bfhi(zw.x); zz[2] = bflo(zw.y); zz[3] = bfhi(zw.y);
                    }
#pragma unroll
                    for (int q = 0; q < 4; ++q) { const float y = (yd[pt][q] + ea * yo[pt][q] + dsk * xs[q]) * silu_f(zz[q]); ssq += y * y;
#pragma unroll
                        for (int k = 0; k < 4; ++k) yv[k][pt][q] = (k == hh) ? y : yv[k][pt][q]; }
                }
            }
            ssq += __shfl_xor(ssq, 16); ssq += __shfl_xor(ssq, 32);
            const float rs = rsqrtf(ssq * (1.f / 256.f) + 1e-6f);
            if (ti >= 0) {
                const float* nw = p.in(8) + (size_t)jj * 2048;
#pragma unroll
                for (int hh = 0; hh < 4; ++hh)
#pragma unroll
                    for (int pt = 0; pt < 4; ++pt) {
                        const int ch = (g * 4 + hh) * 64 + pt * 16 + 4 * fq;
                        const f32x4 wv = *(const f32x4*)(nw + ch);
                        u32x2 w; w.x = pack2(yv[hh][pt][0] * rs * wv[0], yv[hh][pt][1] * rs * wv[1]); w.y = pack2(yv[hh][pt][2] * rs * wv[2], yv[hh][pt][3] * rs * wv[3]);
                        *(u32x2*)(mix + (size_t)ti * 4096 + ch) = w;
                    }
            }
        } else {
            const int h = sub, tbase = c * 64 - 48;
            const bf16_t* qt = (const bf16_t*)(p.ws + O_QT); const bf16_t* kt = (const bf16_t*)(p.ws + O_KT);
            LAS bf16_t* Qs = (LAS bf16_t*)lds;
            LAS bf16_t* Ps = Qs + 64 * 264;
            LAS float* Ssq = (LAS float*)(Ps + 64 * 72);
            LAS bf16_t* Ks = (LAS bf16_t*)(Ssq + 512);
            LAS bf16_t* Vs = Ks;
            for (int item = tid; item < 64 * 64; item += NTHREADS) {
                const int j = item >> 6, cb = item & 63, t = tbase + j;
                u32x4 w = {0u, 0u, 0u, 0u};
                if (t >= 0) w = *(const u32x4*)((cb < 32 ? qt : kt) + (size_t)t * 1024 + h * 256 + (cb & 31) * 8);
                *(LAS u32x4*)((cb < 32 ? Qs : Ks) + j * 264 + (cb & 31) * 8) = w;
            }
            u32x4 vreg[8];
#pragma unroll
            for (int r = 0; r < 8; ++r) { const int item = tid + r * NTHREADS, j = item >> 6, cb = item & 63, t = tbase + j;
                vreg[r] = (u32x4){0u, 0u, 0u, 0u};
                if (t >= 0) vreg[r] = *(const u32x4*)(u + (size_t)t * HYB_N + UV + h * 512 + cb * 8); }
            __syncthreads();
#pragma unroll
            for (int rep = 0; rep < 2; ++rep) {
                const int tix = wid + rep * 8, it = tix >> 2, jt = tix & 3;
                f32x4 acc = {0.f, 0.f, 0.f, 0.f};
                if (jt <= it) {
#pragma unroll
                    for (int ks = 0; ks < 8; ++ks) acc = MFMA16(ldfrag(Ks, 264, jt * 16, ks * 32, lane), ldfrag(Qs, 264, it * 16, ks * 32, lane), acc);
                }
                const int i = it * 16 + fr;
                float m[4];
#pragma unroll
                for (int q = 0; q < 4; ++q) { const int j = jt * 16 + 4 * fq + q; m[q] = (j <= i) ? acc[q] : 0.f; }
                u32x2 w; w.x = pack2(m[0], m[1]); w.y = pack2(m[2], m[3]);
                *(LAS u32x2*)(Ps + i * 72 + jt * 16 + 4 * fq) = w;
            }
            __syncthreads();
#pragma unroll
            for (int r = 0; r < 8; ++r) { const int item = tid + r * NTHREADS, j = item >> 6, cb = item & 63; *(LAS u32x4*)(Vs + j * 520 + cb * 8) = vreg[r]; }
            __syncthreads();
            f32x4 o[4][4];
            float ssq[4] = {0.f, 0.f, 0.f, 0.f};
            const bf16_t* sp = (const bf16_t*)(p.ws + O_R2 + GLA_ST_BYTES) + ((size_t)c * 4 + h) * 512 * 256;
#pragma unroll
            for (int vs = 0; vs < 4; ++vs) {
#pragma unroll
                for (int it = 0; it < 4; ++it) o[vs][it] = (f32x4){0.f, 0.f, 0.f, 0.f};
#pragma unroll
                for (int ks = 0; ks < 2; ++ks) {
                    const bf16x8 vf = ldfrag_tr(Vs, 520, vs * 128 + wid * 16, ks * 32, lane);
#pragma unroll
                    for (int it = 0; it < 4; ++it) o[vs][it] = MFMA16(vf, ldfrag(Ps, 72, it * 16, ks * 32, lane), o[vs][it]);
                }
                const bf16_t* spw = sp + (size_t)(vs * 8 + wid) * 4096 + lane * 8;
#pragma unroll
                for (int ks = 0; ks < 8; ++ks) {
                    const bf16x8 sf = *(const bf16x8*)(spw + ks * 512);
#pragma unroll
                    for (int it = 0; it < 4; ++it) o[vs][it] = MFMA16(sf, ldfrag(Qs, 264, it * 16, ks * 32, lane), o[vs][it]);
                }
#pragma unroll
                for (int it = 0; it < 4; ++it) ssq[it] += o[vs][it][0] * o[vs][it][0] + o[vs][it][1] * o[vs][it][1] + o[vs][it][2] * o[vs][it][2] + o[vs][it][3] * o[vs][it][3];
            }
#pragma unroll
            for (int it = 0; it < 4; ++it) { float s = ssq[it]; s += __shfl_xor(s, 16); s += __shfl_xor(s, 32); if (fq == 0) Ssq[wid * 64 + it * 16 + fr] = s; }
            __syncthreads();
            const float* nw = p.in(11) + (size_t)jj * 2048 + h * 512;
#pragma unroll
            for (int it = 0; it < 4; ++it) {
                const int i = it * 16 + fr, t = tbase + i;
                float s = 0.f;
#pragma unroll
                for (int w8 = 0; w8 < 8; ++w8) s += Ssq[w8 * 64 + i];
                const float rs = rsqrtf(s * (1.f / 512.f) + 1e-6f);
                if (t >= 0) {
#pragma unroll
                    for (int vs = 0; vs < 4; ++vs) {
                        const int v0 = vs * 128 + wid * 16 + 4 * fq;
                        const f32x4 wv = *(const f32x4*)(nw + v0);
                        const u32x2 rw = *(const u32x2*)(u + (size_t)t * HYB_N + UR + h * 512 + v0);
                        const float r0 = bflo(rw.x), r1 = bfhi(rw.x), r2 = bflo(rw.y), r3 = bfhi(rw.y);
                        u32x2 w;
                        w.x = pack2(o[vs][it][0] * rs * wv[0] * silu_f(r0), o[vs][it][1] * rs * wv[1] * silu_f(r1));
                        w.y = pack2(o[vs][it][2] * rs * wv[2] * silu_f(r2), o[vs][it][3] * rs * wv[3] * silu_f(r3));
                        *(u32x2*)(mix + (size_t)t * 4096 + 2048 + h * 512 + v0) = w;
                    }
                }
            }
        }
    }
}
__device__ __forceinline__ void rot_pair(const u32x4 a, const u32x4 b, const float* cs, u32x4& oa, u32x4& ob) {
    float x1[8], x2[8], c[8], s[8]; unpack8(a, x1); unpack8(b, x2); ld8f(cs, c); ld8f(cs + 8, s);
    float r1[8], r2[8];
#pragma unroll
    for (int i = 0; i < 8; ++i) { r1[i] = x1[i] * c[i] - x2[i] * s[i]; r2[i] = x2[i] * c[i] + x1[i] * s[i]; }
    oa.x = pack2(r1[0], r1[1]); oa.y = pack2(r1[2], r1[3]); oa.z = pack2(r1[4], r1[5]); oa.w = pack2(r1[6], r1[7]);
    ob.x = pack2(r2[0], r2[1]); ob.y = pack2(r2[2], r2[3]); ob.z = pack2(r2[4], r2[5]); ob.w = pack2(r2[6], r2[7]);
}
__device__ __forceinline__ void phase_attn(const Ctx& p, int jj, LAS unsigned char* lds) {
    const int tid = tidx(), lane = tid & 63, wid = tid >> 6, fr = lane & 15, fq = lane >> 4;
    const bf16_t* qkv = (const bf16_t*)(p.ws + O_U);
    const float* rope = (const float*)(p.ws + O_ROPE);
    bf16_t* ao = (bf16_t*)(p.ws + O_MIX);
    LAS bf16_t* Ks = (LAS bf16_t*)lds;
    LAS bf16_t* Vt = Ks + 272 * 72;
    LAS bf16_t* Pw = Vt + 64 * 280 + wid * (16 * 168);
    for (int task0 = bidx(); task0 < 520; task0 += gridDim.x) {
        const int task = task0 < 8 ? 512 + task0 : task0 - 8;
        const bool meta = task >= 512;
        const int b = meta ? 0 : (task >> 3), kh = task & 7;
        const int nkeys = meta ? 32 : 272;
        __syncthreads();
        for (int item = tid; item < nkeys * 8; item += NTHREADS) {
            const int key = item >> 3, cb = item & 7;
            const int tok = key < 16 ? key : 16 + 128 * (b - 1) + (key - 16);
            const bool valid = meta ? (key < 16) : (key < 16 || tok >= 16);
            {
                u32x4 w = {0u, 0u, 0u, 0u};
                if (valid) w = *(const u32x4*)(qkv + (size_t)tok * QKV_N + 2560 + kh * 64 + cb * 8);
                const bf16_t e[8] = {(bf16_t)(w.x & 0xffff), (bf16_t)(w.x >> 16), (bf16_t)(w.y & 0xffff), (bf16_t)(w.y >> 16), (bf16_t)(w.z & 0xffff), (bf16_t)(w.z >> 16), (bf16_t)(w.w & 0xffff), (bf16_t)(w.w >> 16)};
#pragma unroll
                for (int i = 0; i < 8; ++i) Vt[(cb * 8 + i) * 280 + key] = e[i];
            }
            if (cb == 1) continue;
            const bf16_t* src = qkv + (size_t)tok * QKV_N + 2048 + kh * 64;
            if (cb == 0) {
                u32x4 oa = {0u, 0u, 0u, 0u}, ob = {0u, 0u, 0u, 0u};
                if (valid) rot_pair(*(const u32x4*)src, *(const u32x4*)(src + 8), rope + (size_t)tok * 16, oa, ob);
                *(LAS u32x4*)(Ks + key * 72) = oa; *(LAS u32x4*)(Ks + key * 72 + 8) = ob;
            } else {
                u32x4 w = {0u, 0u, 0u, 0u};
                if (valid) w = *(const u32x4*)(src + cb * 8);
                *(LAS u32x4*)(Ks + key * 72 + cb * 8) = w;
            }
        }
        __syncthreads();
        if (meta && wid >= 4) continue;
        const int ng = meta ? 1 : 4;
        for (int gi = 0; gi < ng; ++gi) {
            const int g = meta ? wid : gi, hq = kh * 4 + g;
            const int tq = meta ? fr : 16 + 128 * b + 16 * wid + fr;
            u32x4 q0 = *(const u32x4*)(qkv + (size_t)tq * QKV_N + hq * 64 + 8 * fq), q1 = *(const u32x4*)(qkv + (size_t)tq * QKV_N + hq * 64 + 32 + 8 * fq);
            {
                u32x4 ot; ot.x = __shfl_xor((int)q0.x, 16); ot.y = __shfl_xor((int)q0.y, 16); ot.z = __shfl_xor((int)q0.z, 16); ot.w = __shfl_xor((int)q0.w, 16);
                if (fq < 2) {
                    float mine[8], oth[8], c[8], s[8]; unpack8(q0, mine); unpack8(ot, oth); ld8f(rope + (size_t)tq * 16, c); ld8f(rope + (size_t)tq * 16 + 8, s);
                    const float sg = fq == 0 ? -1.f : 1.f;
                    float r[8];
#pragma unroll
                    for (int i = 0; i < 8; ++i) r[i] = mine[i] * c[i] + sg * oth[i] * s[i];
                    q0.x = pack2(r[0], r[1]); q0.y = pack2(r[2], r[3]); q0.z = pack2(r[4], r[5]); q0.w = pack2(r[6], r[7]);
                }
            }
            const bf16x8 qa0 = __builtin_bit_cast(bf16x8, q0), qa1 = __builtin_bit_cast(bf16x8, q1);
            const float sink = p.in(14)[jj * 32 + hq];
            const int nt = meta ? 1 : 10;
            f32x4 sc[10];
            float mx = sink;
#pragma unroll
            for (int t = 0; t < 10; ++t) {
                if (t < nt) {
                    const int krow = t == 0 ? 0 : 16 + 16 * (wid + t - 1);
                    f32x4 a = {0.f, 0.f, 0.f, 0.f};
                    a = MFMA16(ldfrag(Ks, 72, krow, 0, lane), qa0, a);
                    a = MFMA16(ldfrag(Ks, 72, krow, 32, lane), qa1, a);
#pragma unroll
                    for (int j = 0; j < 4; ++j) {
                        bool vis;
                        if (t == 0) vis = meta ? (4 * fq + j <= fr) : true;
                        else { const int rel = 16 * (t - 1) + 4 * fq + j - fr; vis = rel >= 1 && rel <= 128 && (b > 0 || 16 * wid + 16 * (t - 1) + 4 * fq + j >= 128); }
                        const float v = vis ? a[j] * 0.125f : -INFINITY;
                        a[j] = v; mx = fmaxf(mx, v);
                    }
                    sc[t] = a;
                }
            }
            mx = fmaxf(mx, __shfl_xor(mx, 16)); mx = fmaxf(mx, __shfl_xor(mx, 32));
            float den = 0.f;
#pragma unroll
            for (int t = 0; t < 10; ++t) {
                if (t < nt) {
                    float e[4];
#pragma unroll
                    for (int j = 0; j < 4; ++j) { e[j] = __expf(sc[t][j] - mx); den += e[j]; }
                    u32x2 w; w.x = pack2(e[0], e[1]); w.y = pack2(e[2], e[3]);
                    *(LAS u32x2*)(Pw + fr * 168 + t * 16 + 4 * fq) = w;
                }
            }
            if (meta) { unsigned zz = 0u; asm volatile("" : "+v"(zz)); u32x2 z = {zz, zz}; *(LAS u32x2*)(Pw + fr * 168 + 16 + 4 * fq) = z; }
            den += __shfl_xor(den, 16); den += __shfl_xor(den, 32);
            den += __expf(sink - mx);
            const float rden = 1.f / den;
            LDS_FENCE();
            f32x4 oacc[4];
#pragma unroll
            for (int dtl = 0; dtl < 4; ++dtl) oacc[dtl] = (f32x4){0.f, 0.f, 0.f, 0.f};
            const int nks = meta ? 1 : 5;
#pragma unroll
            for (int ks = 0; ks < 5; ++ks) {
                if (ks < nks) {
                    const int pc = 32 * ks + 8 * fq;
                    const bf16x8 pf = *(const LAS bf16x8*)(Pw + fr * 168 + pc);
                    const int vcol = (pc < 16 || meta) ? pc : pc + 16 * wid;
#pragma unroll
                    for (int dtl = 0; dtl < 4; ++dtl) {
                        const bf16x8 vf = *(const LAS bf16x8*)(Vt + (dtl * 16 + fr) * 280 + vcol);
                        oacc[dtl] = MFMA16(vf, pf, oacc[dtl]);
                    }
                }
            }
            LDS_FENCE();
#pragma unroll
            for (int dtl = 0; dtl < 4; ++dtl) {
                u32x2 w; w.x = pack2(oacc[dtl][0] * rden, oacc[dtl][1] * rden); w.y = pack2(oacc[dtl][2] * rden, oacc[dtl][3] * rden);
                *(u32x2*)(ao + (size_t)tq * DM + hq * 64 + dtl * 16 + 4 * fq) = w;
            }
        }
    }
}
enum { K_PREP = 0, K_HIN, K_HPREP, K_HLOCAL, K_HSCAN, K_HOUT, K_GOUT, K_LN1, K_UP, K_CONV, K_DOWN, K_LN2, K_QKV, K_ATTN };
constexpr int N_PHASES = 1 + 2 * 11 + 2 * 8;
__host__ __device__ __forceinline__ void decode_phase(int ph, int& kind, int& layer) {
    if (ph == 0) { kind = K_PREP; layer = 0; return; }
    int r = ph - 1; layer = 0;
    if (r >= 19) { r -= 19; layer = 2; }
    if (r < 11) { kind = K_HIN + r; return; }
    r -= 11; layer += 1;
    kind = r == 0 ? K_QKV : (r == 1 ? K_ATTN : K_GOUT + (r - 2));
}
__global__ void __launch_bounds__(512, 2) fwd_megakernel(Params pin) {
    extern __shared__ __attribute__((aligned(16))) unsigned char shm[];
    LAS unsigned char* lds = (LAS unsigned char*)shm;
    cg::grid_group grid = cg::this_grid();
    volatile LAS unsigned* xst = (volatile LAS unsigned*)(lds + LDS_MAIN);
    if (threadIdx.x == 0) { xst[0] = 0u; xst[1] = 0u; }
    __syncthreads();
    XcdBarrier xb = xcd_barrier_post((unsigned*)(pin.ws + O_BAR), xst);
    if (pin.ph_lo == 0) { phase_prep(pin, lds); if (pin.ph_hi > 1) grid.sync(); }
    for (int ph = pin.ph_lo < 1 ? 1 : pin.ph_lo; ph < pin.ph_hi; ++ph) {
        Ctx p; { unsigned lo = (unsigned)(size_t)pin.ws, hi = (unsigned)((size_t)pin.ws >> 32); asm volatile("" : "+s"(lo), "+s"(hi)); p.ws = (unsigned char*)(__attribute__((address_space(1))) unsigned char*)(((size_t)hi << 32) | lo); p.out = pin.out; }
        ph = __builtin_amdgcn_readfirstlane(ph);
        int kind, layer; decode_phase(ph, kind, layer);
        const int jj = layer >> 1;
        bf16_t* hb = (bf16_t*)(p.ws + O_HB); float* h = (float*)(p.ws + O_H);
        bf16_t* mix = (bf16_t*)(p.ws + O_MIX);
        switch (kind) {
        case K_HIN: case K_QKV: case K_UP: {
            const bf16_t* w; bf16_t* O; int N;
            if (kind == K_HIN) { w = (const bf16_t*)(p.ws + O_WT_HIN) + (size_t)jj * 12288 * 2048; O = (bf16_t*)(p.ws + O_U); N = HYB_N;
                const int lane = tidx() & 63, wid = tidx() >> 6; const bf16_t* ws_ = (const bf16_t*)(p.ws + O_WT_HSIDE) + (size_t)jj * 48 * 2048; float* side = (float*)(p.ws + O_SIDE);
                for (int rt = bidx() * 8 + wid; rt < 513; rt += gridDim.x * 8) {
                    f32x4 a0 = {0.f, 0.f, 0.f, 0.f}, a1 = {0.f, 0.f, 0.f, 0.f}, a2 = {0.f, 0.f, 0.f, 0.f};
                    const bf16_t* pa = hb + (size_t)(rt * 16 + (lane & 15)) * 2048 + 8 * (lane >> 4);
                    const bf16_t* pb = ws_ + (size_t)(lane & 15) * 2048 + 8 * (lane >> 4);
#pragma unroll 8
                    for (int k0 = 0; k0 < 2048; k0 += 32) {
                        const bf16x8 a = *(const bf16x8*)(pa + k0);
                        a0 = MFMA16(*(const bf16x8*)(pb + k0), a, a0); a1 = MFMA16(*(const bf16x8*)(pb + 16 * 2048 + k0), a, a1); a2 = MFMA16(*(const bf16x8*)(pb + 32 * 2048 + k0), a, a2);
                    }
                    float* sr = side + (size_t)(rt * 16 + (lane & 15)) * 64 + 4 * (lane >> 4);
                    *(f32x4*)sr = a0; *(f32x4*)(sr + 16) = a1; *(f32x4*)(sr + 32) = a2; }
            } else if (kind == K_QKV) { w = (const bf16_t*)(p.ws + O_WT_QKV) + (size_t)jj * 3072 * 2048; O = (bf16_t*)(p.ws + O_U); N = QKV_N; }
            else { w = (const bf16_t*)(p.ws + O_WT_UP) + (size_t)layer * 11008 * 2048; O = (bf16_t*)(p.ws + O_R2); N = DFF2; }
            EpiStoreBf16 em{O, N}, e{O + (size_t)16 * N, N};
            gemm_full(lds, hb, w, N, 2048, em, e);
        } break;
        case K_GOUT: case K_DOWN: {
            const bf16_t* w; int K;
            if (kind == K_DOWN) { w = (const bf16_t*)(p.ws + O_WT_DOWN) + (size_t)layer * 2048 * 5504; K = DFF; }
            else if ((layer & 1) == 0) { w = (const bf16_t*)(p.ws + O_WT_HOUT) + (size_t)jj * 2048 * 4096; K = 4096; }
            else { w = (const bf16_t*)(p.ws + O_WT_SOUT) + (size_t)jj * 2048 * 2048; K = 2048; }
            EpiResF32 em{h, hb}, e{h + (size_t)16 * DM, hb + (size_t)16 * DM};
            gemm_full(lds, mix, w, 2048, K, em, e);
        } break;
        case K_HPREP: phase_hyb_prep(p, jj, lds); break;
        case K_HLOCAL: phase_hyb_local(p, lds); break;
        case K_HSCAN: phase_hyb_scan(p); break;
        case K_HOUT: phase_hyb_out(p, jj, lds); break;
        case K_ATTN: phase_attn(p, jj, lds); break;
        case K_LN1: phase_ln(p, p.in(20) + (size_t)layer * DM, p.in(21) + (size_t)layer * DM, false); break;
        case K_LN2: phase_ln(p, p.in(22) + (size_t)layer * DM, p.in(23) + (size_t)layer * DM, layer == 3); break;
        case K_CONV: phase_ffn_conv(p, layer); break;
        default: break;
        }
        if (ph + 1 < pin.ph_hi) xcd_barrier(xb);
    }
}

extern "C" void kernel_launch(void* const* d_in, const int* in_sizes, int n_in, void* d_out, int out_size, void* d_ws, size_t ws_size, hipStream_t stream) {
    static int grid = 0;
    if (grid == 0) {
        if (n_in != 24 || ws_size < WS_END) { fprintf(stderr, "kernel_launch: unexpected inputs (n_in %d, ws %zu, need %zu)\n", n_in, ws_size, (size_t)WS_END); grid = -1; return; }
        int dev = 0, cus = 0, per_cu = 0;
        (void)hipGetDevice(&dev);
        (void)hipDeviceGetAttribute(&cus, hipDeviceAttributeMultiprocessorCount, dev);
        if (hipFuncSetAttribute((const void*)fwd_megakernel, hipFuncAttributeMaxDynamicSharedMemorySize, LDS_BYTES) != hipSuccess) { fprintf(stderr, "kernel_launch: hipFuncSetAttribute failed\n"); grid = -1; return; }
        if (hipOccupancyMaxActiveBlocksPerMultiprocessor(&per_cu, (const void*)fwd_megakernel, NTHREADS, LDS_BYTES) != hipSuccess || per_cu < 1) { fprintf(stderr, "kernel_launch: occupancy query gave %d\n", per_cu); per_cu = 1; }
        (void)hipGetLastError();
        grid = cus * per_cu;
        if (grid > 256) grid = 256;
        fprintf(stderr, "kernel_launch: grid %d (cus %d, per_cu %d), ws need %zu of %zu\n", grid, cus, per_cu, (size_t)WS_END, ws_size);
    }
    if (grid < 0) return;
    Params p{};
    for (int i = 0; i < 24; ++i) p.in[i] = (const float*)d_in[i];
    p.out = (float*)d_out; p.ws = (unsigned char*)d_ws;
    for (int i = 0; i < 8; ++i) p.inv_freq[i] = powf(500000.0f, -(float)i / 8.0f);
#if PER_PHASE_LAUNCH
    for (int ph = 0; ph < N_PHASES; ++ph) {
        p.ph_lo = ph; p.ph_hi = ph + 1;
        hipLaunchKernelGGL(fwd_megakernel, dim3(grid), dim3(NTHREADS), LDS_BYTES, stream, p);
        { int kind, layer; decode_phase(ph, kind, layer); if ((DUP_MASK >> kind) & 1) hipLaunchKernelGGL(fwd_megakernel, dim3(grid), dim3(NTHREADS), LDS_BYTES, stream, p); }
    }
#else
    p.ph_lo = 0; p.ph_hi = N_PHASES;
    if (hipMemsetAsync((unsigned char*)d_ws + O_BAR, 0, XCD_BAR_WORDS * 4, stream) != hipSuccess) fprintf(stderr, "kernel_launch: memset failed\n");
    void* args[] = {&p};
    hipError_t e = hipLaunchCooperativeKernel((const void*)fwd_megakernel, dim3(grid), dim3(NTHREADS), args, LDS_BYTES, stream);
    if (e != hipSuccess) fprintf(stderr, "cooperative launch failed: %s (grid %d)\n", hipGetErrorString(e), grid);
#endif
}
```

```cpp
#include <hip/hip_runtime.h>
#include <hip/hip_cooperative_groups.h>
#include <cstdio>
#include <cmath>
namespace cg = cooperative_groups;
#ifndef PER_PHASE_LAUNCH
#define PER_PHASE_LAUNCH 0
#endif
__device__ __forceinline__ int tidx() { int t = threadIdx.x; asm volatile("" : "+v"(t)); return t; }
__device__ __forceinline__ int bidx() { int b = blockIdx.x; asm volatile("" : "+s"(b)); return b; }
#ifndef DUP_MASK
#define DUP_MASK 0
#endif
namespace pg8 {
#define PG8_LAS __attribute__((address_space(3)))
typedef unsigned short bf16_t;
typedef short bf16x8 __attribute__((ext_vector_type(8)));
typedef float f32x4 __attribute__((ext_vector_type(4)));
typedef unsigned u32x4 __attribute__((ext_vector_type(4)));
constexpr int BM = 256, BK = 64, HALF = 128, HTB = HALF * BK * 2  , STAGE_BYTES = 8 * HTB, NXCD = 8, WGM = 8;

__host__ __device__ __forceinline__ int lds_byte(int r, int c) { const int st = (r >> 4) * 2 + (c >> 5), rr = r & 15, cc = c & 31, ob = rr * 64 + cc * 2; return st * 1024 + (ob ^ (((ob >> 9) & 1) << 5)); }
__host__ __device__ __forceinline__ void stage_rc(int b, int& R, int& C) { const int st = b / 1024, sb = b % 1024, swz = sb ^ (((sb >> 9) & 1) << 5); R = (st >> 1) * 16 + swz / 64; C = (st & 1) * 32 + (swz % 64) / 2; }
__host__ __device__ __forceinline__ int perm32(int rho) { const int n = rho >> 4, i = rho & 15; return 8 * (i >> 2) + 4 * n + (i & 3); }

struct Unit { int pm, pn; };
struct Gemm { const bf16_t* A; const bf16_t* Bt; int M, N, K; };

struct StaticOrder {
    int nM, nN, nwg, G, c;
    __host__ __device__ void init(int M, int N, int G_, int c_) { nM = M / BM; nN = N / BM; nwg = nM * nN; G = G_; c = c_; }
    __host__ __device__ bool next(int i, Unit& u) const {
        const long L = (long)i * G + c; if (L >= nwg) return false;
        int wgid = (int)L; { const int q = nwg / NXCD, r = nwg % NXCD, xcd = wgid % NXCD, off = wgid / NXCD; wgid = (xcd < r ? xcd * (q + 1) : r * (q + 1) + (xcd - r) * q) + off; }
        const int nig = WGM * nN, gid = wgid / nig, fm = gid * WGM, gsz = (nM - fm) < WGM ? (nM - fm) : WGM;
        u.pm = fm + ((wgid % nig) % gsz); u.pn = (wgid % nig) / gsz; return true;
    }
    __device__ __forceinline__ void a_ready(const Unit&) const {}
    __device__ __forceinline__ void done(const Unit&) const {}
};
__device__ __forceinline__ unsigned cvt_pk_bf16(float lo, float hi) { unsigned r; asm volatile("v_cvt_pk_bf16_f32 %0, %1, %2" : "=v"(r) : "v"(lo), "v"(hi)); return r; }
typedef float f32x2 __attribute__((ext_vector_type(2)));

template <class Epi, class Sched, bool STAMP = false>
__device__ __forceinline__ void gemm_phase(PG8_LAS unsigned char* lds, const Gemm g, const Sched& S, const Epi& E, unsigned long long* stamps) {
    const int tid = tidx(), wid = __builtin_amdgcn_readfirstlane(tid >> 6), lane = tid & 63, wr = wid >> 2, wc = wid & 3, fr = lane & 15, fq = lane >> 4;
    const int K = g.K, nt = K / BK;
    int ts_lo = 0, ts_hi = 0, nts = 0; const unsigned long long rt_entry = STAMP ? (unsigned long long)wall_clock64() : 0ull;
#define PG8_STAMP() do { if (STAMP && wid == 0 && nts < 64) { const unsigned long long _c = (unsigned long long)clock64(); \
        ts_lo = (lane == nts) ? (int)(unsigned)_c : ts_lo; ts_hi = (lane == nts) ? (int)(unsigned)(_c >> 32) : ts_hi; ++nts; } } while (0)
    PG8_STAMP();
    unsigned voffA[2], voffB[2];
#pragma unroll
    for (int i = 0; i < 2; ++i) { int R, C; stage_rc(tid * 16 + i * 8192, R, C); const int Rb = Epi::PERM ? ((R & ~31) + perm32(R & 31)) : R;
        voffA[i] = (unsigned)(R * K + C) * 2u; voffB[i] = (unsigned)(Rb * K + C) * 2u; }
    const size_t kstep = (size_t)(BK * 2);
    const size_t hstep = (size_t)HALF * K * 2;
    const size_t tstep = 2 * hstep;
    const unsigned ldsw = (unsigned)wid * 1024u;
    const int aoff = lds_byte(wr * 64 + fr, fq * 8), boff = lds_byte(wc * 32 + fr, fq * 8);
#define PG8_SA(b, h) (((b) * 2 + (h)) * HTB)
#define PG8_SB(b, h) ((4 + (b) * 2 + (h)) * HTB)
#define PG8_STAGE(bufoff, gbase, voff) do { _Pragma("unroll") for (int _i = 0; _i < 2; ++_i) \
        __builtin_amdgcn_global_load_lds((const unsigned*)((const char*)(gbase) + (voff)[_i]), (PG8_LAS unsigned*)(lds + (bufoff) + ldsw + _i * 8192), 16, 0, 0); } while (0)
#define PG8_LDA(dst, b, h) do { _Pragma("unroll") for (int m = 0; m < 4; ++m) _Pragma("unroll") for (int k = 0; k < 2; ++k) dst[m][k] = *(const PG8_LAS bf16x8*)(lds + PG8_SA(b, h) + aoff + m * 2048 + k * 1024); } while (0)
#define PG8_LDB(dst, b, h) do { _Pragma("unroll") for (int n = 0; n < 2; ++n) _Pragma("unroll") for (int k = 0; k < 2; ++k) dst[n][k] = *(const PG8_LAS bf16x8*)(lds + PG8_SB(b, h) + boff + n * 2048 + k * 1024); } while (0)
#define PG8_MMA(ai, bj, At, Bt) do { __builtin_amdgcn_s_setprio(1); _Pragma("unroll") for (int m = 0; m < 4; ++m) _Pragma("unroll") for (int n = 0; n < 2; ++n) _Pragma("unroll") for (int k = 0; k < 2; ++k) \
        acc[ai][bj][m][n] = __builtin_amdgcn_mfma_f32_16x16x32_bf16(Bt[n][k], At[m][k], acc[ai][bj][m][n], 0, 0, 0); __builtin_amdgcn_s_setprio(0); } while (0)
#define PG8_WAIT_V(n) asm volatile("s_waitcnt vmcnt(" #n ")" ::: "memory")
#define PG8_WAIT_L(n) asm volatile("s_waitcnt lgkmcnt(" #n ")" ::: "memory")
#define PG8_BAR __builtin_amdgcn_s_barrier()
#define PG8_SCHED __builtin_amdgcn_sched_barrier(0)
    Unit cur, nxt; int ui = 0;
    if (!S.next(0, cur)) return;
    f32x4 acc[2][2][4][2];
#pragma unroll
    for (int a = 0; a < 2; ++a)
#pragma unroll
        for (int b = 0; b < 2; ++b)
#pragma unroll
            for (int m = 0; m < 4; ++m)
#pragma unroll
                for (int n = 0; n < 2; ++n) acc[a][b][m][n] = (f32x4){0.f, 0.f, 0.f, 0.f};
    bf16x8 At[4][2], B0[2][2], B1[2][2];
    const char* cA = (const char*)g.A + (size_t)cur.pm * tstep; const char* cB = (const char*)g.Bt + (size_t)cur.pn * tstep;
    S.a_ready(cur);
    PG8_STAGE(PG8_SB(0, 0), cB, voffB); PG8_STAGE(PG8_SA(0, 0), cA, voffA); PG8_STAGE(PG8_SB(0, 1), cB + hstep, voffB); PG8_STAGE(PG8_SA(0, 1), cA + hstep, voffA);
    if (wr == 1) PG8_BAR;
    PG8_WAIT_V(4); PG8_BAR;
    PG8_STAGE(PG8_SB(1, 0), cB + kstep, voffB); PG8_STAGE(PG8_SA(1, 0), cA + kstep, voffA); PG8_STAGE(PG8_SB(1, 1), cB + hstep + kstep, voffB);
    PG8_WAIT_V(6); PG8_BAR;
    PG8_STAMP();
    for (;;) {
        const bool has_next = S.next(ui + 1, nxt);
        const char* nA = has_next ? (const char*)g.A + (size_t)nxt.pm * tstep : cA; const char* nB = has_next ? (const char*)g.Bt + (size_t)nxt.pn * tstep : cB;
        for (int t = 0; t < nt; t += 2) {
            const bool last = (t == nt - 2);
            const char* a1 = cA + (size_t)(t + 1) * kstep;
            const char* a2 = last ? nA : cA + (size_t)(t + 2) * kstep; const char* b2 = last ? nB : cB + (size_t)(t + 2) * kstep;
            const char* a3 = a2 + kstep; const char* b3 = b2 + kstep;
            if (last && has_next) S.a_ready(nxt);
            PG8_LDB(B0, 0, 0); PG8_SCHED; PG8_LDA(At, 0, 0); PG8_STAGE(PG8_SA(1, 1), a1 + hstep, voffA);
            PG8_WAIT_L(8); PG8_BAR; PG8_WAIT_L(0); PG8_MMA(0, 0, At, B0); PG8_BAR; PG8_SCHED;
            PG8_LDB(B1, 0, 1); PG8_STAGE(PG8_SB(0, 0), b2, voffB);
            PG8_BAR; PG8_WAIT_L(0); PG8_MMA(0, 1, At, B1); PG8_BAR;
            PG8_LDA(At, 0, 1); PG8_STAGE(PG8_SA(0, 0), a2, voffA);
            PG8_BAR; PG8_WAIT_L(0); PG8_MMA(1, 0, At, B0); PG8_BAR; PG8_SCHED;
            PG8_STAGE(PG8_SB(0, 1), b2 + hstep, voffB);
            PG8_WAIT_V(6); PG8_BAR; PG8_MMA(1, 1, At, B1); PG8_BAR;
            PG8_LDB(B0, 1, 0); PG8_SCHED; PG8_LDA(At, 1, 0); PG8_STAGE(PG8_SA(0, 1), a2 + hstep, voffA);
            PG8_WAIT_L(8); PG8_BAR; PG8_WAIT_L(0); PG8_MMA(0, 0, At, B0); PG8_BAR; PG8_SCHED;
            PG8_LDB(B1, 1, 1); PG8_STAGE(PG8_SB(1, 0), b3, voffB);
            PG8_BAR; PG8_WAIT_L(0); PG8_MMA(0, 1, At, B1); PG8_BAR;
            PG8_LDA(At, 1, 1); PG8_STAGE(PG8_SA(1, 0), a3, voffA);
            PG8_BAR; PG8_WAIT_L(0); PG8_MMA(1, 0, At, B0); PG8_BAR; PG8_SCHED;
            PG8_STAGE(PG8_SB(1, 1), b3 + hstep, voffB);
            PG8_WAIT_V(6); PG8_BAR; PG8_MMA(1, 1, At, B1); PG8_BAR;
        }
        PG8_STAMP();
        if constexpr (!Epi::AFTER_DRAIN) { E(acc, cur, wr, wc, fr, fq); S.done(cur); }
        PG8_STAMP();
        if (!has_next) break;
#pragma unroll
        for (int a = 0; a < 2; ++a)
#pragma unroll
            for (int b = 0; b < 2; ++b)
#pragma unroll
                for (int m = 0; m < 4; ++m)
#pragma unroll
                    for (int n = 0; n < 2; ++n) acc[a][b][m][n] = (f32x4){0.f, 0.f, 0.f, 0.f};
        cur = nxt; cA = nA; cB = nB; ++ui;
    }
    PG8_WAIT_V(0);
    if (wr == 0) PG8_BAR;
    PG8_BAR;
    if constexpr (Epi::AFTER_DRAIN) { E.fused(acc, cur, wr, wc, fr, fq, lds, wid, lane); S.done(cur); }
    PG8_STAMP();
    if (STAMP && wid == 0) { stamps[lane] = lane < nts ? (((unsigned long long)(unsigned)ts_hi << 32) | (unsigned)ts_lo) : 0ull;
        if (lane == 62) stamps[62] = rt_entry; if (lane == 63) stamps[63] = (unsigned long long)wall_clock64(); }
#undef PG8_STAMP
#undef PG8_SA
#undef PG8_SB
#undef PG8_STAGE
#undef PG8_LDA
#undef PG8_LDB
#undef PG8_MMA
#undef PG8_WAIT_V
#undef PG8_WAIT_L
#undef PG8_BAR
#undef PG8_SCHED
}
}
using pg8::bf16_t; using pg8::bf16x8; using pg8::f32x4; using pg8::u32x4;
#define LAS __attribute__((address_space(3)))
typedef unsigned u32x2 __attribute__((ext_vector_type(2)));

constexpr int L_TOK = 8208, DM = 2048;
constexpr int HYB_N = 12288, DFF = 5504, DFF2 = 11008, QKV_N = 3072;
constexpr int UZ = 0, UXBC = 2048, UQ = 6144, UK = 7168, UV = 8192, UR = 10240;
constexpr float ALPHA = 1.6817928305074292f;
constexpr int NTHREADS = 512;
constexpr int LDS_MAIN = 143360;
constexpr int LDS_BYTES = LDS_MAIN + 256;

constexpr size_t al256(size_t x) { return (x + 255) & ~(size_t)255; }
constexpr size_t O_WT_HIN   = 0;
constexpr size_t O_WT_HSIDE = O_WT_HIN   + al256(2ull * 12288 * 2048 * 2);
constexpr size_t O_WT_HOUT  = O_WT_HSIDE + al256(2ull * 48 * 2048 * 2);
constexpr size_t O_WT_QKV   = O_WT_HOUT  + al256(2ull * 2048 * 4096 * 2);
constexpr size_t O_WT_SOUT  = O_WT_QKV   + al256(2ull * 3072 * 2048 * 2);
constexpr size_t O_WT_UP    = O_WT_SOUT  + al256(2ull * 2048 * 2048 * 2);
constexpr size_t O_WT_DOWN  = O_WT_UP    + al256(4ull * 11008 * 2048 * 2);
constexpr size_t O_H        = O_WT_DOWN  + al256(4ull * 2048 * 5504 * 2);
constexpr size_t O_HB       = O_H        + al256((size_t)L_TOK * 2048 * 4);
constexpr size_t O_U        = O_HB       + al256((size_t)L_TOK * 2048 * 2);
constexpr size_t O_R2       = O_U        + al256((size_t)L_TOK * 12288 * 2);
constexpr size_t GLA_ST_BYTES = 129ull * 4 * 512 * 256 * 2;
constexpr size_t O_MIX      = O_R2       + al256(2 * GLA_ST_BYTES);
constexpr size_t O_XC       = O_MIX      + al256((size_t)L_TOK * 5504 * 2);
constexpr size_t O_SIDE     = O_XC       + al256((size_t)L_TOK * 4096 * 2);
constexpr size_t O_DT       = O_SIDE     + al256((size_t)L_TOK * 64 * 4);
constexpr size_t O_ACS      = O_DT       + al256((size_t)L_TOK * 32 * 4);
constexpr size_t O_QT       = O_ACS      + al256((size_t)L_TOK * 32 * 4);
constexpr size_t O_KT       = O_QT       + al256((size_t)L_TOK * 1024 * 2);
constexpr size_t O_GLAST    = O_KT       + al256((size_t)L_TOK * 1024 * 2);
constexpr size_t O_CDEC     = O_GLAST    + al256(129ull * 1024 * 4);
constexpr size_t O_SSDLOC   = O_CDEC     + al256(65ull * 32 * 4);
constexpr size_t O_SSDPREV  = O_SSDLOC   + al256(65ull * 32 * 64 * 128 * 4);
constexpr size_t O_ROPE     = O_SSDPREV  + al256(65ull * 32 * 64 * 128 * 2);
constexpr size_t O_TAB      = O_ROPE     + al256((size_t)L_TOK * 16 * 4);
constexpr size_t O_BAR      = O_TAB      + 256;
constexpr size_t WS_END     = O_BAR      + al256(4096 * 4);
static_assert(WS_END <= 1442840576ull, "workspace too large");

struct Params {
    const float* in[24];
    float* out;
    unsigned char* ws;
    float inv_freq[8];
    int ph_lo, ph_hi;
};

struct Ctx { unsigned char* ws; float* out;
    __device__ __forceinline__ const float* in(int k) const { const size_t a = ((const size_t*)(ws + O_TAB))[k]; return (const float*)(const __attribute__((address_space(1))) float*)a; } };

__device__ __forceinline__ bf16_t f2bf(float f) { unsigned u = __float_as_uint(f); u += 0x7FFFu + ((u >> 16) & 1u); return (bf16_t)(u >> 16); }
__device__ __forceinline__ float bf2f(bf16_t b) { return __uint_as_float(((unsigned)b) << 16); }
__device__ __forceinline__ unsigned pack2(float lo, float hi) { unsigned r; asm("v_cvt_pk_bf16_f32 %0, %1, %2" : "=v"(r) : "v"(lo), "v"(hi)); return r; }
__device__ __forceinline__ float bflo(unsigned w) { return __uint_as_float(w << 16); }
__device__ __forceinline__ float bfhi(unsigned w) { return __uint_as_float(w & 0xffff0000u); }
__device__ __forceinline__ float silu_f(float x) { return x * __builtin_amdgcn_rcpf(1.f + __expf(-x)); }
__device__ __forceinline__ float wave_sum(float v) {
#pragma unroll
    for (int o = 32; o > 0; o >>= 1) v += __shfl_xor(v, o);
    return v;
}
__device__ __forceinline__ bf16x8 ldfrag(const LAS bf16_t* base, int ld, int row0, int k0, int lane) {
    return *(const LAS bf16x8*)(base + (row0 + (lane & 15)) * ld + k0 + 8 * (lane >> 4));
}
__device__ __forceinline__ bf16x8 gfrag(const bf16_t* base, size_t ld, int row0, int k0, int lane) {
    return *(const bf16x8*)(base + (size_t)(row0 + (lane & 15)) * ld + k0 + 8 * (lane >> 4));
}
typedef short s16x4 __attribute__((ext_vector_type(4)));
__device__ __forceinline__ bf16x8 ldfrag_tr(const LAS bf16_t* base, int ld, int n0, int k0, int lane) {
    const int g = lane >> 4, i = lane & 15, q = i >> 2, pp = i & 3;
    const LAS bf16_t* a = base + (k0 + 8 * g + q) * ld + n0 + 4 * pp;
    const s16x4 r1 = __builtin_amdgcn_ds_read_tr16_b64_v4i16((LAS s16x4*)a);
    const s16x4 r2 = __builtin_amdgcn_ds_read_tr16_b64_v4i16((LAS s16x4*)(a + 4 * ld));
    return __builtin_shufflevector(r1, r2, 0, 1, 2, 3, 4, 5, 6, 7);
}
#define MFMA16(a, b, c) __builtin_amdgcn_mfma_f32_16x16x32_bf16((a), (b), (c), 0, 0, 0)
#define LDS_FENCE() asm volatile("s_waitcnt lgkmcnt(0)" ::: "memory")

struct EpiStoreBf16 {
    static constexpr bool PERM = true, AFTER_DRAIN = false;
    bf16_t* O; int ldc;
    __device__ __forceinline__ void operator()(const f32x4 (&acc)[2][2][4][2], const pg8::Unit& u, int wr, int wc, int fr, int fq) const {
        const int row0 = u.pm * 256 + wr * 64 + fr, col0 = u.pn * 256 + wc * 32 + 8 * fq;
#pragma unroll
        for (int ai = 0; ai < 2; ++ai)
#pragma unroll
            for (int m = 0; m < 4; ++m) { bf16_t* rowp = O + (size_t)(row0 + ai * 128 + m * 16) * ldc + col0;
#pragma unroll
                for (int bj = 0; bj < 2; ++bj) { const f32x4 v0 = acc[ai][bj][m][0], v1 = acc[ai][bj][m][1];
                    u32x4 w; w.x = pg8::cvt_pk_bf16(v0[0], v0[1]); w.y = pg8::cvt_pk_bf16(v0[2], v0[3]); w.z = pg8::cvt_pk_bf16(v1[0], v1[1]); w.w = pg8::cvt_pk_bf16(v1[2], v1[3]);
                    *(u32x4*)(rowp + bj * 128) = w; } }
    }
    __device__ __forceinline__ void meta(int row, int col, f32x4 v) const {
        u32x2 w; w.x = pg8::cvt_pk_bf16(v[0], v[1]); w.y = pg8::cvt_pk_bf16(v[2], v[3]);
        *(u32x2*)(O + (size_t)row * ldc + col) = w;
    }
};
struct EpiResF32 {
    static constexpr bool PERM = false, AFTER_DRAIN = false;
    float* H; const bf16_t* HB;
    __device__ __forceinline__ void operator()(const f32x4 (&acc)[2][2][4][2], const pg8::Unit& u, int wr, int wc, int fr, int fq) const {
        const int row0 = u.pm * 256 + wr * 64 + fr, col0 = u.pn * 256 + wc * 32 + 4 * fq;
#pragma unroll
        for (int ai = 0; ai < 2; ++ai)
#pragma unroll
            for (int m = 0; m < 4; ++m) { const size_t ro = (size_t)(row0 + ai * 128 + m * 16) * DM + col0;
#pragma unroll
                for (int bj = 0; bj < 2; ++bj)
#pragma unroll
                    for (int n = 0; n < 2; ++n) { const size_t o = ro + bj * 128 + n * 16; const u32x2 hw = *(const u32x2*)(HB + o);
                        const f32x4 hv = {bflo(hw.x), bfhi(hw.x), bflo(hw.y), bfhi(hw.y)}; *(f32x4*)(H + o) = hv * ALPHA + acc[ai][bj][m][n]; } }
    }
    __device__ __forceinline__ void meta(int row, int col, f32x4 v) const {
        const size_t o = (size_t)row * DM + col; const u32x2 hw = *(const u32x2*)(HB + o);
        const f32x4 hv = {bflo(hw.x), bfhi(hw.x), bflo(hw.y), bfhi(hw.y)}; *(f32x4*)(H + o) = hv * ALPHA + v;
    }
};
__device__ __forceinline__ f32x4 wave_gemm16(const bf16_t* A, const bf16_t* Bt, int K, int lane) {
    f32x4 acc = {0.f, 0.f, 0.f, 0.f};
    const bf16_t* pa = A + (size_t)(lane & 15) * K + 8 * (lane >> 4);
    const bf16_t* pb = Bt + (size_t)(lane & 15) * K + 8 * (lane >> 4);
#pragma unroll 16
    for (int k0 = 0; k0 < K; k0 += 32) {
        const bf16x8 a = *(const bf16x8*)(pa + k0), b = *(const bf16x8*)(pb + k0);
        acc = MFMA16(b, a, acc);
    }
    return acc;
}
template <class Epi>
__device__ __forceinline__ void gemm_full(LAS unsigned char* lds, const bf16_t* A, const bf16_t* Bt, int N, int K, const Epi& Emeta, const Epi& Emain) {
    const int lane = tidx() & 63, wid = tidx() >> 6;
    if (N == 2048) {
        if (bidx() < 64) {
            LAS f32x4* red = (LAS f32x4*)lds;
            const int ksteps = K / 32, per = (ksteps + 7) / 8, k_lo = wid * per, k_hi = (k_lo + per < ksteps ? k_lo + per : ksteps);
#pragma unroll
            for (int t = 0; t < 2; ++t) {
                const int tile = bidx() * 2 + t;
                f32x4 acc = {0.f, 0.f, 0.f, 0.f};
                const bf16_t* pa = A + (size_t)(lane & 15) * K + 8 * (lane >> 4);
                const bf16_t* pb = Bt + (size_t)(tile * 16 + (lane & 15)) * K + 8 * (lane >> 4);
#pragma unroll 8
                for (int ks = k_lo; ks < k_hi; ++ks) acc = MFMA16(*(const bf16x8*)(pb + ks * 32), *(const bf16x8*)(pa + ks * 32), acc);
                red[(t * 8 + wid) * 64 + lane] = acc;
            }
            __syncthreads();
            if (wid < 2) {
                f32x4 s = red[(wid * 8) * 64 + lane];
#pragma unroll
                for (int w = 1; w < 8; ++w) s += red[(wid * 8 + w) * 64 + lane];
                Emeta.meta(lane & 15, (bidx() * 2 + wid) * 16 + 4 * (lane >> 4), s);
            }
            __syncthreads();
        }
    } else {
        for (int tile = ((int)gridDim.x - 1 - bidx()) * 8 + wid; tile < N / 16; tile += gridDim.x * 8) {
            const f32x4 acc = wave_gemm16(A, Bt + (size_t)tile * 16 * K, K, lane);
            Emeta.meta(lane & 15, tile * 16 + 4 * (lane >> 4), acc);
        }
    }
    pg8::Gemm g{A + (size_t)16 * K, Bt, 8192, N, K};
    pg8::StaticOrder S; S.init(8192, N, (int)gridDim.x, (int)bidx());
    pg8::gemm_phase<Epi, pg8::StaticOrder, false>(lds, g, S, Emain, nullptr);
    __syncthreads();
}
#define XB_TMO      128
#define XB_XCNT(j)  (256  + 64 * (j))
#define XB_XSUB(j)  (1280 + 64 * (j))
#define XB_XGEN(j)  (2304 + 64 * (j))
#define XB_TOP      3328
#define XB_TOPGEN   3392
#define XCD_BAR_WORDS 3456
#define XB_SPIN_CAP (1u << 18)

__device__ __forceinline__ unsigned xb_ld(unsigned* p)              { return __hip_atomic_load(p, __ATOMIC_RELAXED, __HIP_MEMORY_SCOPE_AGENT); }
__device__ __forceinline__ unsigned xb_add(unsigned* p, unsigned v) { return __hip_atomic_fetch_add(p, v, __ATOMIC_RELAXED, __HIP_MEMORY_SCOPE_AGENT); }
__device__ __forceinline__ unsigned xb_xcc_id() { return (unsigned)__builtin_amdgcn_s_getreg((3 << 11) | 20) & 0xFu; }
#define XB_SPIN(cond, bar) do { unsigned _sp = 0; while (cond) { __builtin_amdgcn_s_sleep(1); \
    if ((++_sp & 255u) == 0u) { if (xb_ld(&(bar)[XB_TMO])) break; if (_sp > XB_SPIN_CAP) { atomicAdd(&(bar)[XB_TMO], 1u); break; } } } } while (0)

struct XcdBarrier {
    unsigned* bar; unsigned x;
    volatile LAS unsigned* st;
};

__device__ __forceinline__ XcdBarrier xcd_barrier_post(unsigned* bar, volatile LAS unsigned* st) {
    XcdBarrier b; b.bar = bar; b.x = xb_xcc_id(); b.st = st;
    if (threadIdx.x == 0) (void)xb_add(&bar[XB_XCNT(b.x)], 1u);
    return b;
}
__device__ __forceinline__ void xcd_barrier_complete(unsigned* bar, unsigned x, unsigned& nloc, unsigned& nx) {
    const unsigned G = gridDim.x * gridDim.y * gridDim.z;
    unsigned sum, cnt, mine, sp = 0u;
    for (;;) {
        sum = 0u; cnt = 0u; mine = 0u;
#pragma unroll
        for (unsigned j = 0; j < 16; ++j) { const unsigned c = xb_ld(&bar[XB_XCNT(j)]); sum += c; cnt += (c > 0u) ? 1u : 0u; mine = (j == x) ? c : mine; }
        if (sum == G) break;
        __builtin_amdgcn_s_sleep(1);
        if ((++sp & 255u) == 0u) { if (xb_ld(&bar[XB_TMO])) break; if (sp > XB_SPIN_CAP) { atomicAdd(&bar[XB_TMO], 1u); break; } }
    }
    nloc = mine > 0u ? mine : 1u; nx = cnt > 0u ? cnt : 1u;
}

__device__ __forceinline__ void xcd_barrier(const XcdBarrier& b) {
    asm volatile("s_waitcnt vmcnt(0)" ::: "memory");
    __syncthreads();
    if (threadIdx.x == 0) {
        unsigned* bar = b.bar;
        __builtin_amdgcn_s_waitcnt(0);
        unsigned nloc = b.st[0], nx = b.st[1];
        if (nloc == 0u) { xcd_barrier_complete(bar, b.x, nloc, nx); b.st[0] = nloc; b.st[1] = nx; }
        const unsigned old = xb_add(&bar[XB_XSUB(b.x)], 1u);
        const unsigned gen = old / nloc;
        if (old + 1u == (gen + 1u) * nloc) {
            __builtin_amdgcn_fence(__ATOMIC_RELEASE, "agent");
            asm volatile("s_waitcnt vmcnt(0)" ::: "memory");
            const unsigned og = xb_add(&bar[XB_TOP], 1u);
            const unsigned tg = og / nx;
            if (og + 1u == (tg + 1u) * nx) xb_add(&bar[XB_TOPGEN], 1u);
            else XB_SPIN(xb_ld(&bar[XB_TOPGEN]) == tg, bar);
            __builtin_amdgcn_fence(__ATOMIC_ACQUIRE, "agent");
            xb_add(&bar[XB_XGEN(b.x)], 1u);
            asm volatile("s_waitcnt vmcnt(0)" ::: "memory");
        } else {
            XB_SPIN(xb_ld(&bar[XB_XGEN(b.x)]) == gen, bar);
            __builtin_amdgcn_fence(__ATOMIC_ACQUIRE, "agent");
            asm volatile("s_waitcnt vmcnt(0)" ::: "memory");
        }
    }
    __syncthreads();
}
struct TJob { const float* src; int ld, ncols, K; bf16_t* dst; };
__device__ __forceinline__ TJob get_job(const Params& p, int j) {
    TJob J;
    bf16_t* ws16 = (bf16_t*)p.ws;
    if (j < 10) {
        const int jj = j / 5, sub = j % 5;
        const float* base = p.in[2] + (size_t)jj * 2048 * 12336;
        bf16_t* wmain = (bf16_t*)(p.ws + O_WT_HIN) + (size_t)jj * 12288 * 2048;
        bf16_t* wside = (bf16_t*)(p.ws + O_WT_HSIDE) + (size_t)jj * 48 * 2048;
        J.ld = 12336; J.K = 2048;
        if (sub == 0)      { J.src = base;          J.ncols = 6144; J.dst = wmain; }
        else if (sub == 1) { J.src = base + 6176;   J.ncols = 4096; J.dst = wmain + (size_t)6144 * 2048; }
        else if (sub == 2) { J.src = base + 10288;  J.ncols = 2048; J.dst = wmain + (size_t)10240 * 2048; }
        else if (sub == 3) { J.src = base + 6144;   J.ncols = 32;   J.dst = wside; }
        else               { J.src = base + 10272;  J.ncols = 16;   J.dst = wside + (size_t)32 * 2048; }
    } else if (j < 12) { const int jj = j - 10; J.src = p.in[12] + (size_t)jj * 4096 * 2048; J.ld = 2048; J.ncols = 2048; J.K = 4096; J.dst = (bf16_t*)(p.ws + O_WT_HOUT) + (size_t)jj * 2048 * 4096; }
    else if (j < 14) { const int jj = j - 12; J.src = p.in[13] + (size_t)jj * 2048 * 3072; J.ld = 3072; J.ncols = 3072; J.K = 2048; J.dst = (bf16_t*)(p.ws + O_WT_QKV) + (size_t)jj * 3072 * 2048; }
    else if (j < 16) { const int jj = j - 14; J.src = p.in[15] + (size_t)jj * 2048 * 2048; J.ld = 2048; J.ncols = 2048; J.K = 2048; J.dst = (bf16_t*)(p.ws + O_WT_SOUT) + (size_t)jj * 2048 * 2048; }
    else if (j < 20) { const int l = j - 16; J.src = p.in[16] + (size_t)l * 2048 * 11008; J.ld = 11008; J.ncols = 11008; J.K = 2048; J.dst = (bf16_t*)(p.ws + O_WT_UP) + (size_t)l * 11008 * 2048; }
    else { const int l = j - 20; J.src = p.in[19] + (size_t)l * 5504 * 2048; J.ld = 2048; J.ncols = 2048; J.K = 5504; J.dst = (bf16_t*)(p.ws + O_WT_DOWN) + (size_t)l * 2048 * 5504; }
    (void)ws16;
    return J;
}
__device__ __forceinline__ void phase_prep(const Params& p, LAS unsigned char* lds) {
    const int tid = tidx();
    LAS float* ts = (LAS float*)lds;
    for (int j = 0; j < 24; ++j) {
        const TJob J = get_job(p, j);
        const int tn = (J.ncols + 127) / 128, tk = J.K / 128;
        for (int tile = bidx(); tile < tn * tk; tile += gridDim.x) {
            const int kb = tile / tn, nb = tile % tn;
            __syncthreads();
            {
                const int c4 = (tid & 31) * 4, n = nb * 128 + c4, r0 = tid >> 5;
                if (n < J.ncols) {
                    float4 v[8];
#pragma unroll
                    for (int i = 0; i < 8; ++i) v[i] = *(const float4*)(J.src + (size_t)(kb * 128 + r0 + 16 * i) * J.ld + n);
#pragma unroll
                    for (int i = 0; i < 8; ++i) { const int r = r0 + 16 * i; ts[r * 129 + c4] = v[i].x; ts[r * 129 + c4 + 1] = v[i].y; ts[r * 129 + c4 + 2] = v[i].z; ts[r * 129 + c4 + 3] = v[i].w; }
                }
            }
            __syncthreads();
            const int n = tid >> 2, kc = tid & 3;
            if (nb * 128 + n < J.ncols) {
#pragma unroll
                for (int q = 0; q < 4; ++q) {
                    const int kk = kc * 32 + q * 8;
                    u32x4 w;
                    w.x = pack2(ts[(kk + 0) * 129 + n], ts[(kk + 1) * 129 + n]);
                    w.y = pack2(ts[(kk + 2) * 129 + n], ts[(kk + 3) * 129 + n]);
                    w.z = pack2(ts[(kk + 4) * 129 + n], ts[(kk + 5) * 129 + n]);
                    w.w = pack2(ts[(kk + 6) * 129 + n], ts[(kk + 7) * 129 + n]);
                    *(u32x4*)(J.dst + (size_t)(nb * 128 + n) * J.K + kb * 128 + kk) = w;
                }
            }
        }
    }
    __syncthreads();
    const size_t gtid = (size_t)bidx() * NTHREADS + tid, gn = (size_t)gridDim.x * NTHREADS;
    float* h = (float*)(p.ws + O_H); bf16_t* hb = (bf16_t*)(p.ws + O_HB);
    for (size_t i = gtid; i < (size_t)L_TOK * 512; i += gn) {
        const int row = (int)(i >> 9), c4 = (int)(i & 511) * 4;
        const float4 v = row < 16 ? *(const float4*)(p.in[1] + (size_t)row * DM + c4) : *(const float4*)(p.in[0] + (size_t)(row - 16) * DM + c4);
        u32x2 w; w.x = pack2(v.x, v.y); w.y = pack2(v.z, v.w);
        *(u32x2*)(hb + i * 4) = w;
    }
    if (gtid < 24) ((const float**)(p.ws + O_TAB))[gtid] = p.in[gtid];
    float* rope = (float*)(p.ws + O_ROPE);
    for (size_t i = gtid; i < (size_t)L_TOK * 8; i += gn) {
        const int pos = (int)(i >> 3), f = (int)(i & 7);
        const float ang = (float)pos * p.inv_freq[f];
        double rev = (double)ang * 0.15915494309189535;
        rev -= rint(rev);
        rope[pos * 16 + f] = __builtin_amdgcn_cosf((float)rev);
        rope[pos * 16 + 8 + f] = __builtin_amdgcn_sinf((float)rev);
    }
}

__device__ __forceinline__ void phase_ln(const Ctx& p, const float* g, const float* b, bool last) {
    const int lane = tidx() & 63, wid = tidx() >> 6;
    float* h = (float*)(p.ws + O_H); bf16_t* hb = (bf16_t*)(p.ws + O_HB);
    for (int row = bidx() * 8 + wid; row < L_TOK; row += gridDim.x * 8) {
        float4 v[8]; float s = 0.f;
#pragma unroll
        for (int i = 0; i < 8; ++i) { v[i] = *(const float4*)(h + (size_t)row * DM + i * 256 + lane * 4); s += v[i].x + v[i].y + v[i].z + v[i].w; }
        const float mean = wave_sum(s) * (1.f / 2048.f);
        float q = 0.f;
#pragma unroll
        for (int i = 0; i < 8; ++i) { v[i].x -= mean; v[i].y -= mean; v[i].z -= mean; v[i].w -= mean; q += v[i].x * v[i].x + v[i].y * v[i].y + v[i].z * v[i].z + v[i].w * v[i].w; }
        const float rstd = rsqrtf(wave_sum(q) * (1.f / 2048.f) + 1e-5f);
#pragma unroll
        for (int i = 0; i < 8; ++i) {
            const int c = i * 256 + lane * 4;
            const float4 gg = *(const float4*)(g + c), bb = *(const float4*)(b + c);
            float4 y; y.x = v[i].x * rstd * gg.x + bb.x; y.y = v[i].y * rstd * gg.y + bb.y; y.z = v[i].z * rstd * gg.z + bb.z; y.w = v[i].w * rstd * gg.w + bb.w;
            if (last) { if (row >= 16) *(float4*)(p.out + (size_t)(row - 16) * DM + c) = y; }
            else { u32x2 w; w.x = pack2(y.x, y.y); w.y = pack2(y.z, y.w); *(u32x2*)(hb + (size_t)row * DM + c) = w; }
        }
    }
}

__device__ __forceinline__ void unpack8(const u32x4 w, float (&f)[8]) {
    f[0] = bflo(w.x); f[1] = bfhi(w.x); f[2] = bflo(w.y); f[3] = bfhi(w.y); f[4] = bflo(w.z); f[5] = bfhi(w.z); f[6] = bflo(w.w); f[7] = bfhi(w.w);
}
__device__ __forceinline__ void ld8f(const float* q, float (&f)[8]) {
    const float4 a = *(const float4*)q, b = *(const float4*)(q + 4);
    f[0] = a.x; f[1] = a.y; f[2] = a.z; f[3] = a.w; f[4] = b.x; f[5] = b.y; f[6] = b.z; f[7] = b.w;
}
__device__ __forceinline__ void phase_ffn_conv(const Ctx& p, int layer) {
    const bf16_t* up = (const bf16_t*)(p.ws + O_R2); bf16_t* act = (bf16_t*)(p.ws + O_MIX);
    const float* cw = p.in(17) + (size_t)layer * 3 * DFF2; const float* cb = p.in(18) + (size_t)layer * DFF2;
    const size_t gtid = (size_t)bidx() * NTHREADS + tidx(), gn = (size_t)gridDim.x * NTHREADS;
    const int nlanes = (int)(gn / 688);
    if (gtid >= (size_t)nlanes * 688) return;
    const int jb = (int)(gtid % 688), j0 = jb * 8;
    float wg[3][8], wv[3][8], bg[8], bv[8];
#pragma unroll
    for (int k = 0; k < 3; ++k) { ld8f(cw + (size_t)k * DFF2 + j0, wg[k]); ld8f(cw + (size_t)k * DFF2 + DFF + j0, wv[k]); }
    ld8f(cb + j0, bg); ld8f(cb + DFF + j0, bv);
    for (int tb = (int)(gtid / 688); tb < 1026; tb += nlanes) {
        const int t0 = tb * 8;
        u32x4 gr[10], vr[10];
#pragma unroll
        for (int r = 0; r < 10; ++r) {
            const int t = t0 - 2 + r;
            gr[r] = (u32x4){0u, 0u, 0u, 0u}; vr[r] = (u32x4){0u, 0u, 0u, 0u};
            if (t >= 0) { gr[r] = *(const u32x4*)(up + (size_t)t * DFF2 + j0); vr[r] = *(const u32x4*)(up + (size_t)t * DFF2 + DFF + j0); }
        }
        float g2[8], g1[8], v2[8], v1[8];
        unpack8(gr[0], g2); unpack8(vr[0], v2); unpack8(gr[1], g1); unpack8(vr[1], v1);
#pragma unroll
        for (int tt = 0; tt < 8; ++tt) {
            const int t = t0 + tt;
            float g0[8], v0[8], o[8];
            unpack8(gr[tt + 2], g0); unpack8(vr[tt + 2], v0);
#pragma unroll
            for (int i = 0; i < 8; ++i) {
                const float gg = bg[i] + wg[0][i] * g2[i] + wg[1][i] * g1[i] + wg[2][i] * g0[i];
                const float vv = bv[i] + wv[0][i] * v2[i] + wv[1][i] * v1[i] + wv[2][i] * v0[i];
                o[i] = silu_f(gg) * vv;
                g2[i] = g1[i]; g1[i] = g0[i]; v2[i] = v1[i]; v1[i] = v0[i];
            }
            u32x4 w; w.x = pack2(o[0], o[1]); w.y = pack2(o[2], o[3]); w.z = pack2(o[4], o[5]); w.w = pack2(o[6], o[7]);
            *(u32x4*)(act + (size_t)t * DFF + j0) = w;
        }
    }
}
__device__ __forceinline__ void phase_hyb_prep(const Ctx& p, int jj, LAS unsigned char* lds) {
    const bf16_t* u = (const bf16_t*)(p.ws + O_U);
    const float* side = (const float*)(p.ws + O_SIDE);
    const int tid = tidx(), lane = tid & 63, wid = tid >> 6;
    const size_t gtid = (size_t)bidx() * NTHREADS + tid, gn = (size_t)gridDim.x * NTHREADS;
    {
        bf16_t* xc = (bf16_t*)(p.ws + O_XC);
        const float* cw = p.in(3) + (size_t)jj * 4 * 4096; const float* cb = p.in(4) + (size_t)jj * 4096;
        for (size_t task = gtid; task < (size_t)1026 * 512; task += gn) {
            const int cbk = (int)(task & 511), tb = (int)(task >> 9), c0 = cbk * 8, t0 = tb * 8;
            float w[4][8], bb[8], x3[8], x2[8], x1[8];
#pragma unroll
            for (int k = 0; k < 4; ++k) ld8f(cw + (size_t)k * 4096 + c0, w[k]);
            ld8f(cb + c0, bb);
            u32x4 xr[11];
#pragma unroll
            for (int r = 0; r < 11; ++r) { const int t = t0 - 3 + r; xr[r] = (u32x4){0u, 0u, 0u, 0u}; if (t >= 0) xr[r] = *(const u32x4*)(u + (size_t)t * HYB_N + UXBC + c0); }
            unpack8(xr[0], x3); unpack8(xr[1], x2); unpack8(xr[2], x1);
#pragma unroll
            for (int tt = 0; tt < 8; ++tt) {
                const int t = t0 + tt;
                float x0[8], o[8];
                unpack8(xr[tt + 3], x0);
#pragma unroll
                for (int i = 0; i < 8; ++i) {
                    const float y = bb[i] + w[0][i] * x3[i] + w[1][i] * x2[i] + w[2][i] * x1[i] + w[3][i] * x0[i];
                    o[i] = silu_f(y);
                    x3[i] = x2[i]; x2[i] = x1[i]; x1[i] = x0[i];
                }
                u32x4 ww; ww.x = pack2(o[0], o[1]); ww.y = pack2(o[2], o[3]); ww.z = pack2(o[4], o[5]); ww.w = pack2(o[6], o[7]);
                *(u32x4*)(xc + (size_t)t * 4096 + c0) = ww;
            }
        }
    }
    {
        float* dt = (float*)(p.ws + O_DT); float* acs = (float*)(p.ws + O_ACS); float* cdec = (float*)(p.ws + O_CDEC);
        for (int c = bidx(); c < 65; c += gridDim.x)
        for (int head = wid; head < 32; head += 8) {
            const float bias = p.in(5)[jj * 32 + head], a = -__expf(p.in(6)[jj * 32 + head]);
            const int t0 = c * 128 - 112 + 2 * lane;
            float d0 = 0.f, d1 = 0.f;
            if (t0 >= 0) {
                const float x0 = side[(size_t)t0 * 64 + head] + bias, x1 = side[(size_t)(t0 + 1) * 64 + head] + bias;
                d0 = x0 > 20.f ? x0 : __logf(1.f + __expf(x0)); d1 = x1 > 20.f ? x1 : __logf(1.f + __expf(x1));
            }
            const float a0 = d0 * a, a1 = d1 * a;
            float s = a0 + a1;
#pragma unroll
            for (int o = 1; o < 64; o <<= 1) { const float v = __shfl_up(s, o); if (lane >= o) s += v; }
            const float ex = s - (a0 + a1);
            if (t0 >= 0) {
                dt[(size_t)t0 * 32 + head] = d0; dt[(size_t)(t0 + 1) * 32 + head] = d1;
                acs[(size_t)t0 * 32 + head] = ex + a0; acs[(size_t)(t0 + 1) * 32 + head] = s;
            }
            if (lane == 63) cdec[c * 32 + head] = __expf(s);
        }
    }
    {
        bf16_t* qt = (bf16_t*)(p.ws + O_QT); bf16_t* kt = (bf16_t*)(p.ws + O_KT); float* glast = (float*)(p.ws + O_GLAST);
        const float* w2 = p.in(9) + (size_t)jj * 16 * 1024; const float* gb = p.in(10) + (size_t)jj * 1024;
        LAS float* tot = (LAS float*)lds;
        const int d4 = tid & 15, pg = tid >> 4;
        for (int task = bidx(); task < 129 * 16; task += gridDim.x) {
            const int c = task >> 4, dbase = (task & 15) * 64 + d4 * 4, tbase = c * 64 - 48 + 2 * pg;
            f32x4 w[16];
#pragma unroll
            for (int r = 0; r < 16; ++r) w[r] = *(const f32x4*)(w2 + r * 1024 + dbase);
            const f32x4 b = *(const f32x4*)(gb + dbase);
            f32x4 g0 = {0.f, 0.f, 0.f, 0.f}, g1 = {0.f, 0.f, 0.f, 0.f};
            if (tbase >= 0) {
#pragma unroll
                for (int pos = 0; pos < 2; ++pos) {
                    const float* gl = side + (size_t)(tbase + pos) * 64 + 32;
                    f32x4 x = b;
#pragma unroll
                    for (int r4 = 0; r4 < 4; ++r4) { const f32x4 gv = *(const f32x4*)(gl + r4 * 4); x += w[r4 * 4] * gv[0] + w[r4 * 4 + 1] * gv[1] + w[r4 * 4 + 2] * gv[2] + w[r4 * 4 + 3] * gv[3]; }
                    f32x4 ls;
#pragma unroll
                    for (int e = 0; e < 4; ++e) ls[e] = (fminf(x[e], 0.f) - __logf(1.f + __expf(-fabsf(x[e])))) * (1.f / 16.f);
                    if (pos == 0) g0 = ls; else g1 = ls;
                }
            }
            __syncthreads();
            *(LAS f32x4*)(tot + pg * 64 + d4 * 4) = g0 + g1;
            __syncthreads();
            f32x4 pre = {0.f, 0.f, 0.f, 0.f};
            for (int g = 0; g < pg; ++g) pre += *(const LAS f32x4*)(tot + g * 64 + d4 * 4);
            const f32x4 gc0 = pre + g0, gc1 = gc0 + g1;
            if (tbase >= 0) {
#pragma unroll
                for (int pos = 0; pos < 2; ++pos) {
                    const f32x4 gc = pos == 0 ? gc0 : gc1;
                    const size_t t = (size_t)(tbase + pos);
                    const u32x2 qw = *(const u32x2*)(u + t * HYB_N + UQ + dbase), kw = *(const u32x2*)(u + t * HYB_N + UK + dbase);
                    const float q[4] = {bflo(qw.x), bfhi(qw.x), bflo(qw.y), bfhi(qw.y)}, k[4] = {bflo(kw.x), bfhi(kw.x), bflo(kw.y), bfhi(kw.y)};
                    u32x2 qo, ko;
                    qo.x = pack2(q[0] * 0.0625f * __expf(gc[0]), q[1] * 0.0625f * __expf(gc[1])); qo.y = pack2(q[2] * 0.0625f * __expf(gc[2]), q[3] * 0.0625f * __expf(gc[3]));
                    ko.x = pack2(k[0] * __expf(-gc[0]), k[1] * __expf(-gc[1])); ko.y = pack2(k[2] * __expf(-gc[2]), k[3] * __expf(-gc[3]));
                    *(u32x2*)(qt + t * 1024 + dbase) = qo; *(u32x2*)(kt + t * 1024 + dbase) = ko;
                }
            }
            if (pg == 31) { f32x4 e; e[0] = __expf(gc1[0]); e[1] = __expf(gc1[1]); e[2] = __expf(gc1[2]); e[3] = __expf(gc1[3]); *(f32x4*)(glast + c * 1024 + dbase) = e; }
        }
    }
}

__device__ __forceinline__ void phase_hyb_local(const Ctx& p, LAS unsigned char* lds) {
    const int tid = tidx(), lane = tid & 63, wid = tid >> 6, fr = lane & 15, fq = lane >> 4;
    const bf16_t* xc = (const bf16_t*)(p.ws + O_XC);
    const float* dt = (const float*)(p.ws + O_DT); const float* acs = (const float*)(p.ws + O_ACS);
    for (int task0 = bidx(); task0 < 65 * 8 + 129 * 16; task0 += gridDim.x) {
        bool is_ssd; int c, sub;
        if (task0 < 8) { is_ssd = true; c = 0; sub = task0; }
        else if (task0 < 24) { is_ssd = false; c = 0; sub = task0 - 8; }
        else if (task0 < 536) { is_ssd = true; c = 1 + ((task0 - 24) >> 3); sub = (task0 - 24) & 7; }
        else { is_ssd = false; c = 1 + ((task0 - 536) >> 4); sub = (task0 - 536) & 15; }
        __syncthreads();
        if (is_ssd) {
            const int g = sub, tbase = c * 128 - 112;
            LAS bf16_t* Bs = (LAS bf16_t*)lds;
            LAS bf16_t* Xs = Bs + 128 * 136;
            const int tlast = tbase + 127;
            for (int item = tid; item < 128 * 16; item += NTHREADS) {
                const int j = item >> 4, cb = item & 15, t = tbase + j;
                u32x4 w = {0u, 0u, 0u, 0u};
                if (t >= 0) w = *(const u32x4*)(xc + (size_t)t * 4096 + 2048 + g * 128 + cb * 8);
                *(LAS u32x4*)(Bs + j * 136 + cb * 8) = w;
            }
            for (int item = tid; item < 128 * 32; item += NTHREADS) {
                const int j = item >> 5, cb = item & 31, hh = cb >> 3, t = tbase + j, head = g * 4 + hh;
                u32x4 w = {0u, 0u, 0u, 0u};
                if (t >= 0) {
                    float f[8]; unpack8(*(const u32x4*)(xc + (size_t)t * 4096 + g * 256 + cb * 8), f);
                    const float sc = dt[(size_t)t * 32 + head] * __expf(acs[(size_t)tlast * 32 + head] - acs[(size_t)t * 32 + head]);
                    w.x = pack2(f[0] * sc, f[1] * sc); w.y = pack2(f[2] * sc, f[3] * sc); w.z = pack2(f[4] * sc, f[5] * sc); w.w = pack2(f[6] * sc, f[7] * sc);
                }
                *(LAS u32x4*)(Xs + j * 264 + cb * 8) = w;
            }
            __syncthreads();
            float* loc = (float*)(p.ws + O_SSDLOC) + ((size_t)c * 32 + g * 4) * 64 * 128;
            const int pt = wid & 3, nh = wid >> 2;
            for (int hh = 0; hh < 4; ++hh) {
                f32x4 acc[4];
#pragma unroll
                for (int nt = 0; nt < 4; ++nt) acc[nt] = (f32x4){0.f, 0.f, 0.f, 0.f};
#pragma unroll
                for (int ks = 0; ks < 4; ++ks) {
                    const bf16x8 xf = ldfrag_tr(Xs, 264, hh * 64 + pt * 16, ks * 32, lane);
#pragma unroll
                    for (int nt = 0; nt < 4; ++nt) { const bf16x8 bf = ldfrag_tr(Bs, 136, nh * 64 + nt * 16, ks * 32, lane); acc[nt] = MFMA16(bf, xf, acc[nt]); }
                }
#pragma unroll
                for (int nt = 0; nt < 4; ++nt) *(f32x4*)(loc + ((size_t)hh * 64 + pt * 16 + fr) * 128 + nh * 64 + nt * 16 + 4 * fq) = acc[nt];
            }
        } else {
            const int h = (sub >> 2) & 3, vs = sub & 3, tbase = c * 64 - 48;
            const bf16_t* u = (const bf16_t*)(p.ws + O_U); const bf16_t* kt = (const bf16_t*)(p.ws + O_KT);
            LAS bf16_t* Ks = (LAS bf16_t*)lds;
            LAS bf16_t* Vs = Ks + 64 * 264;
            for (int item = tid; item < 64 * 32; item += NTHREADS) {
                const int j = item >> 5, cb = item & 31, t = tbase + j;
                u32x4 w = {0u, 0u, 0u, 0u};
                if (t >= 0) w = *(const u32x4*)(kt + (size_t)t * 1024 + h * 256 + cb * 8);
                *(LAS u32x4*)(Ks + j * 264 + cb * 8) = w;
            }
            for (int item = tid; item < 64 * 16; item += NTHREADS) {
                const int j = item >> 4, cb = item & 15, t = tbase + j;
                u32x4 w = {0u, 0u, 0u, 0u};
                if (t >= 0) w = *(const u32x4*)(u + (size_t)t * HYB_N + UV + h * 512 + vs * 128 + cb * 8);
                *(LAS u32x4*)(Vs + j * 136 + cb * 8) = w;
            }
            __syncthreads();
            const float* glast = (const float*)(p.ws + O_GLAST) + c * 1024 + h * 256;
            bf16_t* kv = (bf16_t*)(p.ws + O_R2) + ((size_t)c * 4 + h) * 131072 + (size_t)(vs * 8 + wid) * 4096 + fr * 8 + (fq & 1) * 4;
            const bf16x8 vf0 = ldfrag_tr(Vs, 136, wid * 16, 0, lane), vf1 = ldfrag_tr(Vs, 136, wid * 16, 32, lane);
#pragma unroll
            for (int nt = 0; nt < 16; ++nt) {
                f32x4 acc = {0.f, 0.f, 0.f, 0.f};
                acc = MFMA16(ldfrag_tr(Ks, 264, nt * 16, 0, lane), vf0, acc);
                acc = MFMA16(ldfrag_tr(Ks, 264, nt * 16, 32, lane), vf1, acc);
                const f32x4 gl = *(const f32x4*)(glast + nt * 16 + 4 * fq);
                u32x2 w; w.x = pack2(acc[0] * gl[0], acc[1] * gl[1]); w.y = pack2(acc[2] * gl[2], acc[3] * gl[3]);
                *(u32x2*)(kv + (nt >> 1) * 512 + ((nt & 1) * 2 + (fq >> 1)) * 128) = w;
            }
        }
    }
}

__device__ __forceinline__ void phase_hyb_scan(const Ctx& p) {
    const int tid_ = tidx(), half = tid_ >> 8;
    for (size_t idx = (size_t)bidx() * 256 + (tid_ & 255); idx < 65536; idx += (size_t)gridDim.x * 256) {
        const size_t task = half ? idx : idx + 65536;
        if (task < 65536) {
            const size_t e = task * 4; const int head = (int)(e >> 13);
            const float* loc = (const float*)(p.ws + O_SSDLOC) + e; bf16_t* prev = (bf16_t*)(p.ws + O_SSDPREV) + e;
            const float* cdec = (const float*)(p.ws + O_CDEC) + head;
            float zz = 0.f; asm volatile("" : "+v"(zz));
            float4 run = {zz, zz, zz, zz};
            for (int c0 = 0; c0 < 65; c0 += 13) {
                float4 l[13]; float dcy[13];
#pragma unroll
                for (int i = 0; i < 13; ++i) { l[i] = *(const float4*)(loc + (size_t)(c0 + i) * 262144); dcy[i] = cdec[(c0 + i) * 32]; }
#pragma unroll
                for (int i = 0; i < 13; ++i) {
                    u32x2 w; w.x = pack2(run.x, run.y); w.y = pack2(run.z, run.w);
                    *(u32x2*)(prev + (size_t)(c0 + i) * 262144) = w;
                    run.x = run.x * dcy[i] + l[i].x; run.y = run.y * dcy[i] + l[i].y; run.z = run.z * dcy[i] + l[i].z; run.w = run.w * dcy[i] + l[i].w;
                }
            }
        } else {
            const size_t e = (task - 65536) * 8; const int h = (int)(e >> 17), ch16 = (int)((e & 131071) >> 3), d0 = ((ch16 >> 6) & 7) * 32 + ((ch16 >> 4) & 3) * 8;
            const bf16_t* kv = (const bf16_t*)(p.ws + O_R2) + e; bf16_t* sp = (bf16_t*)(p.ws + O_R2 + GLA_ST_BYTES) + e;
            const float* glast = (const float*)(p.ws + O_GLAST) + h * 256 + d0;
            float run[8]; float zz = 0.f; asm volatile("" : "+v"(zz));
#pragma unroll
            for (int i = 0; i < 8; ++i) run[i] = zz;
            for (int c0 = 0; c0 < 129; c0 += 8) {
                u32x4 lw[8]; float4 ga[8], gb2[8];
#pragma unroll
                for (int i = 0; i < 8; ++i) { const int c = c0 + i < 129 ? c0 + i : 128; lw[i] = *(const u32x4*)(kv + (size_t)c * 524288); ga[i] = *(const float4*)(glast + c * 1024); gb2[i] = *(const float4*)(glast + c * 1024 + 4); }
#pragma unroll
                for (int i = 0; i < 8; ++i) {
                    if (c0 + i < 129) {
                        float l[8]; unpack8(lw[i], l);
                        u32x4 w; w.x = pack2(run[0], run[1]); w.y = pack2(run[2], run[3]); w.z = pack2(run[4], run[5]); w.w = pack2(run[6], run[7]);
                        *(u32x4*)(sp + (size_t)(c0 + i) * 524288) = w;
                        run[0] = run[0] * ga[i].x + l[0]; run[1] = run[1] * ga[i].y + l[1]; run[2] = run[2] * ga[i].z + l[2]; run[3] = run[3] * ga[i].w + l[3];
                        run[4] = run[4] * gb2[i].x + l[4]; run[5] = run[5] * gb2[i].y + l[5]; run[6] = run[6] * gb2[i].z + l[6]; run[7] = run[7] * gb2[i].w + l[7];
                    }
                }
            }
        }
    }
}
__device__ __forceinline__ void phase_hyb_out(const Ctx& p, int jj, LAS unsigned char* lds) {
    const bf16_t* xc = (const bf16_t*)(p.ws + O_XC); const bf16_t* u = (const bf16_t*)(p.ws + O_U);
    const float* dt = (const float*)(p.ws + O_DT); const float* acs = (const float*)(p.ws + O_ACS);
    bf16_t* mix = (bf16_t*)(p.ws + O_MIX);
    for (int task0 = bidx(); task0 < 1036; task0 += gridDim.x) {
        bool is_ssd; int c, sub;
        if (task0 < 8) { is_ssd = true; c = 0; sub = task0; }
        else if (task0 < 12) { is_ssd = false; c = 0; sub = task0 - 8; }
        else if (task0 < 524) { is_ssd = true; c = 1 + ((task0 - 12) >> 3); sub = (task0 - 12) & 7; }
        else { is_ssd = false; c = 1 + ((task0 - 524) >> 2); sub = (task0 - 524) & 3; }
        const int tid = tidx(), lane = tid & 63, wid = tid >> 6, fr = lane & 15, fq = lane >> 4;
        __syncthreads();
        if (is_ssd) {
            const int g = sub, tbase = c * 128 - 112;
            LAS bf16_t* Cs = (LAS bf16_t*)lds;
            LAS bf16_t* Bs = Cs + 128 * 136;
            LAS bf16_t* Xt = Bs + 128 * 136;
            LAS bf16_t* Pv = Xt + 128 * 72;
            LAS float* Acs = (LAS float*)(Pv + 64 * 136);
            for (int item = tid; item < 128 * 32; item += NTHREADS) {
                const int j = item >> 5, cb = item & 31, t = tbase + j;
                u32x4 w = {0u, 0u, 0u, 0u};
                if (t >= 0) w = *(const u32x4*)(xc + (size_t)t * 4096 + 2048 + (cb < 16 ? 0 : 1024) + g * 128 + (cb & 15) * 8);
                *(LAS u32x4*)((cb < 16 ? Bs : Cs) + j * 136 + (cb & 15) * 8) = w;
            }
            { const int j = tid & 127, hh = tid >> 7, t = tbase + j; Acs[hh * 128 + j] = t >= 0 ? acs[(size_t)t * 32 + g * 4 + hh] : 0.f; }
            __syncthreads();
            const int i_row = wid * 16 + fr, ti = tbase + i_row;
            f32x4 cb_acc[8];
#pragma unroll
            for (int nt = 0; nt < 8; ++nt) cb_acc[nt] = (f32x4){0.f, 0.f, 0.f, 0.f};
#pragma unroll
            for (int ks = 0; ks < 4; ++ks) {
                const bf16x8 cf = ldfrag(Cs, 136, wid * 16, ks * 32, lane);
#pragma unroll
                for (int nt = 0; nt < 8; ++nt) cb_acc[nt] = MFMA16(ldfrag(Bs, 136, nt * 16, ks * 32, lane), cf, cb_acc[nt]);
            }
            f32x4 yv[4][4];
#pragma unroll
            for (int k = 0; k < 4; ++k)
#pragma unroll
                for (int pt = 0; pt < 4; ++pt) yv[k][pt] = (f32x4){0.f, 0.f, 0.f, 0.f};
            float ssq = 0.f;
            u32x4 xr0, xr1, pr0, pr1; float ds0, ds1;
#define SSD_PREFETCH(HD) do { const int hd_ = (HD); \
                { const int j0_ = tid >> 3, cb_ = tid & 7, ta_ = tbase + j0_, tb_ = ta_ + 64; \
                  xr0 = (u32x4){0u, 0u, 0u, 0u}; xr1 = (u32x4){0u, 0u, 0u, 0u}; ds0 = 0.f; ds1 = 0.f; \
                  if (ta_ >= 0) { xr0 = *(const u32x4*)(xc + (size_t)ta_ * 4096 + hd_ * 64 + cb_ * 8); ds0 = dt[(size_t)ta_ * 32 + hd_]; } \
                  if (tb_ >= 0) { xr1 = *(const u32x4*)(xc + (size_t)tb_ * 4096 + hd_ * 64 + cb_ * 8); ds1 = dt[(size_t)tb_ * 32 + hd_]; } } \
                { const bf16_t* pv_ = (const bf16_t*)(p.ws + O_SSDPREV) + ((size_t)c * 32 + hd_) * 64 * 128; const int pp_ = tid >> 4, cc_ = tid & 15; \
                  pr0 = *(const u32x4*)(pv_ + pp_ * 128 + cc_ * 8); pr1 = *(const u32x4*)(pv_ + (pp_ + 32) * 128 + cc_ * 8); } } while (0)
            SSD_PREFETCH(g * 4);
#pragma unroll 1
            for (int hh = 0; hh < 4; ++hh) {
                const int head = g * 4 + hh;
                __syncthreads();
                { const int j0_ = tid >> 3, cb_ = tid & 7; float f[8]; u32x4 w;
                  unpack8(xr0, f); w.x = pack2(f[0] * ds0, f[1] * ds0); w.y = pack2(f[2] * ds0, f[3] * ds0); w.z = pack2(f[4] * ds0, f[5] * ds0); w.w = pack2(f[6] * ds0, f[7] * ds0);
                  *(LAS u32x4*)(Xt + j0_ * 72 + cb_ * 8) = w;
                  unpack8(xr1, f); w.x = pack2(f[0] * ds1, f[1] * ds1); w.y = pack2(f[2] * ds1, f[3] * ds1); w.z = pack2(f[4] * ds1, f[5] * ds1); w.w = pack2(f[6] * ds1, f[7] * ds1);
                  *(LAS u32x4*)(Xt + (j0_ + 64) * 72 + cb_ * 8) = w;
                  const int pp_ = tid >> 4, cc_ = tid & 15;
                  *(LAS u32x4*)(Pv + pp_ * 136 + cc_ * 8) = pr0; *(LAS u32x4*)(Pv + (pp_ + 32) * 136 + cc_ * 8) = pr1; }
                if (hh < 3) SSD_PREFETCH(head + 1);
                const float ai = Acs[hh * 128 + i_row];
#pragma unroll
                for (int nt = 0; nt < 8; ++nt) {
                    float m[4];
#pragma unroll
                    for (int q = 0; q < 4; ++q) { const int j = nt * 16 + 4 * fq + q; m[q] = j <= i_row ? cb_acc[nt][q] * __expf(ai - Acs[hh * 128 + j]) : 0.f; }
                    u32x2 w; w.x = pack2(m[0], m[1]); w.y = pack2(m[2], m[3]);
                    *(LAS u32x2*)(Bs + i_row * 136 + nt * 16 + 4 * fq) = w;
                }
                __syncthreads();
                f32x4 yd[4], yo[4];
#pragma unroll
                for (int pt = 0; pt < 4; ++pt) { yd[pt] = (f32x4){0.f, 0.f, 0.f, 0.f}; yo[pt] = (f32x4){0.f, 0.f, 0.f, 0.f}; }
#pragma unroll
                for (int ks = 0; ks < 4; ++ks) {
                    const bf16x8 mf = ldfrag(Bs, 136, wid * 16, ks * 32, lane), cf = ldfrag(Cs, 136, wid * 16, ks * 32, lane);
#pragma unroll
                    for (int pt = 0; pt < 4; ++pt) {
                        yd[pt] = MFMA16(ldfrag_tr(Xt, 72, pt * 16, ks * 32, lane), mf, yd[pt]);
                        yo[pt] = MFMA16(ldfrag(Pv, 136, pt * 16, ks * 32, lane), cf, yo[pt]);
                    }
                }
                const float ea = __expf(ai), dsk = p.in(7)[jj * 32 + head];
#pragma unroll
                for (int pt = 0; pt < 4; ++pt) {
                    const int ch = head * 64 + pt * 16 + 4 * fq;
                    float xs[4] = {0.f, 0.f, 0.f, 0.f}, zz[4] = {0.f, 0.f, 0.f, 0.f};
                    if (ti >= 0) {
                        const u32x2 xw = *(const u32x2*)(xc + (size_t)ti * 4096 + ch), zw = *(const u32x2*)(u + (size_t)ti * HYB_N + UZ + ch);
                        xs[0] = bflo(xw.x); xs[1] = bfhi(xw.x); xs[2] = bflo(xw.y); xs[3] = bfhi(xw.y);
                        zz[0] = bflo(zw.x); zz[1] = bfhi(zw.x); zz[2] = bflo(zw.y); zz[3] = bfhi(zw.y);
                    }
#pragma unroll
                    for (int q = 0; q < 4; ++q) { const float y = (yd[pt][q] + ea * yo[pt][q] + dsk * xs[q]) * silu_f(zz[q]); ssq += y * y;
#pragma unroll
                        for (int k = 0; k < 4; ++k) yv[k][pt][q] = (k == hh) ? y : yv[k][pt][q]; }
                }
            }
            ssq += __shfl_xor(ssq, 16); ssq += __shfl_xor(ssq, 32);
            const float rs = rsqrtf(ssq * (1.f / 256.f) + 1e-6f);
            if (ti >= 0) {
                const float* nw = p.in(8) + (size_t)jj * 2048;
#pragma unroll
                for (int hh = 0; hh < 4; ++hh)
#pragma unroll
                    for (int pt = 0; pt < 4; ++pt) {
                        const int ch = (g * 4 + hh) * 64 + pt * 16 + 4 * fq;
                        const f32x4 wv = *(const f32x4*)(nw + ch);
                        u32x2 w; w.x = pack2(yv[hh][pt][0] * rs * wv[0], yv[hh][pt][1] * rs * wv[1]); w.y = pack2(yv[hh][pt][2] * rs * wv[2], yv[hh][pt][3] * rs * wv[3]);
                        *(u32x2*)(mix + (size_t)ti * 4096 + ch) = w;
                    }
            }
        } else {
            const int h = sub, tbase = c * 64 - 48;
            const bf16_t* qt = (const bf16_t*)(p.ws + O_QT); const bf16_t* kt = (const bf16_t*)(p.ws + O_KT);
            LAS bf16_t* Qs = (LAS bf16_t*)lds;
            LAS bf16_t* Ps = Qs + 64 * 264;
            LAS float* Ssq = (LAS float*)(Ps + 64 * 72);
            LAS bf16_t* Ks = (LAS bf16_t*)(Ssq + 512);
            LAS bf16_t* Vs = Ks;
            for (int item = tid; item < 64 * 64; item += NTHREADS) {
                const int j = item >> 6, cb = item & 63, t = tbase + j;
                u32x4 w = {0u, 0u, 0u, 0u};
                if (t >= 0) w = *(const u32x4*)((cb < 32 ? qt : kt) + (size_t)t * 1024 + h * 256 + (cb & 31) * 8);
                *(LAS u32x4*)((cb < 32 ? Qs : Ks) + j * 264 + (cb & 31) * 8) = w;
            }
            u32x4 vreg[8];
#pragma unroll
            for (int r = 0; r < 8; ++r) { const int item = tid + r * NTHREADS, j = item >> 6, cb = item & 63, t = tbase + j;
                vreg[r] = (u32x4){0u, 0u, 0u, 0u};
                if (t >= 0) vreg[r] = *(const u32x4*)(u + (size_t)t * HYB_N + UV + h * 512 + cb * 8); }
            __syncthreads();
#pragma unroll
            for (int rep = 0; rep < 2; ++rep) {
                const int tix = wid + rep * 8, it = tix >> 2, jt = tix & 3;
                f32x4 acc = {0.f, 0.f, 0.f, 0.f};
                if (jt <= it) {
#pragma unroll
                    for (int ks = 0; ks < 8; ++ks) acc = MFMA16(ldfrag(Ks, 264, jt * 16, ks * 32, lane), ldfrag(Qs, 264, it * 16, ks * 32, lane), acc);
                }
                const int i = it * 16 + fr;
                float m[4];
#pragma unroll
                for (int q = 0; q < 4; ++q) { const int j = jt * 16 + 4 * fq + q; m[q] = (j <= i) ? acc[q] : 0.f; }
                u32x2 w; w.x = pack2(m[0], m[1]); w.y = pack2(m[2], m[3]);
                *(LAS u32x2*)(Ps + i * 72 + jt * 16 + 4 * fq) = w;
            }
            __syncthreads();
#pragma unroll
            for (int r = 0; r < 8; ++r) { const int item = tid + r * NTHREADS, j = item >> 6, cb = item & 63; *(LAS u32x4*)(Vs + j * 520 + cb * 8) = vreg[r]; }
            __syncthreads();
            f32x4 o[4][4];
            float ssq[4] = {0.f, 0.f, 0.f, 0.f};
            const bf16_t* sp = (const bf16_t*)(p.ws + O_R2 + GLA_ST_BYTES) + ((size_t)c * 4 + h) * 512 * 256;
#pragma unroll
            for (int vs = 0; vs < 4; ++vs) {
#pragma unroll
                for (int it = 0; it < 4; ++it) o[vs][it] = (f32x4){0.f, 0.f, 0.f, 0.f};
#pragma unroll
                for (int ks = 0; ks < 2; ++ks) {
                    const bf16x8 vf = ldfrag_tr(Vs, 520, vs * 128 + wid * 16, ks * 32, lane);
#pragma unroll
                    for (int it = 0; it < 4; ++it) o[vs][it] = MFMA16(vf, ldfrag(Ps, 72, it * 16, ks * 32, lane), o[vs][it]);
                }
                const bf16_t* spw = sp + (size_t)(vs * 8 + wid) * 4096 + lane * 8;
#pragma unroll
                for (int ks = 0; ks < 8; ++ks) {
                    const bf16x8 sf = *(const bf16x8*)(spw + ks * 512);
#pragma unroll
                    for (int it = 0; it < 4; ++it) o[vs][it] = MFMA16(sf, ldfrag(Qs, 264, it * 16, ks * 32, lane), o[vs][it]);
                }
#pragma unroll
                for (int it = 0; it < 4; ++it) ssq[it] += o[vs][it][0] * o[vs][it][0] + o[vs][it][1] * o[vs][it][1] + o[vs][it][2] * o[vs][it][2] + o[vs][it][3] * o[vs][it][3];
            }
#pragma unroll
            for (int it = 0; it < 4; ++it) { float s = ssq[it]; s += __shfl_xor(s, 16); s += __shfl_xor(s, 32); if (fq == 0) Ssq[wid * 64 + it * 16 + fr] = s; }
            __syncthreads();
            const float* nw = p.in(11) + (size_t)jj * 2048 + h * 512;
#pragma unroll
            for (int it = 0; it < 4; ++it) {
                const int i = it * 16 + fr, t = tbase + i;
                float s = 0.f;
#pragma unroll
                for (int w8 = 0; w8 < 8; ++w8) s += Ssq[w8 * 64 + i];
                const float rs = rsqrtf(s * (1.f / 512.f) + 1e-6f);
                if (t >= 0) {
#pragma unroll
                    for (int vs = 0; vs < 4; ++vs) {
                        const int v0 = vs * 128 + wid * 16 + 4 * fq;
                        const f32x4 wv = *(const f32x4*)(nw + v0);
                        const u32x2 rw = *(const u32x2*)(u + (size_t)t * HYB_N + UR + h * 512 + v0);
                        const float r0 = bflo(rw.x), r1 = bfhi(rw.x), r2 = bflo(rw.y), r3 = bfhi(rw.y);
                        u32x2 w;
                        w.x = pack2(o[vs][it][0] * rs * wv[0] * silu_f(r0), o[vs][it][1] * rs * wv[1] * silu_f(r1));
                        w.y = pack2(o[vs][it][2] * rs * wv[2] * silu_f(r2), o[vs][it][3] * rs * wv[3] * silu_f(r3));
                        *(u32x2*)(mix + (size_t)t * 4096 + 2048 + h * 512 + v0) = w;
                    }
                }
            }
        }
    }
}
__device__ __forceinline__ void rot_pair(const u32x4 a, const u32x4 b, const float* cs, u32x4& oa, u32x4& ob) {
    float x1[8], x2[8], c[8], s[8]; unpack8(a, x1); unpack8(b, x2); ld8f(cs, c); ld8f(cs + 8, s);
    float r1[8], r2[8];
#pragma unroll
    for (int i = 0; i < 8; ++i) { r1[i] = x1[i] * c[i] - x2[i] * s[i]; r2[i] = x2[i] * c[i] + x1[i] * s[i]; }
    oa.x = pack2(r1[0], r1[1]); oa.y = pack2(r1[2], r1[3]); oa.z = pack2(r1[4], r1[5]); oa.w = pack2(r1[6], r1[7]);
    ob.x = pack2(r2[0], r2[1]); ob.y = pack2(r2[2], r2[3]); ob.z = pack2(r2[4], r2[5]); ob.w = pack2(r2[6], r2[7]);
}
__device__ __forceinline__ void phase_attn(const Ctx& p, int jj, LAS unsigned char* lds) {
    const int tid = tidx(), lane = tid & 63, wid = tid >> 6, fr = lane & 15, fq = lane >> 4;
    const bf16_t* qkv = (const bf16_t*)(p.ws + O_U);
    const float* rope = (const float*)(p.ws + O_ROPE);
    bf16_t* ao = (bf16_t*)(p.ws + O_MIX);
    LAS bf16_t* Ks = (LAS bf16_t*)lds;
    LAS bf16_t* Vs = Ks + 272 * 72;
    LAS bf16_t* Pw = Vs + 272 * 72 + wid * (16 * 168);
    for (int task0 = bidx(); task0 < 520; task0 += gridDim.x) {
        const int task = task0 < 8 ? 512 + task0 : task0 - 8;
        const bool meta = task >= 512;
        const int b = meta ? 0 : (task >> 3), kh = task & 7;
        const int nkeys = meta ? 32 : 272;
        __syncthreads();
        for (int item = tid; item < nkeys * 8; item += NTHREADS) {
            const int key = item >> 3, cb = item & 7;
            const int tok = key < 16 ? key : 16 + 128 * (b - 1) + (key - 16);
            const bool valid = meta ? (key < 16) : (key < 16 || tok >= 16);
            {
                u32x4 w = {0u, 0u, 0u, 0u};
                if (valid) w = *(const u32x4*)(qkv + (size_t)tok * QKV_N + 2560 + kh * 64 + cb * 8);
                *(LAS u32x4*)(Vs + key * 72 + cb * 8) = w;
            }
            if (cb == 1) continue;
            const bf16_t* src = qkv + (size_t)tok * QKV_N + 2048 + kh * 64;
            if (cb == 0) {
                u32x4 oa = {0u, 0u, 0u, 0u}, ob = {0u, 0u, 0u, 0u};
                if (valid) rot_pair(*(const u32x4*)src, *(const u32x4*)(src + 8), rope + (size_t)tok * 16, oa, ob);
                *(LAS u32x4*)(Ks + key * 72) = oa; *(LAS u32x4*)(Ks + key * 72 + 8) = ob;
            } else {
                u32x4 w = {0u, 0u, 0u, 0u};
                if (valid) w = *(const u32x4*)(src + cb * 8);
                *(LAS u32x4*)(Ks + key * 72 + cb * 8) = w;
            }
        }
        __syncthreads();
        if (meta && wid >= 4) continue;
        const int ng = meta ? 1 : 4;
        for (int gi = 0; gi < ng; ++gi) {
            const int g = meta ? wid : gi, hq = kh * 4 + g;
            const int tq = meta ? fr : 16 + 128 * b + 16 * wid + fr;
            u32x4 q0 = *(const u32x4*)(qkv + (size_t)tq * QKV_N + hq * 64 + 8 * fq), q1 = *(const u32x4*)(qkv + (size_t)tq * QKV_N + hq * 64 + 32 + 8 * fq);
            {
                u32x4 ot; ot.x = __shfl_xor((int)q0.x, 16); ot.y = __shfl_xor((int)q0.y, 16); ot.z = __shfl_xor((int)q0.z, 16); ot.w = __shfl_xor((int)q0.w, 16);
                if (fq < 2) {
                    float mine[8], oth[8], c[8], s[8]; unpack8(q0, mine); unpack8(ot, oth); ld8f(rope + (size_t)tq * 16, c); ld8f(rope + (size_t)tq * 16 + 8, s);
                    const float sg = fq == 0 ? -1.f : 1.f;
                    float r[8];
#pragma unroll
                    for (int i = 0; i < 8; ++i) r[i] = mine[i] * c[i] + sg * oth[i] * s[i];
                    q0.x = pack2(r[0], r[1]); q0.y = pack2(r[2], r[3]); q0.z = pack2(r[4], r[5]); q0.w = pack2(r[6], r[7]);
                }
            }
            const bf16x8 qa0 = __builtin_bit_cast(bf16x8, q0), qa1 = __builtin_bit_cast(bf16x8, q1);
            const float sink = p.in(14)[jj * 32 + hq];
            const int nt = meta ? 1 : 10;
            f32x4 sc[10];
            float mx = sink;
#pragma unroll
            for (int t = 0; t < 10; ++t) {
                if (t < nt) {
                    const int krow = t == 0 ? 0 : 16 + 16 * (wid + t - 1);
                    f32x4 a = {0.f, 0.f, 0.f, 0.f};
                    a = MFMA16(ldfrag(Ks, 72, krow, 0, lane), qa0, a);
                    a = MFMA16(ldfrag(Ks, 72, krow, 32, lane), qa1, a);
#pragma unroll
                    for (int j = 0; j < 4; ++j) {
                        bool vis;
                        if (t == 0) vis = meta ? (4 * fq + j <= fr) : true;
                        else { const int rel = 16 * (t - 1) + 4 * fq + j - fr; vis = rel >= 1 && rel <= 128 && (b > 0 || 16 * wid + 16 * (t - 1) + 4 * fq + j >= 128); }
                        const float v = vis ? a[j] * 0.125f : -INFINITY;
                        a[j] = v; mx = fmaxf(mx, v);
                    }
                    sc[t] = a;
                }
            }
            mx = fmaxf(mx, __shfl_xor(mx, 16)); mx = fmaxf(mx, __shfl_xor(mx, 32));
            float den = 0.f;
#pragma unroll
            for (int t = 0; t < 10; ++t) {
                if (t < nt) {
                    float e[4];
#pragma unroll
                    for (int j = 0; j < 4; ++j) { e[j] = __expf(sc[t][j] - mx); den += e[j]; }
                    u32x2 w; w.x = pack2(e[0], e[1]); w.y = pack2(e[2], e[3]);
                    *(LAS u32x2*)(Pw + fr * 168 + t * 16 + 4 * fq) = w;
                }
            }
            if (meta) { unsigned zz = 0u; asm volatile("" : "+v"(zz)); u32x2 z = {zz, zz}; *(LAS u32x2*)(Pw + fr * 168 + 16 + 4 * fq) = z; }
            den += __shfl_xor(den, 16); den += __shfl_xor(den, 32);
            den += __expf(sink - mx);
            const float rden = 1.f / den;
            LDS_FENCE();
            f32x4 oacc[4];
#pragma unroll
            for (int dtl = 0; dtl < 4; ++dtl) oacc[dtl] = (f32x4){0.f, 0.f, 0.f, 0.f};
            const int nks = meta ? 1 : 5;
#pragma unroll
            for (int ks = 0; ks < 5; ++ks) {
                if (ks < nks) {
                    const int pc = 32 * ks + 8 * fq;
                    const bf16x8 pf = *(const LAS bf16x8*)(Pw + fr * 168 + pc);
                    const int vrow = (pc < 16 || meta) ? pc : pc + 16 * wid;
                    const LAS bf16_t* va = Vs + (vrow + (fr >> 2)) * 72 + 4 * (fr & 3);
#pragma unroll
                    for (int dtl = 0; dtl < 4; ++dtl) {
                        const s16x4 r1 = __builtin_amdgcn_ds_read_tr16_b64_v4i16((LAS s16x4*)(va + dtl * 16));
                        const s16x4 r2 = __builtin_amdgcn_ds_read_tr16_b64_v4i16((LAS s16x4*)(va + dtl * 16 + 4 * 72));
                        const bf16x8 vf = __builtin_shufflevector(r1, r2, 0, 1, 2, 3, 4, 5, 6, 7);
                        oacc[dtl] = MFMA16(vf, pf, oacc[dtl]);
                    }
                }
            }
            LDS_FENCE();
#pragma unroll
            for (int dtl = 0; dtl < 4; ++dtl) {
                u32x2 w; w.x = pack2(oacc[dtl][0] * rden, oacc[dtl][1] * rden); w.y = pack2(oacc[dtl][2] * rden, oacc[dtl][3] * rden);
                *(u32x2*)(ao + (size_t)tq * DM + hq * 64 + dtl * 16 + 4 * fq) = w;
            }
        }
    }
}
enum { K_PREP = 0, K_HIN, K_HPREP, K_HLOCAL, K_HSCAN, K_HOUT, K_GOUT, K_LN1, K_UP, K_CONV, K_DOWN, K_LN2, K_QKV, K_ATTN };
constexpr int N_PHASES = 1 + 2 * 11 + 2 * 8;
__host__ __device__ __forceinline__ void decode_phase(int ph, int& kind, int& layer) {
    if (ph == 0) { kind = K_PREP; layer = 0; return; }
    int r = ph - 1; layer = 0;
    if (r >= 19) { r -= 19; layer = 2; }
    if (r < 11) { kind = K_HIN + r; return; }
    r -= 11; layer += 1;
    kind = r == 0 ? K_QKV : (r == 1 ? K_ATTN : K_GOUT + (r - 2));
}
__global__ void __launch_bounds__(512, 2) fwd_megakernel(Params pin) {
    extern __shared__ __attribute__((aligned(16))) unsigned char shm[];
    LAS unsigned char* lds = (LAS unsigned char*)shm;
    cg::grid_group grid = cg::this_grid();
    volatile LAS unsigned* xst = (volatile LAS unsigned*)(lds + LDS_MAIN);
    if (threadIdx.x == 0) { xst[0] = 0u; xst[1] = 0u; }
    __syncthreads();
    XcdBarrier xb = xcd_barrier_post((unsigned*)(pin.ws + O_BAR), xst);
    if (pin.ph_lo == 0) { phase_prep(pin, lds); if (pin.ph_hi > 1) grid.sync(); }
    for (int ph = pin.ph_lo < 1 ? 1 : pin.ph_lo; ph < pin.ph_hi; ++ph) {
        Ctx p; { unsigned lo = (unsigned)(size_t)pin.ws, hi = (unsigned)((size_t)pin.ws >> 32); asm volatile("" : "+s"(lo), "+s"(hi)); p.ws = (unsigned char*)(__attribute__((address_space(1))) unsigned char*)(((size_t)hi << 32) | lo); p.out = pin.out; }
        ph = __builtin_amdgcn_readfirstlane(ph);
        int kind, layer; decode_phase(ph, kind, layer);
        const int jj = layer >> 1;
        bf16_t* hb = (bf16_t*)(p.ws + O_HB); float* h = (float*)(p.ws + O_H);
        bf16_t* mix = (bf16_t*)(p.ws + O_MIX);
        switch (kind) {
        case K_HIN: case K_QKV: case K_UP: {
            const bf16_t* w; bf16_t* O; int N;
            if (kind == K_HIN) { w = (const bf16_t*)(p.ws + O_WT_HIN) + (size_t)jj * 12288 * 2048; O = (bf16_t*)(p.ws + O_U); N = HYB_N;
                const int lane = tidx() & 63, wid = tidx() >> 6; const bf16_t* ws_ = (const bf16_t*)(p.ws + O_WT_HSIDE) + (size_t)jj * 48 * 2048; float* side = (float*)(p.ws + O_SIDE);
                for (int rt = bidx() * 8 + wid; rt < 513; rt += gridDim.x * 8) {
                    f32x4 a0 = {0.f, 0.f, 0.f, 0.f}, a1 = {0.f, 0.f, 0.f, 0.f}, a2 = {0.f, 0.f, 0.f, 0.f};
                    const bf16_t* pa = hb + (size_t)(rt * 16 + (lane & 15)) * 2048 + 8 * (lane >> 4);
                    const bf16_t* pb = ws_ + (size_t)(lane & 15) * 2048 + 8 * (lane >> 4);
#pragma unroll 8
                    for (int k0 = 0; k0 < 2048; k0 += 32) {
                        const bf16x8 a = *(const bf16x8*)(pa + k0);
                        a0 = MFMA16(*(const bf16x8*)(pb + k0), a, a0); a1 = MFMA16(*(const bf16x8*)(pb + 16 * 2048 + k0), a, a1); a2 = MFMA16(*(const bf16x8*)(pb + 32 * 2048 + k0), a, a2);
                    }
                    float* sr = side + (size_t)(rt * 16 + (lane & 15)) * 64 + 4 * (lane >> 4);
                    *(f32x4*)sr = a0; *(f32x4*)(sr + 16) = a1; *(f32x4*)(sr + 32) = a2; }
            } else if (kind == K_QKV) { w = (const bf16_t*)(p.ws + O_WT_QKV) + (size_t)jj * 3072 * 2048; O = (bf16_t*)(p.ws + O_U); N = QKV_N; }
            else { w = (const bf16_t*)(p.ws + O_WT_UP) + (size_t)layer * 11008 * 2048; O = (bf16_t*)(p.ws + O_R2); N = DFF2; }
            EpiStoreBf16 em{O, N}, e{O + (size_t)16 * N, N};
            gemm_full(lds, hb, w, N, 2048, em, e);
        } break;
        case K_GOUT: case K_DOWN: {
            const bf16_t* w; int K;
            if (kind == K_DOWN) { w = (const bf16_t*)(p.ws + O_WT_DOWN) + (size_t)layer * 2048 * 5504; K = DFF; }
            else if ((layer & 1) == 0) { w = (const bf16_t*)(p.ws + O_WT_HOUT) + (size_t)jj * 2048 * 4096; K = 4096; }
            else { w = (const bf16_t*)(p.ws + O_WT_SOUT) + (size_t)jj * 2048 * 2048; K = 2048; }
            EpiResF32 em{h, hb}, e{h + (size_t)16 * DM, hb + (size_t)16 * DM};
            gemm_full(lds, mix, w, 2048, K, em, e);
        } break;
        case K_HPREP: phase_hyb_prep(p, jj, lds); break;
        case K_HLOCAL: phase_hyb_local(p, lds); break;
        case K_HSCAN: phase_hyb_scan(p); break;
        case K_HOUT: phase_hyb_out(p, jj, lds); break;
        case K_ATTN: phase_attn(p, jj, lds); break;
        case K_LN1: phase_ln(p, p.in(20) + (size_t)layer * DM, p.in(21) + (size_t)layer * DM, false); break;
        case K_LN2: phase_ln(p, p.in(22) + (size_t)layer * DM, p.in(23) + (size_t)layer * DM, layer == 3); break;
        case K_CONV: phase_ffn_conv(p, layer); break;
        default: break;
        }
        if (ph + 1 < pin.ph_hi) xcd_barrier(xb);
    }
}

extern "C" void kernel_launch(void* const* d_in, const int* in_sizes, int n_in, void* d_out, int out_size, void* d_ws, size_t ws_size, hipStream_t stream) {
    static int grid = 0;
    if (grid == 0) {
        if (n_in != 24 || ws_size < WS_END) { fprintf(stderr, "kernel_launch: unexpected inputs (n_in %d, ws %zu, need %zu)\n", n_in, ws_size, (size_t)WS_END); grid = -1; return; }
        int dev = 0, cus = 0, per_cu = 0;
        (void)hipGetDevice(&dev);
        (void)hipDeviceGetAttribute(&cus, hipDeviceAttributeMultiprocessorCount, dev);
        if (hipFuncSetAttribute((const void*)fwd_megakernel, hipFuncAttributeMaxDynamicSharedMemorySize, LDS_BYTES) != hipSuccess) { fprintf(stderr, "kernel_launch: hipFuncSetAttribute failed\n"); grid = -1; return; }
        if (hipOccupancyMaxActiveBlocksPerMultiprocessor(&per_cu, (const void*)fwd_megakernel, NTHREADS, LDS_BYTES) != hipSuccess || per_cu < 1) { fprintf(stderr, "kernel_launch: occupancy query gave %d\n", per_cu); per_cu = 1; }
        (void)hipGetLastError();
        grid = cus * per_cu;
        if (grid > 256) grid = 256;
        fprintf(stderr, "kernel_launch: grid %d (cus %d, per_cu %d), ws need %zu of %zu\n", grid, cus, per_cu, (size_t)WS_END, ws_size);
    }
    if (grid < 0) return;
    Params p{};
    for (int i = 0; i < 24; ++i) p.in[i] = (const float*)d_in[i];
    p.out = (float*)d_out; p.ws = (unsigned char*)d_ws;
    for (int i = 0; i < 8; ++i) p.inv_freq[i] = powf(500000.0f, -(float)i / 8.0f);
#if PER_PHASE_LAUNCH
    for (int ph = 0; ph < N_PHASES; ++ph) {
        p.ph_lo = ph; p.ph_hi = ph + 1;
        hipLaunchKernelGGL(fwd_megakernel, dim3(grid), dim3(NTHREADS), LDS_BYTES, stream, p);
        { int kind, layer; decode_phase(ph, kind, layer); if ((DUP_MASK >> kind) & 1) hipLaunchKernelGGL(fwd_megakernel, dim3(grid), dim3(NTHREADS), LDS_BYTES, stream, p); }
    }
#else
    p.ph_lo = 0; p.ph_hi = N_PHASES;
    if (hipMemsetAsync((unsigned char*)d_ws + O_BAR, 0, XCD_BAR_WORDS * 4, stream) != hipSuccess) fprintf(stderr, "kernel_launch: memset failed\n");
    void* args[] = {&p};
    hipError_t e = hipLaunchCooperativeKernel((const void*)fwd_megakernel, dim3(grid), dim3(NTHREADS), args, LDS_BYTES, stream);
    if (e != hipSuccess) fprintf(stderr, "cooperative launch failed: %s (grid %d)\n", hipGetErrorString(e), grid);
#endif
}
```
